# Optimizing an MI355X kernel written in HIP

```python
import math
import jax, jax.numpy as jnp
from jax import lax
import numpy as np


D_MODEL = 1024
BATCH = 8
SEQ = 2048
DEPTH = 2

N_A_LAYERS = DEPTH // 2
N_B_LAYERS = DEPTH - N_A_LAYERS
RET_HEADS = 4
RET_QK_DIM = D_MODEL // RET_HEADS
RET_V_DIM = 2 * RET_QK_DIM
RET_CHUNK = 128
DIFF_HEADS = 4
DIFF_HEAD_DIM = D_MODEL // (2 * DIFF_HEADS)
DIFF_V_DIM = 2 * DIFF_HEAD_DIM
Q_BLOCK = 128
D_FF = 2816
CONV_WIDTH = 3
ROPE_THETA = 10000.0
NORM_EPS = 1e-6

kernel_name = 'yoco_retention_diffattn_convffn_adaln'


def rms_norm(x, gain=None, eps=NORM_EPS):
    xf = x.astype(jnp.float32)
    y = xf * lax.rsqrt(jnp.mean(xf * xf, axis=-1, keepdims=True) + eps)
    if gain is not None:
        y = y * gain.astype(jnp.float32)
    return y.astype(x.dtype)


def rope(x, freqs):
    s, d = x.shape[1], x.shape[-1]
    ang = jnp.arange(s, dtype=jnp.float32)[:, None] * freqs[None, :]
    shape = (s,) + (1,) * (x.ndim - 3) + (d // 2,)
    cos = jnp.cos(ang).reshape(shape)
    sin = jnp.sin(ang).reshape(shape)
    xf = x.astype(jnp.float32)
    x1, x2 = xf[..., : d // 2], xf[..., d // 2:]
    return jnp.concatenate([x1 * cos - x2 * sin, x2 * cos + x1 * sin], axis=-1).astype(x.dtype)


def adaln(c, w, b):
    return jax.nn.silu(c) @ w + b


def retention(q, k, v):
    b, s, h, dk = q.shape
    dv = v.shape[-1]
    c = RET_CHUNK
    n = s // c
    log_gamma = jnp.log(1.0 - 2.0 ** (-5.0 - jnp.arange(h, dtype=jnp.float32)))
    i = jnp.arange(c, dtype=jnp.float32)
    diff = i[:, None] - i[None, :]
    dmask = jnp.where(diff >= 0, jnp.exp(log_gamma[:, None, None] * jnp.maximum(diff, 0.0)), 0.0)
    q_dec = jnp.exp(log_gamma[:, None] * (i + 1.0))
    k_dec = jnp.exp(log_gamma[:, None] * (c - 1.0 - i))
    c_dec = jnp.exp(log_gamma * c)

    def to_chunks(t):
        return t.astype(jnp.float32).reshape(b, n, c, h, t.shape[-1]).transpose(1, 0, 3, 2, 4)

    def step(state, xs):
        qc, kc, vc = xs
        inner = jnp.einsum('bhqd,bhkd->bhqk', qc, kc) * dmask
        out = (jnp.einsum('bhqk,bhkv->bhqv', inner, vc)
               + jnp.einsum('bhqd,bhdv->bhqv', qc * q_dec[..., None], state))
        state = state * c_dec[:, None, None] + jnp.einsum('bhkd,bhkv->bhdv', kc * k_dec[..., None], vc)
        return state, out

    state0 = jnp.zeros((b, h, dk, dv), jnp.float32)
    _, out = lax.scan(step, state0, (to_chunks(q), to_chunks(k), to_chunks(v)))
    return out.transpose(1, 0, 3, 2, 4).reshape(b, s, h, dv).astype(v.dtype)


def diff_attention(q, k, v, lam):
    b, s, h, _, d = q.shape
    dv = v.shape[-1]
    nb = s // Q_BLOCK
    qb = q.reshape(b, nb, Q_BLOCK, h, 2, d).transpose(1, 0, 3, 4, 2, 5)
    kt = k.transpose(0, 2, 3, 1, 4)
    vt = v.transpose(0, 2, 1, 3)
    kpos = jnp.arange(s, dtype=jnp.int32)
    scale = d ** -0.5

    def block(args):
        qblk, start = args
        qpos = start + jnp.arange(Q_BLOCK, dtype=jnp.int32)
        sc = jnp.einsum('bhpqd,bhpkd->bhpqk', qblk, kt).astype(jnp.float32) * scale
        sc = jnp.where(kpos[None, :] <= qpos[:, None], sc, -jnp.inf)
        p = jax.nn.softmax(sc, axis=-1)
        a = p[:, :, 0] - lam * p[:, :, 1]
        return jnp.einsum('bhqk,bhkv->bhqv', a.astype(vt.dtype), vt)

    starts = jnp.arange(nb, dtype=jnp.int32) * Q_BLOCK
    out = lax.map(block, (qb, starts))
    return out.transpose(1, 0, 3, 2, 4).reshape(b, s, h, dv)


def conv_ffn(h, w_in, w_conv, b_conv, w_down):
    a, g = jnp.split(h @ w_in, 2, axis=-1)
    a = lax.conv_general_dilated(a, w_conv[:, None, :], window_strides=(1,),
                                 padding=[(CONV_WIDTH - 1, 0)],
                                 dimension_numbers=('NWC', 'WIO', 'NWC'),
                                 feature_group_count=D_FF) + b_conv
    return (jax.nn.gelu(a, approximate=False) * g) @ w_down


def setup_inputs(seed: int = 0) -> dict:
    key = jax.random.key(seed)
    ks = jax.random.split(key, 20)
    f32 = jnp.float32
    D = D_MODEL

    def nrm(k, shape, scale):
        return jax.random.normal(k, shape, f32) * scale

    ret_in = 2 * RET_HEADS * RET_QK_DIM + 2 * RET_HEADS * RET_V_DIM
    ret_out = RET_HEADS * RET_V_DIM
    diff_q = DIFF_HEADS * 2 * DIFF_HEAD_DIM
    kv = diff_q + DIFF_HEADS * DIFF_V_DIM
    diff_o = DIFF_HEADS * DIFF_V_DIM
    return {
        'x': nrm(ks[0], (BATCH, SEQ, D), 1.0),
        'c': nrm(ks[1], (BATCH, D), 1.0),
        'norm_gain': 1.0 + nrm(ks[2], (DEPTH, 2, D), 0.05),
        'w_ada': nrm(ks[3], (DEPTH, D, 6 * D), D ** -0.5),
        'b_ada': nrm(ks[4], (DEPTH, 6 * D), 0.02),
        'ret_w_in': nrm(ks[5], (N_A_LAYERS, D, ret_in), D ** -0.5),
        'ret_w_out': nrm(ks[6], (N_A_LAYERS, ret_out, D), ret_out ** -0.5),
        'ffn_w_in': nrm(ks[7], (DEPTH, D, 2 * D_FF), D ** -0.5),
        'ffn_w_conv': nrm(ks[8], (DEPTH, CONV_WIDTH, D_FF), CONV_WIDTH ** -0.5),
        'ffn_b_conv': nrm(ks[9], (DEPTH, D_FF), 0.02),
        'ffn_w_down': nrm(ks[10], (DEPTH, D_FF, D), D_FF ** -0.5),
        'kv_norm_gain': 1.0 + nrm(ks[11], (D,), 0.05),
        'kv_w_ada': nrm(ks[12], (D, 2 * D), D ** -0.5),
        'kv_b_ada': nrm(ks[13], (2 * D,), 0.02),
        'w_kv': nrm(ks[14], (D, kv), D ** -0.5),
        'diff_w_q': nrm(ks[15], (N_B_LAYERS, D, diff_q), D ** -0.5),
        'diff_lambda': nrm(ks[16], (N_B_LAYERS, 4, DIFF_HEAD_DIM), 0.1),
        'diff_subln_gain': 1.0 + nrm(ks[17], (N_B_LAYERS, DIFF_V_DIM), 0.05),
        'diff_w_out': nrm(ks[18], (N_B_LAYERS, diff_o, D), diff_o ** -0.5),
        'final_norm_gain': 1.0 + nrm(ks[19], (D,), 0.05),
    }


def reference(x, c, norm_gain, w_ada, b_ada, ret_w_in, ret_w_out, ffn_w_in, ffn_w_conv,
              ffn_b_conv, ffn_w_down, kv_norm_gain, kv_w_ada, kv_b_ada, w_kv, diff_w_q,
              diff_lambda, diff_subln_gain, diff_w_out, final_norm_gain):
    b, s, _ = x.shape
    ret_freqs = 1.0 / (ROPE_THETA ** jnp.linspace(0.0, 1.0, RET_QK_DIM // 2))
    diff_freqs = 1.0 / (ROPE_THETA ** (jnp.arange(0, DIFF_HEAD_DIM, 2, dtype=jnp.float32) / DIFF_HEAD_DIM))
    ret_split = [RET_HEADS * RET_QK_DIM, 2 * RET_HEADS * RET_QK_DIM,
                 2 * RET_HEADS * RET_QK_DIM + RET_HEADS * RET_V_DIM]
    k_dim = DIFF_HEADS * 2 * DIFF_HEAD_DIM
    k_sh = None
    v_sh = None
    for layer in range(DEPTH):
        mod = adaln(c, w_ada[layer], b_ada[layer])[:, None, :]
        sh1, sc1, g1, sh2, sc2, g2 = jnp.split(mod, 6, axis=-1)
        h = rms_norm(x, norm_gain[layer, 0]) * (1.0 + sc1) + sh1
        if layer < N_A_LAYERS:
            q, k, v, gt = jnp.split(h @ ret_w_in[layer], ret_split, axis=-1)
            q = rope(q.reshape(b, s, RET_HEADS, RET_QK_DIM), ret_freqs)
            k = rope(k.reshape(b, s, RET_HEADS, RET_QK_DIM), ret_freqs) * (RET_QK_DIM ** -0.5)
            o = retention(q, k, v.reshape(b, s, RET_HEADS, RET_V_DIM))
            o = rms_norm(o).reshape(b, s, RET_HEADS * RET_V_DIM)
            mix = (jax.nn.silu(gt) * o) @ ret_w_out[layer]
        else:
            j = layer - N_A_LAYERS
            q = rope((h @ diff_w_q[j]).reshape(b, s, DIFF_HEADS, 2, DIFF_HEAD_DIM), diff_freqs)
            lv = diff_lambda[j].astype(jnp.float32)
            lam_init = 0.8 - 0.6 * math.exp(-0.3 * layer)
            lam = jnp.exp(jnp.sum(lv[0] * lv[1])) - jnp.exp(jnp.sum(lv[2] * lv[3])) + lam_init
            o = diff_attention(q, k_sh, v_sh, lam)
            o = rms_norm(o, diff_subln_gain[j]) * (1.0 - lam_init)
            mix = o.reshape(b, s, DIFF_HEADS * DIFF_V_DIM) @ diff_w_out[j]
        x = x + g1 * mix
        h = rms_norm(x, norm_gain[layer, 1]) * (1.0 + sc2) + sh2
        x = x + g2 * conv_ffn(h, ffn_w_in[layer], ffn_w_conv[layer], ffn_b_conv[layer], ffn_w_down[layer])
        if layer == N_A_LAYERS - 1:
            kv_sh, kv_sc = jnp.split(adaln(c, kv_w_ada, kv_b_ada)[:, None, :], 2, axis=-1)
            hk = rms_norm(x, kv_norm_gain) * (1.0 + kv_sc) + kv_sh
            kv = hk @ w_kv
            k_sh = rope(kv[..., :k_dim].reshape(b, s, DIFF_HEADS, 2, DIFF_HEAD_DIM), diff_freqs)
            v_sh = kv[..., k_dim:].reshape(b, s, DIFF_HEADS, DIFF_V_DIM)
    return rms_norm(x, final_norm_gain)
```

```cpp
#include <hip/hip_runtime.h>
#include <hip/hip_cooperative_groups.h>
#include <cstdio>
#include <cstdint>
namespace cg = cooperative_groups;

#define LAS __attribute__((address_space(3)))
typedef unsigned short bf16_t;
typedef short bf16x8 __attribute__((ext_vector_type(8)));
typedef short s16x4 __attribute__((ext_vector_type(4)));
typedef float f32x4 __attribute__((ext_vector_type(4)));
typedef float f32x2 __attribute__((ext_vector_type(2)));
typedef unsigned u32x4 __attribute__((ext_vector_type(4)));
typedef unsigned u32x2 __attribute__((ext_vector_type(2)));

#ifndef MK_DUP
#define MK_DUP -1
#endif
#ifndef MK_DUPSYNC
#define MK_DUPSYNC 0
#endif
#ifndef MK_PER_PHASE
#define MK_PER_PHASE 0
#endif

constexpr int NB = 8, SEQ = 2048, DM = 1024, TOK = NB * SEQ;
constexpr int DFF = 2816, NFF = 2 * DFF;
constexpr float EPS = 1e-6f;
constexpr int NPHASE = 18;

constexpr size_t MiB = 1u << 20;
constexpr size_t WS_MOD0 = 0, WS_MOD1 = 196608, WS_KVMOD = 393216, WS_LAM = 458752, CTL_ZERO_BYTES = 1 * MiB;
constexpr size_t WS_BAR = 524288, BAR_ZERO_BYTES = 16384;
constexpr size_t WS_TABR = 1 * MiB, WS_TABD = 3 * MiB;
constexpr size_t WS_WRIN = 4 * MiB, WS_WROUT = 16 * MiB, WS_WFIN0 = 20 * MiB, WS_WFIN1 = 31 * MiB, WS_WFDN0 = 42 * MiB, WS_WFDN1 = 42 * MiB + 5632 * 1024,
                 WS_WKV = 53 * MiB, WS_WQ = 57 * MiB, WS_WO = 59 * MiB;
constexpr size_t WS_A0 = 61 * MiB;
constexpr size_t WS_Q = WS_A0, WS_K = 93 * MiB, WS_V = 125 * MiB, WS_G = 189 * MiB;
constexpr size_t WS_H = WS_A0 + 8192;
constexpr size_t WS_U = 126 * MiB;
constexpr size_t WS_H3 = 94 * MiB, WS_KSH = 126 * MiB, WS_VSH = 158 * MiB, WS_QD = 190 * MiB, WS_O0 = 222 * MiB, WS_O1 = WS_H, WS_OD = 94 * MiB;
constexpr size_t WS_SSQ = 253 * MiB;
constexpr size_t WS_XSLOT = 255 * MiB;
constexpr size_t WS_XCNT = 700000;
constexpr size_t WS_END = 256 * MiB;

constexpr int LDS_BYTES = 147456;
constexpr int LDS_XOFF = 131072;

__device__ __forceinline__ unsigned cvt_pk_bf16(float lo, float hi) { unsigned r; asm volatile("v_cvt_pk_bf16_f32 %0, %1, %2" : "=v"(r) : "v"(lo), "v"(hi)); return r; }
__device__ __forceinline__ float bf_lo(unsigned u) { return __uint_as_float(u << 16); }
__device__ __forceinline__ float bf_hi(unsigned u) { return __uint_as_float(u & 0xffff0000u); }
__device__ __forceinline__ float wave_sum(float v) {
#pragma unroll
    for (int o = 1; o < 64; o <<= 1) v += __shfl_xor(v, o);
    return v;
}
__device__ __forceinline__ float silu_f(float x) { return x / (1.0f + __expf(-x)); }
__device__ __forceinline__ f32x2 gelu_pk(f32x2 v) {
    const f32x2 av = __builtin_elementwise_abs(v), d = av * 0.2316418882f + 1.0f;
    f32x2 t; t.x = __builtin_amdgcn_rcpf(d.x); t.y = __builtin_amdgcn_rcpf(d.y);
    f32x2 q = t * 0.5307027145f + (-0.7265760135f); q = q * t + 0.7107068705f; q = q * t + (-0.142248368f); q = q * t + 0.127414796f; q = q * t;
    const f32x2 s = (v * v) * (-0.72134752044f);
    f32x2 e; e.x = __builtin_amdgcn_exp2f(s.x); e.y = __builtin_amdgcn_exp2f(s.y);
    const f32x2 m = v * (q * e), r = v - m;
    f32x2 o; o.x = v.x < 0.f ? m.x : r.x; o.y = v.y < 0.f ? m.y : r.y; return o;
}
__device__ __forceinline__ u32x4 pack8(const f32x4 a, const f32x4 b) { u32x4 w; w.x = cvt_pk_bf16(a[0], a[1]); w.y = cvt_pk_bf16(a[2], a[3]); w.z = cvt_pk_bf16(b[0], b[1]); w.w = cvt_pk_bf16(b[2], b[3]); return w; }
__device__ __forceinline__ bf16x8 lds_b128(const LAS unsigned char* p) { return *(const LAS bf16x8*)p; }
__device__ __forceinline__ s16x4 lds_tr(const LAS unsigned char* p) { return __builtin_amdgcn_ds_read_tr16_b64_v4i16((LAS s16x4*)p); }
__device__ __forceinline__ void glds16_asm(const void* gsrc, unsigned lds_dst) { unsigned keep;
    asm volatile("s_mov_b32 %0, m0\n\ts_mov_b32 m0, %2\n\ts_nop 0\n\tglobal_load_lds_dwordx4 %1, off\n\ts_mov_b32 m0, %0" : "=&s"(keep) : "v"(gsrc), "s"(lds_dst) : "memory"); }
template <int OFF> __device__ __forceinline__ s16x4 lds_tr_asm(unsigned addr) { s16x4 d; asm volatile("ds_read_b64_tr_b16 %0, %1 offset:%2" : "=v"(d) : "v"(addr), "n"(OFF)); return d; }
#define LGKM_WAIT8(n, r) asm volatile("s_waitcnt lgkmcnt(" #n ")" : "+v"(r[0]), "+v"(r[1]), "+v"(r[2]), "+v"(r[3]), "+v"(r[4]), "+v"(r[5]), "+v"(r[6]), "+v"(r[7]))
__device__ __forceinline__ bf16x8 cat4(s16x4 a, s16x4 b) { return __builtin_shufflevector(a, b, 0, 1, 2, 3, 4, 5, 6, 7); }
__device__ __forceinline__ bf16x8 pack_frag(const f32x4 a, const f32x4 b) { u32x4 w = pack8(a, b); return __builtin_bit_cast(bf16x8, w); }
#define MFMA16(a, b, c) __builtin_amdgcn_mfma_f32_16x16x32_bf16((a), (b), (c), 0, 0, 0)

namespace pg8 {
constexpr int BM = 256, BK = 64, HALF = 128, HTB = HALF * BK * 2, STAGE_BYTES = 8 * HTB, NXCD = 8, WGM = 8;
__host__ __device__ __forceinline__ int lds_byte(int r, int c) { const int st = (r >> 4) * 2 + (c >> 5), rr = r & 15, cc = c & 31, ob = rr * 64 + cc * 2; return st * 1024 + (ob ^ (((ob >> 9) & 1) << 5)); }
__host__ __device__ __forceinline__ void stage_rc(int b, int& R, int& C) { const int st = b / 1024, sb = b % 1024, swz = sb ^ (((sb >> 9) & 1) << 5); R = (st >> 1) * 16 + swz / 64; C = (st & 1) * 32 + (swz % 64) / 2; }
__host__ __device__ __forceinline__ int perm32(int rho) { const int n = rho >> 4, i = rho & 15; return 8 * (i >> 2) + 4 * n + (i & 3); }

struct Unit { int pm, pn; };
struct Gemm { const bf16_t* A; const bf16_t* Bt; int M, N, K; int a_rows; };

struct StaticOrder {
    int nM, nN, nwg, G, c;
    __host__ __device__ void init(int M, int N, int G_, int c_) { nM = M / BM; nN = N / BM; nwg = nM * nN; G = G_; c = c_; }
    __host__ __device__ bool next(int i, Unit& u) const {
        const long L = (long)i * G + c; if (L >= nwg) return false;
        int wgid = (int)L; { const int q = nwg / NXCD, r = nwg % NXCD, xcd = wgid % NXCD, off = wgid / NXCD; wgid = (xcd < r ? xcd * (q + 1) : r * (q + 1) + (xcd - r) * q) + off; }
        const int nig = WGM * nN, gid = wgid / nig, fm = gid * WGM, gsz = (nM - fm) < WGM ? (nM - fm) : WGM;
        u.pm = fm + ((wgid % nig) % gsz); u.pn = (wgid % nig) / gsz; return true;
    }
};

template <class Epi>
__device__ __forceinline__ void gemm_phase(LAS unsigned char* lds, LAS unsigned char* ldsx, const Gemm g, const StaticOrder& S, const Epi& E) {
    const int tid = threadIdx.x, wid = __builtin_amdgcn_readfirstlane(tid >> 6), lane = tid & 63, wr = wid >> 2, wc = wid & 3, fr = lane & 15, fq = lane >> 4;
    const int K = g.K, nt = K / BK;
    unsigned voffA[2], voffB[2];
#pragma unroll
    for (int i = 0; i < 2; ++i) { int R, C; stage_rc(tid * 16 + i * 8192, R, C); const int Rb = Epi::PERM ? ((R & ~31) + perm32(R & 31)) : R;
        voffA[i] = (unsigned)(R * K + C) * 2u; voffB[i] = (unsigned)(Rb * K + C) * 2u; }
    const size_t kstep = (size_t)(BK * 2);
    const size_t hstep = (size_t)HALF * K * 2;
    const size_t tstepB = 2 * hstep;
    const size_t tstepA = (size_t)g.a_rows * K * 2;
    const unsigned ldsw = (unsigned)wid * 1024u;
    const int aoff = lds_byte(wr * 64 + fr, fq * 8), boff = lds_byte(wc * 32 + fr, fq * 8);
#define PG8_SA(b, h) (((b) * 2 + (h)) * HTB)
#define PG8_SB(b, h) ((4 + (b) * 2 + (h)) * HTB)
#define PG8_STAGE(bufoff, gbase, voff) do { _Pragma("unroll") for (int _i = 0; _i < 2; ++_i) \
        __builtin_amdgcn_global_load_lds((const unsigned*)((const char*)(gbase) + (voff)[_i]), (LAS unsigned*)(lds + (bufoff) + ldsw + _i * 8192), 16, 0, 0); } while (0)
#define PG8_LDA(dst, b, h) do { _Pragma("unroll") for (int m = 0; m < 4; ++m) _Pragma("unroll") for (int k = 0; k < 2; ++k) dst[m][k] = *(const LAS bf16x8*)(lds + PG8_SA(b, h) + aoff + m * 2048 + k * 1024); } while (0)
#define PG8_LDB(dst, b, h) do { _Pragma("unroll") for (int n = 0; n < 2; ++n) _Pragma("unroll") for (int k = 0; k < 2; ++k) dst[n][k] = *(const LAS bf16x8*)(lds + PG8_SB(b, h) + boff + n * 2048 + k * 1024); } while (0)
#define PG8_MMA(ai, bj, At, Bt) do { __builtin_amdgcn_s_setprio(1); _Pragma("unroll") for (int m = 0; m < 4; ++m) _Pragma("unroll") for (int n = 0; n < 2; ++n) _Pragma("unroll") for (int k = 0; k < 2; ++k) \
        acc[ai][bj][m][n] = __builtin_amdgcn_mfma_f32_16x16x32_bf16(Bt[n][k], At[m][k], acc[ai][bj][m][n], 0, 0, 0); __builtin_amdgcn_s_setprio(0); } while (0)
#define PG8_WAIT_V(n) asm volatile("s_waitcnt vmcnt(" #n ")" ::: "memory")
#define PG8_WAIT_L(n) asm volatile("s_waitcnt lgkmcnt(" #n ")" ::: "memory")
#define PG8_BAR __builtin_amdgcn_s_barrier()
#define PG8_SCHED __builtin_amdgcn_sched_barrier(0)
    Unit cur, nxt; int ui = 0;
    if (!S.next(0, cur)) return;
    if constexpr (Epi::KHOOK) E.prep(cur, ldsx);
    f32x4 acc[2][2][4][2];
#pragma unroll
    for (int a = 0; a < 2; ++a)
#pragma unroll
        for (int b = 0; b < 2; ++b)
#pragma unroll
            for (int m = 0; m < 4; ++m)
#pragma unroll
                for (int n = 0; n < 2; ++n) acc[a][b][m][n] = (f32x4){0.f, 0.f, 0.f, 0.f};
    bf16x8 At[4][2], B0[2][2], B1[2][2];
    const char* cA = (const char*)g.A + (size_t)cur.pm * tstepA; const char* cB = (const char*)g.Bt + (size_t)cur.pn * tstepB;
    PG8_STAGE(PG8_SB(0, 0), cB, voffB); PG8_STAGE(PG8_SB(0, 1), cB + hstep, voffB); PG8_STAGE(PG8_SA(0, 0), cA, voffA); PG8_STAGE(PG8_SA(0, 1), cA + hstep, voffA);
    if (wr == 1) PG8_BAR;
    PG8_WAIT_V(2); PG8_BAR;
    PG8_STAGE(PG8_SB(1, 0), cB + kstep, voffB); PG8_STAGE(PG8_SA(1, 0), cA + kstep, voffA); PG8_STAGE(PG8_SB(1, 1), cB + hstep + kstep, voffB);
    PG8_WAIT_V(6); PG8_BAR;
    for (;;) {
        const bool has_next = S.next(ui + 1, nxt);
        const char* nA = has_next ? (const char*)g.A + (size_t)nxt.pm * tstepA : cA; const char* nB = has_next ? (const char*)g.Bt + (size_t)nxt.pn * tstepB : cB;
        for (int t = 0; t < nt; t += 2) {
            const bool last = (t == nt - 2);
            if constexpr (Epi::KHOOK) { if (t != 0 && (t & 7) == 0) E.khook(acc, t >> 3, wr, fr, ldsx); }
            const char* a1 = cA + (size_t)(t + 1) * kstep;
            const char* a2 = last ? nA : cA + (size_t)(t + 2) * kstep; const char* b2 = last ? nB : cB + (size_t)(t + 2) * kstep;
            const char* a3 = a2 + kstep; const char* b3 = b2 + kstep;
            PG8_LDB(B0, 0, 0); PG8_LDB(B1, 0, 1); PG8_SCHED; PG8_LDA(At, 0, 0); PG8_STAGE(PG8_SA(1, 1), a1 + hstep, voffA);
            PG8_WAIT_V(8); PG8_WAIT_L(0); PG8_BAR; PG8_MMA(0, 0, At, B0); PG8_MMA(0, 1, At, B1); PG8_BAR; PG8_SCHED;
            PG8_LDA(At, 0, 1); PG8_STAGE(PG8_SB(0, 0), b2, voffB); PG8_STAGE(PG8_SB(0, 1), b2 + hstep, voffB); PG8_STAGE(PG8_SA(0, 0), a2, voffA);
            PG8_WAIT_V(8); PG8_WAIT_L(0); PG8_BAR; PG8_MMA(1, 0, At, B0); PG8_MMA(1, 1, At, B1); PG8_BAR; PG8_SCHED;
            PG8_LDB(B0, 1, 0); PG8_LDB(B1, 1, 1); PG8_SCHED; PG8_LDA(At, 1, 0); PG8_STAGE(PG8_SA(0, 1), a2 + hstep, voffA);
            PG8_WAIT_V(8); PG8_WAIT_L(0); PG8_BAR; PG8_MMA(0, 0, At, B0); PG8_MMA(0, 1, At, B1); PG8_BAR; PG8_SCHED;
            PG8_LDA(At, 1, 1); PG8_STAGE(PG8_SB(1, 0), b3, voffB); PG8_STAGE(PG8_SB(1, 1), b3 + hstep, voffB); PG8_STAGE(PG8_SA(1, 0), a3, voffA);
            PG8_WAIT_V(8); PG8_WAIT_L(0); PG8_BAR; PG8_MMA(1, 0, At, B0); PG8_MMA(1, 1, At, B1); PG8_BAR; PG8_SCHED;
        }
        if (wr == 0) PG8_BAR;
        E(acc, cur, wr, wc, fr, fq, ldsx);
        if (!has_next) break;
#pragma unroll
        for (int a = 0; a < 2; ++a)
#pragma unroll
            for (int b = 0; b < 2; ++b)
#pragma unroll
                for (int m = 0; m < 4; ++m)
#pragma unroll
                    for (int n = 0; n < 2; ++n) acc[a][b][m][n] = (f32x4){0.f, 0.f, 0.f, 0.f};
        cur = nxt; cA = nA; cB = nB; ++ui;
        if (wr == 1) PG8_BAR;
    }
    PG8_WAIT_V(0);
    PG8_BAR;
#undef PG8_SA
#undef PG8_SB
#undef PG8_STAGE
#undef PG8_LDA
#undef PG8_LDB
#undef PG8_MMA
#undef PG8_WAIT_V
#undef PG8_WAIT_L
#undef PG8_BAR
#undef PG8_SCHED
}
}
using pg8::Unit;

struct EpiRetIn {
    static constexpr bool PERM = true, KHOOK = false;
    bf16_t *Q, *Kk, *V, *G; const float* tab;
    __device__ __forceinline__ void operator()(const f32x4 (&acc)[2][2][4][2], const Unit& u, int wr, int wc, int fr, int fq, LAS unsigned char*) const {
        const int row0 = u.pm * 256 + wr * 64 + fr, cw = wc * 32 + 8 * fq;
        if (u.pn < 8) {
            const int head = u.pn & 3; const bool isk = u.pn >= 4;
            bf16_t* dst = (isk ? Kk : Q) + head * 256 + cw;
            const float lg = log2f(1.0f - exp2f(-5.0f - (float)head));
#pragma unroll
            for (int ai = 0; ai < 2; ++ai)
#pragma unroll
                for (int m = 0; m < 4; ++m) {
                    const int row = row0 + ai * 128 + m * 16, pos = row & 2047, ci = pos & 127;
                    const float sc = isk ? exp2f(-lg * (float)ci) * 0.0625f : exp2f(lg * (float)ci);
                    const f32x4* tp = (const f32x4*)(tab + ((size_t)pos * 128 + cw) * 2);
                    const f32x4 t0 = tp[0], t1 = tp[1], t2 = tp[2], t3 = tp[3];
                    const f32x4 cs0 = {t0[0], t0[2], t1[0], t1[2]}, sn0 = {t0[1], t0[3], t1[1], t1[3]}, cs1 = {t2[0], t2[2], t3[0], t3[2]}, sn1 = {t2[1], t2[3], t3[1], t3[3]};
                    const f32x4 x10 = acc[ai][0][m][0], x11 = acc[ai][0][m][1], x20 = acc[ai][1][m][0], x21 = acc[ai][1][m][1];
                    const f32x4 o10 = (x10 * cs0 - x20 * sn0) * sc, o11 = (x11 * cs1 - x21 * sn1) * sc;
                    const f32x4 o20 = (x20 * cs0 + x10 * sn0) * sc, o21 = (x21 * cs1 + x11 * sn1) * sc;
                    bf16_t* rp = dst + (size_t)row * 1024;
                    *(u32x4*)rp = pack8(o10, o11); *(u32x4*)(rp + 128) = pack8(o20, o21);
                }
        } else {
            bf16_t* dst = (u.pn < 16 ? V + (u.pn - 8) * 256 : G + (u.pn - 16) * 256) + cw;
#pragma unroll
            for (int ai = 0; ai < 2; ++ai)
#pragma unroll
                for (int m = 0; m < 4; ++m) {
                    bf16_t* rp = dst + (size_t)(row0 + ai * 128 + m * 16) * 2048;
#pragma unroll
                    for (int bj = 0; bj < 2; ++bj) *(u32x4*)(rp + bj * 128) = pack8(acc[ai][bj][m][0], acc[ai][bj][m][1]);
                }
        }
    }
};
struct EpiRes {
    static constexpr bool PERM = false, KHOOK = false;
    const float* base; float* out; const float* gate;
    __device__ __forceinline__ void operator()(const f32x4 (&acc)[2][2][4][2], const Unit& u, int wr, int wc, int fr, int fq, LAS unsigned char*) const {
        const int row0 = u.pm * 256 + wr * 64 + fr, col0 = u.pn * 256 + wc * 32 + 4 * fq;
#pragma unroll
        for (int ai = 0; ai < 2; ++ai)
#pragma unroll
            for (int m = 0; m < 4; ++m) {
                const int row = row0 + ai * 128 + m * 16; const float* gp = gate + (size_t)(row >> 11) * 6144 + col0; const size_t off = (size_t)row * 1024 + col0;
#pragma unroll
                for (int bj = 0; bj < 2; ++bj)
#pragma unroll
                    for (int n = 0; n < 2; ++n) { const int c = bj * 128 + n * 16; const f32x4 gv = *(const f32x4*)(gp + c), bs = *(const f32x4*)(base + off + c);
                        *(f32x4*)(out + off + c) = bs + gv * acc[ai][bj][m][n]; }
            }
    }
};
struct EpiResHead {
    static constexpr bool PERM = false, KHOOK = true;
    const float* base; float* out; const float* gate; const float* ssq;
    __device__ __forceinline__ void prep(const Unit& u, LAS unsigned char* lx) const {
        const int t = threadIdx.x;
        if (t < 256) {
            const f32x4* p = (const f32x4*)(ssq + (size_t)(u.pm * 256 + t) * 32);
            float ri[4];
#pragma unroll
            for (int h = 0; h < 4; ++h) { const f32x4 a = p[2 * h], b = p[2 * h + 1]; const float sm = ((a[0] + a[1]) + (a[2] + a[3])) + ((b[0] + b[1]) + (b[2] + b[3])); ri[h] = 1.0f / sqrtf(sm * (1.0f / 512.0f) + EPS); }
            *(LAS f32x4*)(lx + t * 16) = (f32x4){ri[3], ri[0] / ri[1], ri[1] / ri[2], ri[2] / ri[3]};
        }
        asm volatile("s_waitcnt lgkmcnt(0)" ::: "memory");
    }
    __device__ __forceinline__ void khook(f32x4 (&acc)[2][2][4][2], int hb, int wr, int fr, LAS unsigned char* lx) const {
#pragma unroll
        for (int ai = 0; ai < 2; ++ai)
#pragma unroll
            for (int m = 0; m < 4; ++m) { const float f = ((const LAS float*)lx)[(ai * 128 + wr * 64 + m * 16 + fr) * 4 + hb];
#pragma unroll
                for (int bj = 0; bj < 2; ++bj)
#pragma unroll
                    for (int n = 0; n < 2; ++n) acc[ai][bj][m][n] = acc[ai][bj][m][n] * f; }
    }
    __device__ __forceinline__ void operator()(const f32x4 (&acc)[2][2][4][2], const Unit& u, int wr, int wc, int fr, int fq, LAS unsigned char* lx) const {
        const int row0 = u.pm * 256 + wr * 64 + fr, col0 = u.pn * 256 + wc * 32 + 4 * fq;
#pragma unroll
        for (int ai = 0; ai < 2; ++ai)
#pragma unroll
            for (int m = 0; m < 4; ++m) {
                const int row = row0 + ai * 128 + m * 16; const float* gp = gate + (size_t)(row >> 11) * 6144 + col0; const size_t off = (size_t)row * 1024 + col0;
                const float r3 = ((const LAS float*)lx)[(ai * 128 + wr * 64 + m * 16 + fr) * 4];
#pragma unroll
                for (int bj = 0; bj < 2; ++bj)
#pragma unroll
                    for (int n = 0; n < 2; ++n) { const int c = bj * 128 + n * 16; const f32x4 gv = *(const f32x4*)(gp + c), bs = *(const f32x4*)(base + off + c);
                        *(f32x4*)(out + off + c) = bs + gv * (acc[ai][bj][m][n] * r3); }
            }
    }
};
struct NormOut { bf16_t* dst; const float* gain; const float* sh; const float* sc; int bstride; };
template <bool HEAD, int NX> struct EpiResNorm {
    static constexpr bool PERM = false, KHOOK = HEAD;
    const float* base; float* out; const float* gate; const float* ssq; NormOut no[2]; float* slots; unsigned* cnt; unsigned target;
    __device__ __forceinline__ void prep(const Unit& u, LAS unsigned char* lx) const {
        const int t = threadIdx.x;
        if (t < 256) {
            const f32x4* p = (const f32x4*)(ssq + (size_t)(u.pm * 256 + t) * 32);
            float ri[4];
#pragma unroll
            for (int h = 0; h < 4; ++h) { const f32x4 a = p[2 * h], b = p[2 * h + 1]; const float sm = ((a[0] + a[1]) + (a[2] + a[3])) + ((b[0] + b[1]) + (b[2] + b[3])); ri[h] = 1.0f / sqrtf(sm * (1.0f / 512.0f) + EPS); }
            *(LAS f32x4*)(lx + t * 16) = (f32x4){ri[3], ri[0] / ri[1], ri[1] / ri[2], ri[2] / ri[3]};
        }
        asm volatile("s_waitcnt lgkmcnt(0)" ::: "memory");
    }
    __device__ __forceinline__ void khook(f32x4 (&acc)[2][2][4][2], int hb, int wr, int fr, LAS unsigned char* lx) const {
        int rb = wr * 64 + fr; asm volatile("" : "+v"(rb));
#pragma unroll
        for (int ai = 0; ai < 2; ++ai)
#pragma unroll
            for (int m = 0; m < 4; ++m) { const float f = ((const LAS float*)lx)[(ai * 128 + rb + m * 16) * 4 + hb];
#pragma unroll
                for (int bj = 0; bj < 2; ++bj)
#pragma unroll
                    for (int n = 0; n < 2; ++n) acc[ai][bj][m][n] = acc[ai][bj][m][n] * f; }
    }
    __device__ __forceinline__ void operator()(f32x4 (&acc)[2][2][4][2], const Unit& u, int wr, int wc, int fr, int fq, LAS unsigned char* lx) const {
        LAS float* P = (LAS float*)(lx + 4096);
        LAS float* Sr = (LAS float*)(lx + 9216);
        const int row0 = u.pm * 256 + wr * 64 + fr, col0 = u.pn * 256 + wc * 32 + 4 * fq, wid = wr * 4 + wc, b = (u.pm * 256) >> 11;
        const int lane = (int)__builtin_amdgcn_mbcnt_hi(~0u, __builtin_amdgcn_mbcnt_lo(~0u, 0u));
        const float* gp = gate + (size_t)b * 6144 + col0;
        int rb = wr * 64 + fr; asm volatile("" : "+v"(rb));
#pragma unroll
        for (int ai = 0; ai < 2; ++ai)
#pragma unroll
            for (int m = 0; m < 4; ++m) {
                const int row = row0 + ai * 128 + m * 16; const size_t off = (size_t)row * 1024 + col0;
                const float r3 = HEAD ? ((const LAS float*)lx)[(ai * 128 + rb + m * 16) * 4] : 1.0f;
                float ss = 0.f;
#pragma unroll
                for (int bj = 0; bj < 2; ++bj)
#pragma unroll
                    for (int n = 0; n < 2; ++n) { const int c = bj * 128 + n * 16; const f32x4 gv = *(const f32x4*)(gp + c), bs = *(const f32x4*)(base + off + c);
                        const f32x4 v = bs + gv * (HEAD ? acc[ai][bj][m][n] * r3 : acc[ai][bj][m][n]); acc[ai][bj][m][n] = v; *(f32x4*)(out + off + c) = v;
                        ss += (v[0] * v[0] + v[1] * v[1]) + (v[2] * v[2] + v[3] * v[3]); }
                ss += __shfl_xor(ss, 16); ss += __shfl_xor(ss, 32);
                if (fq == 0) P[(ai * 128 + rb + m * 16) * 4 + wc] = ss;
            }
        asm volatile("s_waitcnt lgkmcnt(0)" ::: "memory"); __builtin_amdgcn_s_barrier(); asm volatile("" ::: "memory");
        const int rl = wid * 32 + (lane & 31);
        if (lane < 32) { const f32x4 p = *(const LAS f32x4*)(P + rl * 4); const float sm = (p[0] + p[1]) + (p[2] + p[3]);
            __hip_atomic_store(slots + (size_t)(u.pm * 256 + rl) * 4 + u.pn, sm, __ATOMIC_RELAXED, __HIP_MEMORY_SCOPE_AGENT); }
        asm volatile("s_waitcnt vmcnt(0)" ::: "memory");
        if (lane == 0) __hip_atomic_fetch_add(cnt + 16 * u.pm, 1u, __ATOMIC_RELAXED, __HIP_MEMORY_SCOPE_AGENT);
        if (wid == 0) {
            unsigned sp = 0;
            while ((unsigned)__builtin_amdgcn_readfirstlane(__hip_atomic_load(cnt + 16 * u.pm, __ATOMIC_RELAXED, __HIP_MEMORY_SCOPE_AGENT)) < target) { __builtin_amdgcn_s_sleep(2); if (++sp > (1u << 16)) break; }
            __builtin_amdgcn_fence(__ATOMIC_ACQUIRE, "agent");
            asm volatile("s_waitcnt vmcnt(0)" ::: "memory");
        }
        asm volatile("s_waitcnt vmcnt(0) lgkmcnt(0)" ::: "memory"); __builtin_amdgcn_s_barrier(); asm volatile("" ::: "memory");
        if (lane < 32) { const float* sl = slots + (size_t)(u.pm * 256 + rl) * 4; float t = 0.f;
#pragma unroll
            for (int k = 0; k < 4; ++k) t += __hip_atomic_load(sl + k, __ATOMIC_RELAXED, __HIP_MEMORY_SCOPE_AGENT);
            Sr[rl] = 1.0f / sqrtf(t * (1.0f / DM) + EPS); }
        asm volatile("s_waitcnt vmcnt(0) lgkmcnt(0)" ::: "memory"); __builtin_amdgcn_s_barrier(); asm volatile("" ::: "memory");
#pragma unroll
        for (int ai = 0; ai < 2; ++ai)
#pragma unroll
            for (int m = 0; m < 4; ++m) {
                const int rloc = ai * 128 + rb + m * 16; const float ri = Sr[rloc]; const size_t off = (size_t)(u.pm * 256 + rloc) * 1024 + col0;
#pragma unroll
                for (int bj = 0; bj < 2; ++bj)
#pragma unroll
                    for (int n = 0; n < 2; ++n) { const int c = col0 + bj * 128 + n * 16; const f32x4 vr = acc[ai][bj][m][n] * ri;
#pragma unroll
                        for (int x = 0; x < NX; ++x) { const f32x4 g4 = *(const f32x4*)(no[x].gain + c), s4 = *(const f32x4*)(no[x].sc + (size_t)b * no[x].bstride + c), h4 = *(const f32x4*)(no[x].sh + (size_t)b * no[x].bstride + c);
                            const f32x4 h = vr * g4 * (s4 + 1.0f) + h4; u32x2 w; w.x = cvt_pk_bf16(h[0], h[1]); w.y = cvt_pk_bf16(h[2], h[3]); *(u32x2*)(no[x].dst + off + bj * 128 + n * 16) = w; } }
            }
    }
};
struct EpiResFinal {
    static constexpr bool PERM = false, KHOOK = false;
    const float* base; float* out; const float* gate; const float* gain; float* slots; unsigned* cnt; unsigned target;
    __device__ __forceinline__ void operator()(f32x4 (&acc)[2][2][4][2], const Unit& u, int wr, int wc, int fr, int fq, LAS unsigned char* lx) const {
        LAS float* P = (LAS float*)lx;
        LAS float* Sr = (LAS float*)(lx + 4096);
        const int row0 = u.pm * 256 + wr * 64 + fr, col0 = u.pn * 256 + wc * 32 + 4 * fq, wid = wr * 4 + wc;
        const int lane = (int)__builtin_amdgcn_mbcnt_hi(~0u, __builtin_amdgcn_mbcnt_lo(~0u, 0u));
#pragma unroll
        for (int ai = 0; ai < 2; ++ai)
#pragma unroll
            for (int m = 0; m < 4; ++m) {
                const int row = row0 + ai * 128 + m * 16; const float* gp = gate + (size_t)(row >> 11) * 6144 + col0; const size_t off = (size_t)row * 1024 + col0;
                float ss = 0.f;
#pragma unroll
                for (int bj = 0; bj < 2; ++bj)
#pragma unroll
                    for (int n = 0; n < 2; ++n) { const int c = bj * 128 + n * 16; const f32x4 gv = *(const f32x4*)(gp + c), bs = *(const f32x4*)(base + off + c);
                        const f32x4 v = bs + gv * acc[ai][bj][m][n]; acc[ai][bj][m][n] = v; ss += (v[0] * v[0] + v[1] * v[1]) + (v[2] * v[2] + v[3] * v[3]); }
                ss += __shfl_xor(ss, 16); ss += __shfl_xor(ss, 32);
                if (fq == 0) P[(ai * 128 + wr * 64 + m * 16 + fr) * 4 + wc] = ss;
            }
        asm volatile("s_waitcnt lgkmcnt(0)" ::: "memory"); __builtin_amdgcn_s_barrier(); asm volatile("" ::: "memory");
        const int rl = wid * 32 + (lane & 31);
        if (lane < 32) { const f32x4 p = *(const LAS f32x4*)(P + rl * 4); const float sm = (p[0] + p[1]) + (p[2] + p[3]);
            __hip_atomic_store(slots + (size_t)(u.pm * 256 + rl) * 4 + u.pn, sm, __ATOMIC_RELAXED, __HIP_MEMORY_SCOPE_AGENT); }
        asm volatile("s_waitcnt vmcnt(0)" ::: "memory");
        if (lane == 0) __hip_atomic_fetch_add(cnt + 16 * u.pm, 1u, __ATOMIC_RELAXED, __HIP_MEMORY_SCOPE_AGENT);
        if (wid == 0) {
            unsigned sp = 0;
            while ((unsigned)__builtin_amdgcn_readfirstlane(__hip_atomic_load(cnt + 16 * u.pm, __ATOMIC_RELAXED, __HIP_MEMORY_SCOPE_AGENT)) < target) { __builtin_amdgcn_s_sleep(2); if (++sp > (1u << 16)) break; }
            __builtin_amdgcn_fence(__ATOMIC_ACQUIRE, "agent");
            asm volatile("s_waitcnt vmcnt(0)" ::: "memory");
        }
        asm volatile("s_waitcnt vmcnt(0) lgkmcnt(0)" ::: "memory"); __builtin_amdgcn_s_barrier(); asm volatile("" ::: "memory");
        if (lane < 32) { const float* sl = slots + (size_t)(u.pm * 256 + rl) * 4; float t = 0.f;
#pragma unroll
            for (int k = 0; k < 4; ++k) t += __hip_atomic_load(sl + k, __ATOMIC_RELAXED, __HIP_MEMORY_SCOPE_AGENT);
            Sr[rl] = 1.0f / sqrtf(t * (1.0f / DM) + EPS); }
        asm volatile("s_waitcnt vmcnt(0) lgkmcnt(0)" ::: "memory"); __builtin_amdgcn_s_barrier(); asm volatile("" ::: "memory");
#pragma unroll
        for (int ai = 0; ai < 2; ++ai)
#pragma unroll
            for (int m = 0; m < 4; ++m) {
                const int rloc = ai * 128 + wr * 64 + m * 16 + fr; const float ri = Sr[rloc]; const size_t off = (size_t)(u.pm * 256 + rloc) * 1024 + col0;
#pragma unroll
                for (int bj = 0; bj < 2; ++bj)
#pragma unroll
                    for (int n = 0; n < 2; ++n) { const int c = bj * 128 + n * 16; __builtin_nontemporal_store(acc[ai][bj][m][n] * ri * *(const f32x4*)(gain + col0 + c), (f32x4*)(out + off + c)); }
            }
    }
};
struct EpiRope {
    static constexpr bool PERM = true, KHOOK = false;
    bf16_t* dstR; bf16_t* dstV; int nrope; const float* tab; float scale;
    __device__ __forceinline__ void operator()(const f32x4 (&acc)[2][2][4][2], const Unit& u, int wr, int wc, int fr, int fq, LAS unsigned char*) const {
        const int row0 = u.pm * 256 + wr * 64 + fr, cw = wc * 32 + 8 * fq;
        if (u.pn < nrope) {
            const int p = cw >> 6, dd = cw & 63;
            bf16_t* dst = dstR + u.pn * 256 + p * 128 + dd;
#pragma unroll
            for (int ai = 0; ai < 2; ++ai)
#pragma unroll
                for (int m = 0; m < 4; ++m) {
                    const int row = row0 + ai * 128 + m * 16, pos = row & 2047;
                    const f32x4* tp = (const f32x4*)(tab + ((size_t)pos * 64 + dd) * 2);
                    const f32x4 t0 = tp[0], t1 = tp[1], t2 = tp[2], t3 = tp[3];
                    const f32x4 cs0 = {t0[0], t0[2], t1[0], t1[2]}, sn0 = {t0[1], t0[3], t1[1], t1[3]}, cs1 = {t2[0], t2[2], t3[0], t3[2]}, sn1 = {t2[1], t2[3], t3[1], t3[3]};
                    const f32x4 x10 = acc[ai][0][m][0], x11 = acc[ai][0][m][1], x20 = acc[ai][1][m][0], x21 = acc[ai][1][m][1];
                    const f32x4 o10 = (x10 * cs0 - x20 * sn0) * scale, o11 = (x11 * cs1 - x21 * sn1) * scale;
                    const f32x4 o20 = (x20 * cs0 + x10 * sn0) * scale, o21 = (x21 * cs1 + x11 * sn1) * scale;
                    bf16_t* rp = dst + (size_t)row * 1024;
                    *(u32x4*)rp = pack8(o10, o11); *(u32x4*)(rp + 64) = pack8(o20, o21);
                }
        } else {
            bf16_t* dst = dstV + (u.pn - nrope) * 256 + cw;
#pragma unroll
            for (int ai = 0; ai < 2; ++ai)
#pragma unroll
                for (int m = 0; m < 4; ++m) {
                    bf16_t* rp = dst + (size_t)(row0 + ai * 128 + m * 16) * 1024;
#pragma unroll
                    for (int bj = 0; bj < 2; ++bj) *(u32x4*)(rp + bj * 128) = pack8(acc[ai][bj][m][0], acc[ai][bj][m][1]);
                }
        }
    }
};
__device__ __forceinline__ float dpp_shr1(float v) { return __builtin_bit_cast(float, __builtin_amdgcn_update_dpp(0, __builtin_bit_cast(int, v), 0x111, 0xf, 0xf, true)); }
__device__ __forceinline__ float dpp_shr2(float v) { return __builtin_bit_cast(float, __builtin_amdgcn_update_dpp(0, __builtin_bit_cast(int, v), 0x112, 0xf, 0xf, true)); }
__device__ __forceinline__ float dpp_ror1(float v) { return __builtin_bit_cast(float, __builtin_amdgcn_update_dpp(0, __builtin_bit_cast(int, v), 0x121, 0xf, 0xf, false)); }
__device__ __forceinline__ float dpp_ror2(float v) { return __builtin_bit_cast(float, __builtin_amdgcn_update_dpp(0, __builtin_bit_cast(int, v), 0x122, 0xf, 0xf, false)); }
struct EpiFfn {
    static constexpr bool PERM = true, KHOOK = false;
    bf16_t* U; const float* wconv; const float* bconv;
    __device__ __forceinline__ void operator()(const f32x4 (&acc)[2][2][4][2], const Unit& u, int wr, int wc, int fr, int fq, LAS unsigned char* lx) const {
        const int cw = wc * 32 + 8 * fq, j0 = u.pn * 128 + cw;
        f32x4 w0[2], w1[2], w2[2], bc[2];
#pragma unroll
        for (int n = 0; n < 2; ++n) { w0[n] = *(const f32x4*)(wconv + j0 + 4 * n); w1[n] = *(const f32x4*)(wconv + DFF + j0 + 4 * n); w2[n] = *(const f32x4*)(wconv + 2 * DFF + j0 + 4 * n); bc[n] = *(const f32x4*)(bconv + j0 + 4 * n); }
        LAS float* hx = (LAS float*)lx;
        if (fr >= 14) {
#pragma unroll
            for (int ai = 0; ai < 2; ++ai) { LAS float* p = hx + ((((2 * ai + wr) * 4 + wc) * 2 + (fr - 14)) * 4 + fq) * 8;
                *(LAS f32x4*)p = acc[ai][0][3][0]; *(LAS f32x4*)(p + 4) = acc[ai][0][3][1]; }
        }
        asm volatile("s_waitcnt lgkmcnt(0)" ::: "memory"); __builtin_amdgcn_s_barrier(); asm volatile("" ::: "memory");
        const int rr = fr >= 14 ? fr - 14 : 0;
#pragma unroll
        for (int ai = 0; ai < 2; ++ai) {
            const int qc = 2 * ai + wr;
            f32x4 pv[2] = {(f32x4){0.f, 0.f, 0.f, 0.f}, (f32x4){0.f, 0.f, 0.f, 0.f}};
            if (qc >= 1) { const LAS float* p = hx + (((((qc - 1) * 4 + wc) * 2 + rr) * 4 + fq) * 8); pv[0] = *(const LAS f32x4*)p; pv[1] = *(const LAS f32x4*)(p + 4); }
#pragma unroll
            for (int m = 0; m < 4; ++m) {
                const int trow = ai * 128 + wr * 64 + m * 16 + fr, grow = u.pm * 254 - 2 + trow, pos = grow & 2047;
                f32x4 res[2];
#pragma unroll
                for (int n = 0; n < 2; ++n) {
                    const f32x4 cur = acc[ai][0][m][n], gg = acc[ai][1][m][n];
                    f32x4 cv;
#pragma unroll
                    for (int j = 0; j < 4; ++j) {
                        const float s1 = dpp_shr1(cur[j]), r1 = dpp_ror1(pv[n][j]), s2 = dpp_shr2(cur[j]), r2 = dpp_ror2(pv[n][j]);
                        float a1 = fr >= 1 ? s1 : r1, a2 = fr >= 2 ? s2 : r2;
                        a1 = pos < 1 ? 0.f : a1; a2 = pos < 2 ? 0.f : a2;
                        cv[j] = w0[n][j] * a2 + w1[n][j] * a1 + w2[n][j] * cur[j] + bc[n][j];
                    }
                    const f32x2 ga = gelu_pk((f32x2){cv[0], cv[1]}), gb = gelu_pk((f32x2){cv[2], cv[3]});
                    res[n] = (f32x4){ga.x * gg[0], ga.y * gg[1], gb.x * gg[2], gb.y * gg[3]};
                    pv[n] = cur;
                }
                if (trow >= 2 && grow < TOK) *(u32x4*)(U + (size_t)grow * DFF + j0) = pack8(res[0], res[1]);
            }
        }
    }
};

__device__ __forceinline__ int rowmap(int kind, int n) {
    if (kind == 0) return n;
    if (kind == 1) { const int half = n >= DFF ? 1 : 0, j = n - half * DFF; return (j >> 7) * 256 + half * 128 + (j & 127); }
    const int h = n >> 8, p = (n >> 7) & 1, d = n & 127; return h * 256 + (d >> 6) * 128 + p * 64 + (d & 63);
}
__device__ __forceinline__ void transpose_item(const float* W, int ldw, int col0, int ncols, int K, bf16_t* WT, int kind, int row_off, LAS float* scr, int item, int lane) {
    const int nblk = ncols / 32, kb = item / nblk, nb = item % nblk, k0 = 64 * kb, n0 = 32 * nb;
    f32x4 v[8];
#pragma unroll
    for (int i = 0; i < 8; ++i) v[i] = *(const f32x4*)(W + (size_t)(k0 + 8 * i + (lane >> 3)) * ldw + col0 + n0 + 4 * (lane & 7));
#pragma unroll
    for (int i = 0; i < 8; ++i) { LAS float* d = scr + (8 * i + (lane >> 3)) * 33 + 4 * (lane & 7); d[0] = v[i][0]; d[1] = v[i][1]; d[2] = v[i][2]; d[3] = v[i][3]; }
    asm volatile("s_waitcnt lgkmcnt(0)" ::: "memory");
    const int c = lane & 7;
#pragma unroll
    for (int j = 0; j < 4; ++j) { const int n = (lane >> 3) + 8 * j; const LAS float* s = scr + (8 * c) * 33 + n;
        u32x4 o; o.x = cvt_pk_bf16(s[0 * 33], s[1 * 33]); o.y = cvt_pk_bf16(s[2 * 33], s[3 * 33]); o.z = cvt_pk_bf16(s[4 * 33], s[5 * 33]); o.w = cvt_pk_bf16(s[6 * 33], s[7 * 33]);
        *(u32x4*)(WT + (size_t)(row_off + rowmap(kind, n0 + n)) * K + k0 + 8 * c) = o; }
    asm volatile("s_waitcnt lgkmcnt(0)" ::: "memory");
}
__device__ __forceinline__ void mods_item(const float* c, const float* W, int N, int strip, int kc, LAS float* scr, LAS float* red, int lane) {
    const int k0 = kc * 128, n0 = strip * 64;
#pragma unroll
    for (int i = 0; i < 16; ++i) { const int idx = lane + 64 * i, b = idx >> 7, kk = idx & 127; scr[kk * 8 + b] = silu_f(c[b * 1024 + k0 + kk]); }
    asm volatile("s_waitcnt lgkmcnt(0)" ::: "memory");
    float a0 = 0.f, a1 = 0.f, a2 = 0.f, a3 = 0.f, a4 = 0.f, a5 = 0.f, a6 = 0.f, a7 = 0.f;
#pragma unroll 32
    for (int kk = 0; kk < 128; ++kk) {
        const float wv = __builtin_nontemporal_load(W + (size_t)(k0 + kk) * N + n0 + lane);
        const f32x4 s0 = *(const LAS f32x4*)(scr + kk * 8), s1 = *(const LAS f32x4*)(scr + kk * 8 + 4);
        a0 += s0[0] * wv; a1 += s0[1] * wv; a2 += s0[2] * wv; a3 += s0[3] * wv; a4 += s1[0] * wv; a5 += s1[1] * wv; a6 += s1[2] * wv; a7 += s1[3] * wv;
    }
    red[0 * 64 + lane] = a0; red[1 * 64 + lane] = a1; red[2 * 64 + lane] = a2; red[3 * 64 + lane] = a3;
    red[4 * 64 + lane] = a4; red[5 * 64 + lane] = a5; red[6 * 64 + lane] = a6; red[7 * 64 + lane] = a7;
}
__device__ __forceinline__ void sincos_acc(float ang, float& s, float& c) {
    const double x = (double)ang;
    const double k = __builtin_rint(x * 0.6366197723675814);
    double y = __builtin_fma(-k, 1.5707963267948966, x); y = __builtin_fma(-k, 6.123233995736766e-17, y);
    const int q = ((int)k) & 3;
    const double y2 = y * y;
    const double sp = y * (1.0 + y2 * (-1.0 / 6.0 + y2 * (1.0 / 120.0 + y2 * (-1.0 / 5040.0 + y2 * (1.0 / 362880.0 + y2 * (-1.0 / 39916800.0 + y2 * (1.0 / 6227020800.0)))))));
    const double cp = 1.0 + y2 * (-0.5 + y2 * (1.0 / 24.0 + y2 * (-1.0 / 720.0 + y2 * (1.0 / 40320.0 + y2 * (-1.0 / 3628800.0 + y2 * (1.0 / 479001600.0))))));
    const double ss = (q == 0) ? sp : (q == 1) ? cp : (q == 2) ? -sp : -cp;
    const double cc = (q == 0) ? cp : (q == 1) ? -sp : (q == 2) ? -cp : sp;
    s = (float)ss; c = (float)cc;
}

struct Args { const float* in[20]; float* out; unsigned char* ws; int ph_lo, ph_hi; };

template <int PART> __device__ __forceinline__ void p0_prologue(const Args& a, LAS unsigned char* lds, int wave, int lane, int G) {
    LAS float* scr = (LAS float*)(lds + wave * 16384);
    const int gw = blockIdx.x * 8 + wave, NGW = G * 8;
    unsigned char* ws = a.ws;
    if (PART == 0) {
    for (int strip = blockIdx.x; strip < 224; strip += G) {
        LAS float* red = (LAS float*)(lds + wave * 16384 + 8192);
        const float* W; const float* bias; float* out; int N, st;
        if (strip < 96) { W = a.in[3]; bias = a.in[4]; out = (float*)(ws + WS_MOD0); N = 6144; st = strip; }
        else if (strip < 192) { W = a.in[3] + (size_t)1024 * 6144; bias = a.in[4] + 6144; out = (float*)(ws + WS_MOD1); N = 6144; st = strip - 96; }
        else { W = a.in[12]; bias = a.in[13]; out = (float*)(ws + WS_KVMOD); N = 2048; st = strip - 192; }
        mods_item(a.in[1], W, N, st, wave, scr, red, lane);
        __syncthreads();
        { float sum = bias[st * 64 + lane];
#pragma unroll
          for (int kc = 0; kc < 8; ++kc) sum += ((const LAS float*)(lds + kc * 16384 + 8192))[wave * 64 + lane];
          out[(size_t)wave * N + st * 64 + lane] = sum; }
        __syncthreads();
    }
    }
    if (PART == 1) {
    {
        constexpr int T_RIN = (1024 / 128) * (6144 / 64), T_ROUT = (2048 / 128) * (1024 / 64), T_FIN = (1024 / 128) * (NFF / 64), T_FDN = (DFF / 128) * (1024 / 64), T_SQ = (1024 / 128) * (1024 / 64);
        constexpr int NTILES = T_RIN + T_ROUT + 2 * T_FIN + 2 * T_FDN + 4 * T_SQ;
        struct TrJob { const float* W; int ldw, col0, ncols, K; bf16_t* WT; int kind, row_off, item; };
        auto decode = [&](int it) -> TrJob {
            int r = it;
            if (r < T_RIN) return TrJob{a.in[5], 6144, 0, 6144, 1024, (bf16_t*)(ws + WS_WRIN), 0, 0, r}; r -= T_RIN;
            if (r < T_ROUT) return TrJob{a.in[6], 1024, 0, 1024, 2048, (bf16_t*)(ws + WS_WROUT), 0, 0, r}; r -= T_ROUT;
            if (r < T_FIN) return TrJob{a.in[7], NFF, 0, NFF, 1024, (bf16_t*)(ws + WS_WFIN0), 1, 0, r}; r -= T_FIN;
            if (r < T_FIN) return TrJob{a.in[7] + (size_t)1024 * NFF, NFF, 0, NFF, 1024, (bf16_t*)(ws + WS_WFIN1), 1, 0, r}; r -= T_FIN;
            if (r < T_FDN) return TrJob{a.in[10], 1024, 0, 1024, DFF, (bf16_t*)(ws + WS_WFDN0), 0, 0, r}; r -= T_FDN;
            if (r < T_FDN) return TrJob{a.in[10] + (size_t)DFF * 1024, 1024, 0, 1024, DFF, (bf16_t*)(ws + WS_WFDN1), 0, 0, r}; r -= T_FDN;
            if (r < T_SQ) return TrJob{a.in[14], 2048, 0, 1024, 1024, (bf16_t*)(ws + WS_WKV), 2, 0, r}; r -= T_SQ;
            if (r < T_SQ) return TrJob{a.in[14], 2048, 1024, 1024, 1024, (bf16_t*)(ws + WS_WKV), 0, 1024, r}; r -= T_SQ;
            if (r < T_SQ) return TrJob{a.in[15], 1024, 0, 1024, 1024, (bf16_t*)(ws + WS_WQ), 2, 0, r}; r -= T_SQ;
            return TrJob{a.in[18], 1024, 0, 1024, 1024, (bf16_t*)(ws + WS_WO), 0, 0, r};
        };
        const int tid = threadIdx.x, c4 = tid & 15, rp = tid >> 4;
        f32x4 v[4];
        int it = blockIdx.x;
        TrJob cur = decode(it < NTILES ? it : 0);
#define TR_LOAD(j_) do { const int nblk_ = (j_).ncols / 64, k0_ = 128 * ((j_).item / nblk_), n0_ = 64 * ((j_).item % nblk_); \
        _Pragma("unroll") for (int i = 0; i < 2; ++i) { const float* p_ = (j_).W + (size_t)(k0_ + 2 * (32 * i + rp)) * (j_).ldw + (j_).col0 + n0_ + 4 * c4; v[2 * i] = __builtin_nontemporal_load((const f32x4*)p_); v[2 * i + 1] = __builtin_nontemporal_load((const f32x4*)(p_ + (j_).ldw)); } } while (0)
        if (it < NTILES) TR_LOAD(cur);
        int buf = 0;
        for (; it < NTILES; it += G) {
            LAS unsigned* tile = (LAS unsigned*)(lds + buf * 16896);
#pragma unroll
            for (int i = 0; i < 2; ++i) { LAS unsigned* d = tile + (32 * i + rp) * 65 + 4 * c4;
                d[0] = cvt_pk_bf16(v[2 * i][0], v[2 * i + 1][0]); d[1] = cvt_pk_bf16(v[2 * i][1], v[2 * i + 1][1]); d[2] = cvt_pk_bf16(v[2 * i][2], v[2 * i + 1][2]); d[3] = cvt_pk_bf16(v[2 * i][3], v[2 * i + 1][3]); }
            __syncthreads();
            const TrJob job = cur;
            if (it + G < NTILES) { cur = decode(it + G); TR_LOAD(cur); }
            { const int nblk = job.ncols / 64, k0 = 128 * (job.item / nblk), n0 = 64 * (job.item % nblk);
#pragma unroll
              for (int p = 0; p < 2; ++p) { const int n = 32 * p + rp; const LAS unsigned* sp = tile + (4 * c4) * 65 + n;
                  u32x4 o; o.x = sp[0]; o.y = sp[65]; o.z = sp[130]; o.w = sp[195];
                  __builtin_nontemporal_store(o, (u32x4*)(job.WT + (size_t)(job.row_off + rowmap(job.kind, n0 + n)) * job.K + k0 + 8 * c4)); } }
            buf ^= 1;
        }
#undef TR_LOAD
        __syncthreads();
    }
    const int gt = blockIdx.x * 512 + threadIdx.x, NGT = G * 512;
    f32x2* tabR = (f32x2*)(ws + WS_TABR); f32x2* tabD = (f32x2*)(ws + WS_TABD);
    for (int i = gt; i < 2048 * 128; i += NGT) { const int pos = i >> 7, f = i & 127; const float fr = exp2f(-13.287712379549449f * ((float)f / 127.0f)); float s, c; sincos_acc((float)pos * fr, s, c); tabR[i] = (f32x2){c, s}; }
    for (int i = gt; i < 2048 * 64; i += NGT) { const int pos = i >> 6, f = i & 63; const float fr = exp2f(-13.287712379549449f * ((float)f / 64.0f)); float s, c; sincos_acc((float)pos * fr, s, c); tabD[i] = (f32x2){c, s}; }
    }
    if (PART == 0 && gw == 0) {
        const float* lv = a.in[16];
        float d0 = lv[lane] * lv[128 + lane] + lv[64 + lane] * lv[128 + 64 + lane];
        float d1 = lv[256 + lane] * lv[384 + lane] + lv[256 + 64 + lane] * lv[384 + 64 + lane];
        d0 = wave_sum(d0); d1 = wave_sum(d1);
        const float lam_init = 0.8f - 0.6f * expf(-0.3f);
        if (lane == 0) { float* lp = (float*)(ws + WS_LAM); lp[0] = expf(d0) - expf(d1) + lam_init; lp[1] = 1.0f - lam_init; }
    }
}

struct NM { const float* gain; const float* sh; const float* sc; int bstride; bf16_t* dst; };
constexpr int RW = 4;
template <bool TWO>
__device__ __forceinline__ void normmod_phase(const float* src, const NM A, const NM Bq, int gw, int NGW, int lane) {
    for (int row = gw; row < TOK; row += RW * NGW) {
        f32x4 v[RW][4]; float rinv[RW];
#pragma unroll
        for (int r = 0; r < RW; ++r) { const int rw = row + r * NGW < TOK ? row + r * NGW : row; const f32x4* xr = (const f32x4*)(src + (size_t)rw * DM) + lane;
#pragma unroll
            for (int j = 0; j < 4; ++j) v[r][j] = xr[64 * j]; }
#pragma unroll
        for (int r = 0; r < RW; ++r) { float ss = 0.f;
#pragma unroll
            for (int j = 0; j < 4; ++j) ss += (v[r][j][0] * v[r][j][0] + v[r][j][1] * v[r][j][1]) + (v[r][j][2] * v[r][j][2] + v[r][j][3] * v[r][j][3]);
            rinv[r] = 1.0f / sqrtf(wave_sum(ss) * (1.0f / DM) + EPS); }
#pragma unroll
        for (int r = 0; r < RW; ++r) {
            const int rw = row + r * NGW; if (rw >= TOK) break;
            const int b = rw >> 11;
#pragma unroll
            for (int j = 0; j < 4; ++j) {
                const int k0 = 256 * j + 4 * lane;
                { const f32x4 g = *(const f32x4*)(A.gain + k0), sc = *(const f32x4*)(A.sc + (size_t)b * A.bstride + k0), sh = *(const f32x4*)(A.sh + (size_t)b * A.bstride + k0);
                  const f32x4 o = v[r][j] * rinv[r] * g * (sc + 1.0f) + sh; u32x2 w; w.x = cvt_pk_bf16(o[0], o[1]); w.y = cvt_pk_bf16(o[2], o[3]); *(u32x2*)(A.dst + (size_t)rw * DM + k0) = w; }
                if (TWO) { const f32x4 g = *(const f32x4*)(Bq.gain + k0), sc = *(const f32x4*)(Bq.sc + (size_t)b * Bq.bstride + k0), sh = *(const f32x4*)(Bq.sh + (size_t)b * Bq.bstride + k0);
                  const f32x4 o = v[r][j] * rinv[r] * g * (sc + 1.0f) + sh; u32x2 w; w.x = cvt_pk_bf16(o[0], o[1]); w.y = cvt_pk_bf16(o[2], o[3]); *(u32x2*)(Bq.dst + (size_t)rw * DM + k0) = w; }
            }
        }
    }
}
__device__ __forceinline__ void gate_phase(const bf16_t* O, const bf16_t* Gt, bf16_t* Y, int gw, int NGW, int lane) {
    for (int idx0 = gw; idx0 < TOK * 4; idx0 += RW * NGW) {
        u32x4 ov[RW], gv[RW];
#pragma unroll
        for (int r = 0; r < RW; ++r) { const int ix = idx0 + r * NGW < TOK * 4 ? idx0 + r * NGW : idx0; const size_t off = (size_t)ix * 512 + 8 * lane; ov[r] = *(const u32x4*)(O + off); gv[r] = *(const u32x4*)(Gt + off); }
#pragma unroll
        for (int r = 0; r < RW; ++r) {
            const int ix = idx0 + r * NGW; if (ix >= TOK * 4) break;
            float o[8], g[8];
            o[0] = bf_lo(ov[r].x); o[1] = bf_hi(ov[r].x); o[2] = bf_lo(ov[r].y); o[3] = bf_hi(ov[r].y); o[4] = bf_lo(ov[r].z); o[5] = bf_hi(ov[r].z); o[6] = bf_lo(ov[r].w); o[7] = bf_hi(ov[r].w);
            g[0] = bf_lo(gv[r].x); g[1] = bf_hi(gv[r].x); g[2] = bf_lo(gv[r].y); g[3] = bf_hi(gv[r].y); g[4] = bf_lo(gv[r].z); g[5] = bf_hi(gv[r].z); g[6] = bf_lo(gv[r].w); g[7] = bf_hi(gv[r].w);
            float ss = 0.f;
#pragma unroll
            for (int i = 0; i < 8; ++i) ss += o[i] * o[i];
            const float rinv = 1.0f / sqrtf(wave_sum(ss) * (1.0f / 512.0f) + EPS);
            float y[8];
#pragma unroll
            for (int i = 0; i < 8; ++i) y[i] = silu_f(g[i]) * o[i] * rinv;
            u32x4 w; w.x = cvt_pk_bf16(y[0], y[1]); w.y = cvt_pk_bf16(y[2], y[3]); w.z = cvt_pk_bf16(y[4], y[5]); w.w = cvt_pk_bf16(y[6], y[7]);
            *(u32x4*)(Y + (size_t)ix * 512 + 8 * lane) = w;
        }
    }
}
__device__ __forceinline__ void combine_phase(const bf16_t* O0, const bf16_t* O1, bf16_t* Od, const float* gain, const float* lamp, int gw, int NGW, int lane) {
    const float lam = lamp[0], oml = lamp[1];
    const f32x4 gn = *(const f32x4*)(gain + 4 * lane);
    for (int idx0 = gw; idx0 < TOK * 4; idx0 += RW * NGW) {
        u32x2 av[RW], bv[RW];
#pragma unroll
        for (int r = 0; r < RW; ++r) { const int ix = idx0 + r * NGW < TOK * 4 ? idx0 + r * NGW : idx0; const size_t off = (size_t)ix * 256 + 4 * lane; av[r] = *(const u32x2*)(O0 + off); bv[r] = *(const u32x2*)(O1 + off); }
#pragma unroll
        for (int r = 0; r < RW; ++r) {
            const int ix = idx0 + r * NGW; if (ix >= TOK * 4) break;
            const u32x2 a = av[r], b = bv[r];
            f32x4 o = {bf_lo(a.x) - lam * bf_lo(b.x), bf_hi(a.x) - lam * bf_hi(b.x), bf_lo(a.y) - lam * bf_lo(b.y), bf_hi(a.y) - lam * bf_hi(b.y)};
            const float ss = (o[0] * o[0] + o[1] * o[1]) + (o[2] * o[2] + o[3] * o[3]);
            const float rinv = 1.0f / sqrtf(wave_sum(ss) * (1.0f / 256.0f) + EPS);
            o = o * (rinv * oml) * gn;
            u32x2 w; w.x = cvt_pk_bf16(o[0], o[1]); w.y = cvt_pk_bf16(o[2], o[3]); *(u32x2*)(Od + (size_t)ix * 256 + 4 * lane) = w;
        }
    }
}
__device__ __forceinline__ void final_norm_phase(float* X, const float* gain, int gw, int NGW, int lane) {
    for (int row = gw; row < TOK; row += RW * NGW) {
        f32x4 v[RW][4]; float rinv[RW];
#pragma unroll
        for (int r = 0; r < RW; ++r) { const int rw = row + r * NGW < TOK ? row + r * NGW : row; const f32x4* xr = (const f32x4*)(X + (size_t)rw * DM) + lane;
#pragma unroll
            for (int j = 0; j < 4; ++j) v[r][j] = xr[64 * j]; }
#pragma unroll
        for (int r = 0; r < RW; ++r) { float ss = 0.f;
#pragma unroll
            for (int j = 0; j < 4; ++j) ss += (v[r][j][0] * v[r][j][0] + v[r][j][1] * v[r][j][1]) + (v[r][j][2] * v[r][j][2] + v[r][j][3] * v[r][j][3]);
            rinv[r] = 1.0f / sqrtf(wave_sum(ss) * (1.0f / DM) + EPS); }
#pragma unroll
        for (int r = 0; r < RW; ++r) {
            const int rw = row + r * NGW; if (rw >= TOK) break;
            f32x4* xw = (f32x4*)(X + (size_t)rw * DM) + lane;
#pragma unroll
            for (int j = 0; j < 4; ++j) __builtin_nontemporal_store(v[r][j] * rinv[r] * *(const f32x4*)(gain + 256 * j + 4 * lane), xw + 64 * j);
        }
    }
}

__device__ __forceinline__ void retention_phase(LAS unsigned char* lds, const bf16_t* Q, const bf16_t* K, bf16_t* V, const bf16_t* Gt, float* ssqb, int G) {
    const int tid = threadIdx.x, lane = tid & 63, w = __builtin_amdgcn_readfirstlane(tid >> 6), li = lane & 15, fq = lane >> 4, q4 = li >> 2, p4 = li & 3;
    constexpr int KS = 528, VS = 144, SS = 528;
    LAS unsigned char* Ks = lds; LAS unsigned char* Vs = lds + 128 * KS; LAS unsigned char* StT = Vs + 128 * VS;
    const int bx = blockIdx.x; const int vcu = (G % 8 == 0) ? (bx % 8) * (G / 8) + bx / 8 : bx;
    for (int item = vcu; item < 256; item += G) {
        const int bh = item >> 3, sl = item & 7, b = bh >> 2, h = bh & 3;
        const float gam = 1.0f - exp2f(-5.0f - (float)h);
        float g128 = gam;
#pragma unroll
        for (int i = 0; i < 7; ++i) g128 *= g128;
        const float g127 = g128 / gam;
        const bf16_t* Qb = Q + (size_t)b * SEQ * 1024 + h * 256;
        const bf16_t* Kb = K + (size_t)b * SEQ * 1024 + h * 256;
        const bf16_t* Vb = V + (size_t)b * SEQ * 2048 + h * 512 + sl * 64;
        bf16_t* Ob = V + (size_t)b * SEQ * 2048 + h * 512 + sl * 64;
        const bf16_t* Gb = Gt + (size_t)b * SEQ * 2048 + h * 512 + sl * 64;
        __syncthreads();
        for (int i = tid; i < 64 * SS / 16; i += 512) *(LAS u32x4*)(StT + i * 16) = (u32x4){0u, 0u, 0u, 0u};
        f32x4 St[2][4];
#pragma unroll
        for (int mt = 0; mt < 2; ++mt)
#pragma unroll
            for (int nt = 0; nt < 4; ++nt) St[mt][nt] = (f32x4){0.f, 0.f, 0.f, 0.f};
        u32x4 kreg[8], vreg[2]; bf16x8 Qf[8];
        const unsigned voK = (unsigned)((tid >> 5) * 1024 + (tid & 31) * 8) * 2u, voV = (unsigned)((tid >> 3) * 2048 + (tid & 7) * 8) * 2u, voQ = (unsigned)(li * 1024 + 8 * fq) * 2u;
#define RET_LOAD_KV(t0_) do { \
        _Pragma("unroll") for (int i = 0; i < 8; ++i) kreg[i] = *(const u32x4*)((const char*)Kb + (size_t)((t0_) + 16 * i) * 2048 + voK); \
        _Pragma("unroll") for (int i = 0; i < 2; ++i) vreg[i] = *(const u32x4*)((const char*)Vb + (size_t)((t0_) + 64 * i) * 4096 + voV); } while (0)
#define RET_LOAD_Q(t0_) do { _Pragma("unroll") for (int ks = 0; ks < 8; ++ks) Qf[ks] = *(const bf16x8*)((const char*)Qb + (size_t)((t0_) + 16 * w) * 2048 + ks * 64 + voQ); } while (0)
#define RET_WRITE_KV() do { \
        _Pragma("unroll") for (int i = 0; i < 8; ++i) { const int id = tid + 512 * i, r = id >> 5, pc = id & 31; *(LAS u32x4*)(Ks + r * KS + pc * 16) = kreg[i]; } \
        _Pragma("unroll") for (int i = 0; i < 2; ++i) { const int id = tid + 512 * i, r = id >> 3, pc = id & 7; *(LAS u32x4*)(Vs + r * VS + pc * 16) = vreg[i]; } } while (0)
        RET_LOAD_KV(0); RET_LOAD_Q(0);
        RET_WRITE_KV();
        __syncthreads();
#pragma nounroll
        for (int n = 0; n < 16; ++n) {
            const int t0 = n * 128;
            if (n + 1 < 16) RET_LOAD_KV(t0 + 128);
            u32x2 greg[4];
#pragma unroll
            for (int nt = 0; nt < 4; ++nt) greg[nt] = *(const u32x2*)(Gb + (size_t)(t0 + 16 * w + li) * 2048 + 16 * nt + 4 * fq);
            f32x4 accS[8];
#pragma unroll
            for (int kt = 0; kt < 8; ++kt) {
                accS[kt] = (f32x4){0.f, 0.f, 0.f, 0.f};
                if (kt <= w) {
#pragma unroll
                    for (int ks = 0; ks < 8; ++ks) accS[kt] = MFMA16(lds_b128(Ks + (16 * kt + li) * KS + (32 * ks + 8 * fq) * 2), Qf[ks], accS[kt]);
                    __builtin_amdgcn_sched_barrier(0);
                    if (kt == w) {
#pragma unroll
                        for (int r = 0; r < 4; ++r) if (4 * fq + r > li) accS[kt][r] = 0.f;
                    }
                }
            }
            bf16x8 P[4];
#pragma unroll
            for (int s = 0; s < 4; ++s) P[s] = pack_frag(accS[2 * s], accS[2 * s + 1]);
            f32x4 o1[4], o2[4];
#pragma unroll
            for (int nt = 0; nt < 4; ++nt) { o1[nt] = (f32x4){0.f, 0.f, 0.f, 0.f}; o2[nt] = (f32x4){0.f, 0.f, 0.f, 0.f}; }
#pragma unroll
            for (int s = 0; s < 4; ++s) {
                if (2 * s <= w) {
#pragma unroll
                    for (int nt = 0; nt < 4; ++nt) {
                        const bf16x8 av = cat4(lds_tr(Vs + (32 * s + 4 * fq + q4) * VS + (16 * nt + 4 * p4) * 2), lds_tr(Vs + (32 * s + 16 + 4 * fq + q4) * VS + (16 * nt + 4 * p4) * 2));
                        o1[nt] = MFMA16(av, P[s], o1[nt]);
                    }
                }
            }
#pragma unroll
            for (int ks = 0; ks < 8; ++ks)
#pragma unroll
                for (int nt = 0; nt < 4; ++nt) { o2[nt] = MFMA16(lds_b128(StT + (16 * nt + li) * SS + (32 * ks + 8 * fq) * 2), Qf[ks], o2[nt]); if (nt == 3 && (ks & 1)) __builtin_amdgcn_sched_barrier(0); }
            {
                bf16_t* op = Ob + (size_t)(t0 + 16 * w + li) * 2048 + 4 * fq;
                float sq = 0.f;
#pragma unroll
                for (int nt = 0; nt < 4; ++nt) { const f32x4 o = o1[nt] + o2[nt] * gam;
                    sq += (o[0] * o[0] + o[1] * o[1]) + (o[2] * o[2] + o[3] * o[3]);
                    const float y0 = silu_f(bf_lo(greg[nt].x)) * o[0], y1 = silu_f(bf_hi(greg[nt].x)) * o[1], y2 = silu_f(bf_lo(greg[nt].y)) * o[2], y3 = silu_f(bf_hi(greg[nt].y)) * o[3];
                    u32x2 wv; wv.x = cvt_pk_bf16(y0, y1); wv.y = cvt_pk_bf16(y2, y3); *(u32x2*)(op + 16 * nt) = wv; }
                sq += __shfl_xor(sq, 16); sq += __shfl_xor(sq, 32);
                if (fq == 0) ssqb[((size_t)(b * SEQ + t0 + 16 * w + li) * 4 + h) * 8 + sl] = sq;
            }
            if (n + 1 < 16) RET_LOAD_Q(t0 + 128);
            f32x4 tmp[2][4];
#pragma unroll
            for (int mt = 0; mt < 2; ++mt)
#pragma unroll
                for (int nt = 0; nt < 4; ++nt) tmp[mt][nt] = (f32x4){0.f, 0.f, 0.f, 0.f};
#pragma unroll
            for (int s = 0; s < 4; ++s) {
                bf16x8 bv[4];
#pragma unroll
                for (int nt = 0; nt < 4; ++nt) bv[nt] = cat4(lds_tr(Vs + (32 * s + 8 * fq + q4) * VS + (16 * nt + 4 * p4) * 2), lds_tr(Vs + (32 * s + 8 * fq + 4 + q4) * VS + (16 * nt + 4 * p4) * 2));
#pragma unroll
                for (int mt = 0; mt < 2; ++mt) {
                    const bf16x8 ak = cat4(lds_tr(Ks + (32 * s + 8 * fq + q4) * KS + (32 * w + 16 * mt + 4 * p4) * 2), lds_tr(Ks + (32 * s + 8 * fq + 4 + q4) * KS + (32 * w + 16 * mt + 4 * p4) * 2));
#pragma unroll
                    for (int nt = 0; nt < 4; ++nt) tmp[mt][nt] = MFMA16(ak, bv[nt], tmp[mt][nt]);
                }
            }
#pragma unroll
            for (int mt = 0; mt < 2; ++mt)
#pragma unroll
                for (int nt = 0; nt < 4; ++nt) St[mt][nt] = St[mt][nt] * g128 + tmp[mt][nt] * g127;
            if (n + 1 < 16) {
                __syncthreads();
#pragma unroll
                for (int mt = 0; mt < 2; ++mt)
#pragma unroll
                    for (int nt = 0; nt < 4; ++nt) {
                        u32x2 wv; wv.x = cvt_pk_bf16(St[mt][nt][0], St[mt][nt][1]); wv.y = cvt_pk_bf16(St[mt][nt][2], St[mt][nt][3]);
                        *(LAS u32x2*)(StT + (16 * nt + li) * SS + (32 * w + 16 * mt + 4 * fq) * 2) = wv;
                    }
                RET_WRITE_KV();
                __syncthreads();
            }
        }
    }
#undef RET_WRITE_KV
#undef RET_LOAD_KV
#undef RET_LOAD_Q
    __syncthreads();
}

__device__ __forceinline__ void attn_phase(LAS unsigned char* lds, const bf16_t* Qd, const bf16_t* Kd, const bf16_t* Vd, bf16_t* O0, bf16_t* O1, int G) {
    const int tid = threadIdx.x, lane = tid & 63, w = __builtin_amdgcn_readfirstlane(tid >> 6), li = lane & 15, fq = lane >> 4, q4 = li >> 2, p4 = li & 3;
    constexpr int KS = 272, VS = 544, SLOT = 32768;
    const float NEG = -__builtin_inff();
    const unsigned ldsb = (unsigned)(size_t)lds;
    int soff[4]; bool isv[4];
#pragma unroll
    for (int i = 0; i < 4; ++i) {
        const int q = (w * 4 + i) * 64 + lane;
        if (q < 544) { const int row = q / 17, pc = q % 17; soff[i] = row * 1024 + (pc < 16 ? pc : 15) * 8; isv[i] = false; }
        else if (q < 1632) { const int q2 = q - 544, row = q2 / 34, pc = q2 % 34; soff[i] = row * 1024 + (pc < 32 ? pc : 31) * 8; isv[i] = true; }
        else { soff[i] = 0; isv[i] = false; }
    }
    for (int idx = blockIdx.x; idx < 512; idx += G) {
        const int r = idx >> 8, c = idx & 255, xc = c & 7, l = c >> 3, qbi = l & 7;
        const int bh = 4 * xc + 2 * r + (l >> 4), p = (l >> 3) & 1, b = bh >> 2, h = bh & 3;
        const int qb = r ? 7 - qbi : qbi;
        const int q0 = qb * 256, nkt = 8 * (qb + 1);
        const int r0 = q0 + 16 * w, r1 = q0 + 16 * (15 - w);
        const bf16_t* Kp = Kd + (size_t)b * SEQ * 1024 + h * 256 + p * 128;
        const bf16_t* Vp = Vd + (size_t)b * SEQ * 1024 + h * 256;
        const bf16_t* src[4];
#pragma unroll
        for (int i = 0; i < 4; ++i) src[i] = (isv[i] ? Vp : Kp) + soff[i];
        bf16x8 Qf[2][4];
#pragma unroll
        for (int u = 0; u < 2; ++u)
#pragma unroll
            for (int ks = 0; ks < 4; ++ks) Qf[u][ks] = *(const bf16x8*)(Qd + (size_t)(b * SEQ + (u ? r1 : r0) + li) * 1024 + h * 256 + p * 128 + 32 * ks + 8 * fq);
#define ATT_DMA(tile_, slot_) do { const size_t ko_ = (size_t)(tile_) * (32 * 1024); const unsigned lb_ = ldsb + (unsigned)(slot_) * SLOT + (unsigned)(w * 4) * 1024u; _Pragma("unroll") for (int i = 0; i < 4; ++i) \
        glds16_asm(src[i] + ko_, __builtin_amdgcn_readfirstlane(lb_ + i * 1024)); } while (0)
#pragma unroll
        for (int u = 0; u < 2; ++u)
#pragma unroll
            for (int ks = 0; ks < 4; ++ks) asm volatile("" : "+v"(Qf[u][ks]));
        asm volatile("s_waitcnt lgkmcnt(0)\n\ts_barrier" ::: "memory");
        ATT_DMA(0, 0); ATT_DMA(1, 1); ATT_DMA(2, 2);
        float mrun[2] = {NEG, NEG}, lrun[2] = {0.f, 0.f};
        f32x4 O[2][16];
#pragma unroll
        for (int u = 0; u < 2; ++u)
#pragma unroll
            for (int nt = 0; nt < 16; ++nt) O[u][nt] = (f32x4){0.f, 0.f, 0.f, 0.f};
#define ATT_BODY(A0) do { \
                const LAS unsigned char* Kt = lds + (kt & 3) * SLOT; const LAS unsigned char* Vt = Kt + 32 * KS; \
                f32x4 sv[2][2]; \
                _Pragma("unroll") for (int u = 0; u < 2; ++u) _Pragma("unroll") for (int kk = 0; kk < 2; ++kk) sv[u][kk] = (f32x4){0.f, 0.f, 0.f, 0.f}; \
                __builtin_amdgcn_s_setprio(1); \
                _Pragma("unroll") for (int kk = 0; kk < 2; ++kk) _Pragma("unroll") for (int ks = 0; ks < 4; ++ks) { \
                    const bf16x8 a = lds_b128(Kt + (16 * kk + li) * KS + (32 * ks + 8 * fq) * 2); \
                    if (A0) sv[0][kk] = MFMA16(a, Qf[0][ks], sv[0][kk]); sv[1][kk] = MFMA16(a, Qf[1][ks], sv[1][kk]); } \
                __builtin_amdgcn_s_setprio(0); \
                _Pragma("unroll") for (int u = (A0) ? 0 : 1; u < 2; ++u) { const int rb = u ? r1 : r0; \
                    if (k0 + 31 > rb) { _Pragma("unroll") for (int kk = 0; kk < 2; ++kk) _Pragma("unroll") for (int rg = 0; rg < 4; ++rg) if (k0 + 16 * kk + 4 * fq + rg > rb + li) sv[u][kk][rg] = NEG; } } \
                float alpha[2] = {1.0f, 1.0f}; \
                _Pragma("unroll") for (int u = (A0) ? 0 : 1; u < 2; ++u) { \
                    float mx = fmaxf(fmaxf(fmaxf(sv[u][0][0], sv[u][0][1]), fmaxf(sv[u][0][2], sv[u][0][3])), fmaxf(fmaxf(sv[u][1][0], sv[u][1][1]), fmaxf(sv[u][1][2], sv[u][1][3]))); \
                    mx = fmaxf(mx, __shfl_xor(mx, 16)); mx = fmaxf(mx, __shfl_xor(mx, 32)); \
                    const float mn = fmaxf(mrun[u], mx); alpha[u] = __builtin_amdgcn_exp2f(mrun[u] - mn); mrun[u] = mn; \
                    float ls = 0.f; \
                    _Pragma("unroll") for (int kk = 0; kk < 2; ++kk) _Pragma("unroll") for (int rg = 0; rg < 4; ++rg) { sv[u][kk][rg] = __builtin_amdgcn_exp2f(sv[u][kk][rg] - mn); ls += sv[u][kk][rg]; } \
                    lrun[u] = lrun[u] * alpha[u] + ls; } \
                if (__any((alpha[0] != 1.0f) || (alpha[1] != 1.0f))) { \
                    _Pragma("unroll") for (int u = (A0) ? 0 : 1; u < 2; ++u) _Pragma("unroll") for (int nt = 0; nt < 16; ++nt) O[u][nt] = O[u][nt] * alpha[u]; } \
                const bf16x8 P0 = pack_frag(sv[0][0], sv[0][1]), P1 = pack_frag(sv[1][0], sv[1][1]); \
                __builtin_amdgcn_sched_barrier(0); \
                __builtin_amdgcn_s_setprio(1); \
                _Pragma("unroll") for (int nt = 0; nt < 16; ++nt) { \
                    const bf16x8 av = cat4(lds_tr(Vt + (4 * fq + q4) * VS + (16 * nt + 4 * p4) * 2), lds_tr(Vt + (16 + 4 * fq + q4) * VS + (16 * nt + 4 * p4) * 2)); \
                    if (A0) O[0][nt] = MFMA16(av, P0, O[0][nt]); O[1][nt] = MFMA16(av, P1, O[1][nt]); \
                    if ((nt & 3) == 3) __builtin_amdgcn_sched_barrier(0); } \
                __builtin_amdgcn_s_setprio(0); } while (0)
#define ATT_STEP() do { asm volatile("s_waitcnt vmcnt(8) lgkmcnt(0)\n\ts_barrier" ::: "memory"); \
                const int tn_ = kt + 3 < nkt ? kt + 3 : nkt - 1; ATT_DMA(tn_, (kt + 3) & 3); } while (0)
        const int ktA = (r0 + 15) / 32 + 1;
        int kt = 0;
#pragma nounroll
        for (; kt < ktA; ++kt) { const int k0 = 32 * kt; ATT_STEP(); ATT_BODY(1); }
#pragma nounroll
        for (; kt < nkt; ++kt) { const int k0 = 32 * kt; ATT_STEP(); if (k0 <= r1 + 15) ATT_BODY(0); }
#undef ATT_BODY
#undef ATT_STEP
#undef ATT_DMA
#pragma unroll
        for (int u = 0; u < 2; ++u) {
            float l = lrun[u]; l += __shfl_xor(l, 16); l += __shfl_xor(l, 32);
            const float inv = 1.0f / l;
            bf16_t* op = (p ? O1 : O0) + (size_t)(b * SEQ + (u ? r1 : r0) + li) * 1024 + h * 256 + 4 * fq;
#pragma unroll
            for (int nt = 0; nt < 16; ++nt) { const f32x4 o = O[u][nt] * inv; u32x2 wv; wv.x = cvt_pk_bf16(o[0], o[1]); wv.y = cvt_pk_bf16(o[2], o[3]); *(u32x2*)(op + 16 * nt) = wv; }
        }
    }
    asm volatile("s_waitcnt vmcnt(0) lgkmcnt(0)\n\ts_barrier" ::: "memory");
}

#define XB_TMO      128
#define XB_XCNT(j)  (256  + 64 * (j))
#define XB_XSUB(j)  (1280 + 64 * (j))
#define XB_XGEN(j)  (2304 + 64 * (j))
#define XB_TOP      3328
#define XB_TOPGEN   3392
#define XCD_BAR_WORDS 3456
#define XB_SPIN_CAP (1u << 18)
__device__ __forceinline__ unsigned xb_ld(unsigned* p)              { return __hip_atomic_load(p, __ATOMIC_RELAXED, __HIP_MEMORY_SCOPE_AGENT); }
__device__ __forceinline__ unsigned xb_add(unsigned* p, unsigned v) { return __hip_atomic_fetch_add(p, v, __ATOMIC_RELAXED, __HIP_MEMORY_SCOPE_AGENT); }
__device__ __forceinline__ unsigned xb_xcc_id() { return (unsigned)__builtin_amdgcn_s_getreg((3 << 11) | 20) & 0xFu; }
#define XB_SPIN(cond, bar) do { unsigned _sp = 0; while (cond) { __builtin_amdgcn_s_sleep(1); \
    if ((++_sp & 255u) == 0u) { if (xb_ld(&(bar)[XB_TMO])) break; if (_sp > XB_SPIN_CAP) { atomicAdd(&(bar)[XB_TMO], 1u); break; } } } } while (0)
struct XcdBarrier { unsigned* bar; unsigned x; volatile LAS unsigned* st; };
__device__ __forceinline__ XcdBarrier xcd_barrier_post(unsigned* bar, volatile LAS unsigned* st) {
    XcdBarrier b; b.bar = bar; b.x = xb_xcc_id(); b.st = st;
    if (threadIdx.x == 0) (void)xb_add(&bar[XB_XCNT(b.x)], 1u);
    return b;
}
__device__ __forceinline__ void xcd_barrier_complete(unsigned* bar, unsigned x, unsigned& nloc, unsigned& nx) {
    const unsigned G = gridDim.x * gridDim.y * gridDim.z;
    unsigned sum, cnt, mine, sp = 0u;
    for (;;) {
        sum = 0u; cnt = 0u; mine = 0u;
#pragma unroll
        for (unsigned j = 0; j < 16; ++j) { const unsigned c = xb_ld(&bar[XB_XCNT(j)]); sum += c; cnt += (c > 0u) ? 1u : 0u; mine = (j == x) ? c : mine; }
        if (sum == G) break;
        __builtin_amdgcn_s_sleep(1);
        if ((++sp & 255u) == 0u) { if (xb_ld(&bar[XB_TMO])) break; if (sp > XB_SPIN_CAP) { atomicAdd(&bar[XB_TMO], 1u); break; } }
    }
    nloc = mine > 0u ? mine : 1u; nx = cnt > 0u ? cnt : 1u;
}
__device__ __forceinline__ void xcd_barrier(const XcdBarrier& b) {
    asm volatile("s_waitcnt vmcnt(0)" ::: "memory");
    __syncthreads();
    if (threadIdx.x == 0) {
        unsigned* bar = b.bar;
        __builtin_amdgcn_s_waitcnt(0);
        unsigned nloc = b.st[0], nx = b.st[1];
        if (nloc == 0u) { xcd_barrier_complete(bar, b.x, nloc, nx); b.st[0] = nloc; b.st[1] = nx; }
        const unsigned old = xb_add(&bar[XB_XSUB(b.x)], 1u);
        const unsigned gen = old / nloc;
        if (old + 1u == (gen + 1u) * nloc) {
            __builtin_amdgcn_fence(__ATOMIC_RELEASE, "agent");
            asm volatile("s_waitcnt vmcnt(0)" ::: "memory");
            const unsigned og = xb_add(&bar[XB_TOP], 1u);
            const unsigned tg = og / nx;
            if (og + 1u == (tg + 1u) * nx) xb_add(&bar[XB_TOPGEN], 1u);
            else XB_SPIN(xb_ld(&bar[XB_TOPGEN]) == tg, bar);
            __builtin_amdgcn_fence(__ATOMIC_ACQUIRE, "agent");
            xb_add(&bar[XB_XGEN(b.x)], 1u);
            asm volatile("s_waitcnt vmcnt(0)" ::: "memory");
        } else {
            XB_SPIN(xb_ld(&bar[XB_XGEN(b.x)]) == gen, bar);
            __builtin_amdgcn_fence(__ATOMIC_ACQUIRE, "agent");
            asm volatile("s_waitcnt vmcnt(0)" ::: "memory");
        }
    }
    __syncthreads();
}

__global__ void __launch_bounds__(512, 2) yoco_fwd(Args args) {
    extern __shared__ __attribute__((aligned(16))) unsigned char lds_raw[];
    LAS unsigned char* lds = (LAS unsigned char*)lds_raw;
    LAS unsigned char* ldsx = lds + LDS_XOFF;
    cg::grid_group grid = cg::this_grid();
    const int tid = threadIdx.x, lane = tid & 63, wave = __builtin_amdgcn_readfirstlane(tid >> 6);
    const int G = gridDim.x, gw = blockIdx.x * 8 + wave, NGW = G * 8;
    unsigned char* ws = args.ws;
    const int lo = args.ph_lo, hi = args.ph_hi;
    volatile LAS unsigned* xst = (volatile LAS unsigned*)(lds + LDS_XOFF + 8192);
    if (tid < 2) xst[tid] = 0u;
    if (blockIdx.x == 0 && tid < 64) __hip_atomic_store((unsigned*)(ws + WS_XCNT) + 16 * tid, 0u, __ATOMIC_RELAXED, __HIP_MEMORY_SCOPE_AGENT);
    if (blockIdx.x == 0) { for (int i = tid; i < XCD_BAR_WORDS; i += 512) __hip_atomic_store((unsigned*)(ws + WS_BAR) + i, 0u, __ATOMIC_RELAXED, __HIP_MEMORY_SCOPE_AGENT); }
    asm volatile("s_waitcnt vmcnt(0)" ::: "memory");
    __syncthreads();
#define IN(k) (lo <= (k) && (k) < hi)
#define SEAM(k) do { if (IN(k) && hi > (k) + 1 && (k) != 16) xcd_barrier(xbar); } while (0)
    grid.sync();
    asm volatile("" ::: "memory");
    const XcdBarrier xbar = xcd_barrier_post((unsigned*)(ws + WS_BAR), xst);
    float* X = args.out;
    const float* mod0 = (const float*)(ws + WS_MOD0); const float* mod1 = (const float*)(ws + WS_MOD1); const float* kvmod = (const float*)(ws + WS_KVMOD);
    bf16_t* H = (bf16_t*)(ws + WS_H);
    bf16_t* U = (bf16_t*)(ws + WS_U);
    const float* tabR = (const float*)(ws + WS_TABR); const float* tabD = (const float*)(ws + WS_TABD);
    pg8::StaticOrder S;

#define PH(k, ...) do { if (IN(k)) { __VA_ARGS__ if (MK_DUP == (k)) { __VA_ARGS__ } } SEAM(k); if (MK_DUPSYNC) SEAM(k); } while (0)
    PH(0, { p0_prologue<0>(args, lds, wave, lane, G); });
    PH(1, { p0_prologue<1>(args, lds, wave, lane, G); NM a{args.in[2], mod0, mod0 + 1024, 6144, (bf16_t*)args.out}; normmod_phase<false>(args.in[0], a, a, gw, NGW, lane); });
    PH(2, {
        pg8::Gemm g{(const bf16_t*)args.out, (const bf16_t*)(ws + WS_WRIN), TOK, 6144, 1024, 256}; S.init(TOK, 6144, G, (int)blockIdx.x);
        EpiRetIn E{(bf16_t*)(ws + WS_Q), (bf16_t*)(ws + WS_K), (bf16_t*)(ws + WS_V), (bf16_t*)(ws + WS_G), tabR};
        pg8::gemm_phase<EpiRetIn>(lds, ldsx, g, S, E); });
    PH(3, { retention_phase(lds, (const bf16_t*)(ws + WS_Q), (const bf16_t*)(ws + WS_K), (bf16_t*)(ws + WS_V), (const bf16_t*)(ws + WS_G), (float*)(ws + WS_SSQ), G); });
    PH(5, {
        pg8::Gemm g{(const bf16_t*)(ws + WS_V), (const bf16_t*)(ws + WS_WROUT), TOK, 1024, 2048, 256}; S.init(TOK, 1024, G, (int)blockIdx.x);
        EpiResNorm<true, 1> E{args.in[0], X, mod0 + 2048, (const float*)(ws + WS_SSQ), {{H, args.in[2] + 1024, mod0 + 3072, mod0 + 4096, 6144}, {H, args.in[2] + 1024, mod0 + 3072, mod0 + 4096, 6144}}, (float*)(ws + WS_XSLOT), (unsigned*)(ws + WS_XCNT), 32u};
        pg8::gemm_phase<EpiResNorm<true, 1>>(lds, ldsx, g, S, E); });
    PH(7, {
        pg8::Gemm g{H - 2 * 1024, (const bf16_t*)(ws + WS_WFIN0), 65 * 256, NFF, 1024, 254}; S.init(65 * 256, NFF, G, (int)blockIdx.x);
        EpiFfn E{U, args.in[8], args.in[9]};
        pg8::gemm_phase<EpiFfn>(lds, ldsx, g, S, E); });
    PH(8, {
        pg8::Gemm g{U, (const bf16_t*)(ws + WS_WFDN0), TOK, 1024, DFF, 256}; S.init(TOK, 1024, G, (int)blockIdx.x);
        EpiResNorm<false, 2> E{X, X, mod0 + 5120, nullptr, {{H, args.in[11], kvmod, kvmod + 1024, 2048}, {(bf16_t*)(ws + WS_H3), args.in[2] + 2048, mod1, mod1 + 1024, 6144}}, (float*)(ws + WS_XSLOT), (unsigned*)(ws + WS_XCNT), 64u};
        pg8::gemm_phase<EpiResNorm<false, 2>>(lds, ldsx, g, S, E); });
    PH(10, {
        { pg8::Gemm g{H, (const bf16_t*)(ws + WS_WKV), TOK, 2048, 1024, 256}; S.init(TOK, 2048, G, (int)blockIdx.x);
          EpiRope E{(bf16_t*)(ws + WS_KSH), (bf16_t*)(ws + WS_VSH), 4, tabD, 1.0f};
          pg8::gemm_phase<EpiRope>(lds, ldsx, g, S, E); }
        { pg8::Gemm g{(const bf16_t*)(ws + WS_H3), (const bf16_t*)(ws + WS_WQ), TOK, 1024, 1024, 256}; S.init(TOK, 1024, G, (int)blockIdx.x);
          EpiRope E{(bf16_t*)(ws + WS_QD), (bf16_t*)(ws + WS_QD), 4, tabD, 0.08838834764831845f * 1.4426950408889634f};
          pg8::gemm_phase<EpiRope>(lds, ldsx, g, S, E); } });
    PH(11, { attn_phase(lds, (const bf16_t*)(ws + WS_QD), (const bf16_t*)(ws + WS_KSH), (const bf16_t*)(ws + WS_VSH), (bf16_t*)(ws + WS_O0), (bf16_t*)(ws + WS_O1), G); });
    PH(12, { combine_phase((const bf16_t*)(ws + WS_O0), (const bf16_t*)(ws + WS_O1), (bf16_t*)(ws + WS_OD), args.in[17], (const float*)(ws + WS_LAM), gw, NGW, lane); });
    PH(13, {
        pg8::Gemm g{(const bf16_t*)(ws + WS_OD), (const bf16_t*)(ws + WS_WO), TOK, 1024, 1024, 256}; S.init(TOK, 1024, G, (int)blockIdx.x);
        EpiResNorm<false, 1> E{X, X, mod1 + 2048, nullptr, {{H, args.in[2] + 3072, mod1 + 3072, mod1 + 4096, 6144}, {H, args.in[2] + 3072, mod1 + 3072, mod1 + 4096, 6144}}, (float*)(ws + WS_XSLOT), (unsigned*)(ws + WS_XCNT), 96u};
        pg8::gemm_phase<EpiResNorm<false, 1>>(lds, ldsx, g, S, E); });
    PH(15, {
        pg8::Gemm g{H - 2 * 1024, (const bf16_t*)(ws + WS_WFIN1), 65 * 256, NFF, 1024, 254}; S.init(65 * 256, NFF, G, (int)blockIdx.x);
        EpiFfn E{U, args.in[8] + 3 * DFF, args.in[9] + DFF};
        pg8::gemm_phase<EpiFfn>(lds, ldsx, g, S, E); });
    PH(16, {
        pg8::Gemm g{U, (const bf16_t*)(ws + WS_WFDN1), TOK, 1024, DFF, 256}; S.init(TOK, 1024, G, (int)blockIdx.x);
        EpiResFinal E{X, X, mod1 + 5120, args.in[19], (float*)(ws + WS_XSLOT), (unsigned*)(ws + WS_XCNT), 128u};
        pg8::gemm_phase<EpiResFinal>(lds, ldsx, g, S, E); });
#undef PH
#undef IN
#undef SEAM
}

extern "C" void kernel_launch(void* const* d_in, const int* in_sizes, int n_in, void* d_out, int out_size, void* d_ws, size_t ws_size, hipStream_t stream) {
    static int grid = 0;
    if (grid == 0) {
        if (n_in != 20 || out_size != TOK * DM || ws_size < WS_END) { fprintf(stderr, "kernel_launch: unexpected shapes (n_in %d, out %d, ws %zu)\n", n_in, out_size, ws_size); grid = -1; return; }
        int dev = 0, cus = 0, per_cu = 0;
        if (hipGetDevice(&dev) != hipSuccess || hipDeviceGetAttribute(&cus, hipDeviceAttributeMultiprocessorCount, dev) != hipSuccess) { grid = -1; return; }
        if (hipFuncSetAttribute((const void*)yoco_fwd, hipFuncAttributeMaxDynamicSharedMemorySize, LDS_BYTES) != hipSuccess) { fprintf(stderr, "kernel_launch: hipFuncSetAttribute failed\n"); grid = -1; return; }
        if (hipOccupancyMaxActiveBlocksPerMultiprocessor(&per_cu, (const void*)yoco_fwd, 512, LDS_BYTES) != hipSuccess || per_cu < 1) { fprintf(stderr, "kernel_launch: occupancy query failed (%d)\n", per_cu); (void)hipGetLastError(); grid = -1; return; }
        if (cus != 256) { fprintf(stderr, "kernel_launch: built for a 256-CU device (one 256x256 unit per workgroup in the fused final-norm GEMM), found %d CUs\n", cus); grid = -1; return; }
        grid = cus;
    }
    if (grid < 0) return;
    Args a{};
    for (int i = 0; i < 20; ++i) a.in[i] = (const float*)d_in[i];
    a.out = (float*)d_out; a.ws = (unsigned char*)d_ws;
#if MK_PER_PHASE
    for (int ph = 0; ph < NPHASE; ++ph) {
        a.ph_lo = ph; a.ph_hi = ph + 1; void* kargs[] = {&a};
        hipError_t e = hipLaunchCooperativeKernel((const void*)yoco_fwd, dim3(grid), dim3(512), kargs, LDS_BYTES, stream);
        if (e != hipSuccess) { fprintf(stderr, "cooperative launch failed: %s\n", hipGetErrorString(e)); break; }
    }
#else
    a.ph_lo = 0; a.ph_hi = NPHASE; void* kargs[] = {&a};
    hipError_t e = hipLaunchCooperativeKernel((const void*)yoco_fwd, dim3(grid), dim3(512), kargs, LDS_BYTES, stream);
    if (e != hipSuccess) fprintf(stderr, "cooperative launch failed: %s (grid %d)\n", hipGetErrorString(e), grid);
#endif
}
```

```cpp
#include <hip/hip_runtime.h>
#include <hip/hip_cooperative_groups.h>
#include <cstdio>
#include <cstdint>
namespace cg = cooperative_groups;

#define LAS __attribute__((address_space(3)))
typedef unsigned short bf16_t;
typedef short bf16x8 __attribute__((ext_vector_type(8)));
typedef short s16x4 __attribute__((ext_vector_type(4)));
typedef float f32x4 __attribute__((ext_vector_type(4)));
typedef float f32x2 __attribute__((ext_vector_type(2)));
typedef unsigned u32x4 __attribute__((ext_vector_type(4)));
typedef unsigned u32x2 __attribute__((ext_vector_type(2)));

#ifndef MK_DUP
#define MK_DUP -1
#endif
#ifndef MK_DUPSYNC
#define MK_DUPSYNC 0
#endif
#ifndef MK_PER_PHASE
#define MK_PER_PHASE 0
#endif

constexpr int NB = 8, SEQ = 2048, DM = 1024, TOK = NB * SEQ;
constexpr int DFF = 2816, NFF = 2 * DFF;
constexpr float EPS = 1e-6f;
constexpr int NPHASE = 18;

constexpr size_t MiB = 1u << 20;
constexpr size_t WS_MOD0 = 0, WS_MOD1 = 196608, WS_KVMOD = 393216, WS_LAM = 458752, CTL_ZERO_BYTES = 1 * MiB;
constexpr size_t WS_BAR = 524288, BAR_ZERO_BYTES = 16384;
constexpr size_t WS_TABR = 1 * MiB, WS_TABD = 3 * MiB;
constexpr size_t WS_WRIN = 4 * MiB, WS_WROUT = 16 * MiB, WS_WFIN0 = 20 * MiB, WS_WFIN1 = 31 * MiB, WS_WFDN0 = 42 * MiB, WS_WFDN1 = 42 * MiB + 5632 * 1024,
                 WS_WKV = 53 * MiB, WS_WQ = 57 * MiB, WS_WO = 59 * MiB;
constexpr size_t WS_A0 = 61 * MiB;
constexpr size_t WS_Q = WS_A0, WS_K = 93 * MiB, WS_V = 125 * MiB, WS_G = 189 * MiB;
constexpr size_t WS_H = WS_A0 + 8192;
constexpr size_t WS_U = 126 * MiB;
constexpr size_t WS_H3 = 94 * MiB, WS_KSH = 126 * MiB, WS_VSH = 158 * MiB, WS_QD = 190 * MiB, WS_O0 = 222 * MiB, WS_O1 = WS_H, WS_OD = 94 * MiB;
constexpr size_t WS_SSQ = 253 * MiB;
constexpr size_t WS_XSLOT = 255 * MiB;
constexpr size_t WS_XCNT = 700000;
constexpr size_t WS_END = 256 * MiB;

constexpr int LDS_BYTES = 147456;
constexpr int LDS_XOFF = 131072;

__device__ __forceinline__ unsigned cvt_pk_bf16(float lo, float hi) { unsigned r; asm volatile("v_cvt_pk_bf16_f32 %0, %1, %2" : "=v"(r) : "v"(lo), "v"(hi)); return r; }
__device__ __forceinline__ float bf_lo(unsigned u) { return __uint_as_float(u << 16); }
__device__ __forceinline__ float bf_hi(unsigned u) { return __uint_as_float(u & 0xffff0000u); }
__device__ __forceinline__ float wave_sum(float v) {
#pragma unroll
    for (int o = 1; o < 64; o <<= 1) v += __shfl_xor(v, o);
    return v;
}
__device__ __forceinline__ float silu_f(float x) { return x / (1.0f + __expf(-x)); }
__device__ __forceinline__ f32x2 gelu_pk(f32x2 v) {
    const f32x2 av = __builtin_elementwise_abs(v), d = av * 0.2316418882f + 1.0f;
    f32x2 t; t.x = __builtin_amdgcn_rcpf(d.x); t.y = __builtin_amdgcn_rcpf(d.y);
    f32x2 q = t * 0.5307027145f + (-0.7265760135f); q = q * t + 0.7107068705f; q = q * t + (-0.142248368f); q = q * t + 0.127414796f; q = q * t;
    const f32x2 s = (v * v) * (-0.72134752044f);
    f32x2 e; e.x = __builtin_amdgcn_exp2f(s.x); e.y = __builtin_amdgcn_exp2f(s.y);
    const f32x2 m = v * (q * e), r = v - m;
    f32x2 o; o.x = v.x < 0.f ? m.x : r.x; o.y = v.y < 0.f ? m.y : r.y; return o;
}
__device__ __forceinline__ u32x4 pack8(const f32x4 a, const f32x4 b) { u32x4 w; w.x = cvt_pk_bf16(a[0], a[1]); w.y = cvt_pk_bf16(a[2], a[3]); w.z = cvt_pk_bf16(b[0], b[1]); w.w = cvt_pk_bf16(b[2], b[3]); return w; }
__device__ __forceinline__ bf16x8 lds_b128(const LAS unsigned char* p) { return *(const LAS bf16x8*)p; }
__device__ __forceinline__ s16x4 lds_tr(const LAS unsigned char* p) { return __builtin_amdgcn_ds_read_tr16_b64_v4i16((LAS s16x4*)p); }
__device__ __forceinline__ void glds16_asm(const void* gsrc, unsigned lds_dst) { unsigned keep;
    asm volatile("s_mov_b32 %0, m0\n\ts_mov_b32 m0, %2\n\ts_nop 0\n\tglobal_load_lds_dwordx4 %1, off\n\ts_mov_b32 m0, %0" : "=&s"(keep) : "v"(gsrc), "s"(lds_dst) : "memory"); }
template <int OFF> __device__ __forceinline__ s16x4 lds_tr_asm(unsigned addr) { s16x4 d; asm volatile("ds_read_b64_tr_b16 %0, %1 offset:%2" : "=v"(d) : "v"(addr), "n"(OFF)); return d; }
#define LGKM_WAIT8(n, r) asm volatile("s_waitcnt lgkmcnt(" #n ")" : "+v"(r[0]), "+v"(r[1]), "+v"(r[2]), "+v"(r[3]), "+v"(r[4]), "+v"(r[5]), "+v"(r[6]), "+v"(r[7]))
__device__ __forceinline__ bf16x8 cat4(s16x4 a, s16x4 b) { return __builtin_shufflevector(a, b, 0, 1, 2, 3, 4, 5, 6, 7); }
__device__ __forceinline__ bf16x8 pack_frag(const f32x4 a, const f32x4 b) { u32x4 w = pack8(a, b); return __builtin_bit_cast(bf16x8, w); }
#define MFMA16(a, b, c) __builtin_amdgcn_mfma_f32_16x16x32_bf16((a), (b), (c), 0, 0, 0)

namespace pg8 {
constexpr int BM = 256, BK = 64, HALF = 128, HTB = HALF * BK * 2, STAGE_BYTES = 8 * HTB, NXCD = 8, WGM = 8;
__host__ __device__ __forceinline__ int lds_byte(int r, int c) { const int st = (r >> 4) * 2 + (c >> 5), rr = r & 15, cc = c & 31, ob = rr * 64 + cc * 2; return st * 1024 + (ob ^ (((ob >> 9) & 1) << 5)); }
__host__ __device__ __forceinline__ void stage_rc(int b, int& R, int& C) { const int st = b / 1024, sb = b % 1024, swz = sb ^ (((sb >> 9) & 1) << 5); R = (st >> 1) * 16 + swz / 64; C = (st & 1) * 32 + (swz % 64) / 2; }
__host__ __device__ __forceinline__ int perm32(int rho) { const int n = rho >> 4, i = rho & 15; return 8 * (i >> 2) + 4 * n + (i & 3); }

struct Unit { int pm, pn; };
struct Gemm { const bf16_t* A; const bf16_t* Bt; int M, N, K; int a_rows; };

struct StaticOrder {
    int nM, nN, nwg, G, c;
    __host__ __device__ void init(int M, int N, int G_, int c_) { nM = M / BM; nN = N / BM; nwg = nM * nN; G = G_; c = c_; }
    __host__ __device__ bool next(int i, Unit& u) const {
        const long L = (long)i * G + c; if (L >= nwg) return false;
        int wgid = (int)L; { const int q = nwg / NXCD, r = nwg % NXCD, xcd = wgid % NXCD, off = wgid / NXCD; wgid = (xcd < r ? xcd * (q + 1) : r * (q + 1) + (xcd - r) * q) + off; }
        const int nig = WGM * nN, gid = wgid / nig, fm = gid * WGM, gsz = (nM - fm) < WGM ? (nM - fm) : WGM;
        u.pm = fm + ((wgid % nig) % gsz); u.pn = (wgid % nig) / gsz; return true;
    }
};

template <class Epi>
__device__ __forceinline__ void gemm_phase(LAS unsigned char* lds, LAS unsigned char* ldsx, const Gemm g, const StaticOrder& S, const Epi& E) {
    const int tid = threadIdx.x, wid = __builtin_amdgcn_readfirstlane(tid >> 6), lane = tid & 63, wr = wid >> 2, wc = wid & 3, fr = lane & 15, fq = lane >> 4;
    const int K = g.K, nt = K / BK;
    unsigned voffA[2], voffB[2];
#pragma unroll
    for (int i = 0; i < 2; ++i) { int R, C; stage_rc(tid * 16 + i * 8192, R, C); const int Rb = Epi::PERM ? ((R & ~31) + perm32(R & 31)) : R;
        voffA[i] = (unsigned)(R * K + C) * 2u; voffB[i] = (unsigned)(Rb * K + C) * 2u; }
    const size_t kstep = (size_t)(BK * 2);
    const size_t hstep = (size_t)HALF * K * 2;
    const size_t tstepB = 2 * hstep;
    const size_t tstepA = (size_t)g.a_rows * K * 2;
    const unsigned ldsw = (unsigned)wid * 1024u;
    const int aoff = lds_byte(wr * 64 + fr, fq * 8), boff = lds_byte(wc * 32 + fr, fq * 8);
#define PG8_SA(b, h) (((b) * 2 + (h)) * HTB)
#define PG8_SB(b, h) ((4 + (b) * 2 + (h)) * HTB)
#define PG8_STAGE(bufoff, gbase, voff) do { _Pragma("unroll") for (int _i = 0; _i < 2; ++_i) \
        __builtin_amdgcn_global_load_lds((const unsigned*)((const char*)(gbase) + (voff)[_i]), (LAS unsigned*)(lds + (bufoff) + ldsw + _i * 8192), 16, 0, 0); } while (0)
#define PG8_LDA(dst, b, h) do { _Pragma("unroll") for (int m = 0; m < 4; ++m) _Pragma("unroll") for (int k = 0; k < 2; ++k) dst[m][k] = *(const LAS bf16x8*)(lds + PG8_SA(b, h) + aoff + m * 2048 + k * 1024); } while (0)
#define PG8_LDB(dst, b, h) do { _Pragma("unroll") for (int n = 0; n < 2; ++n) _Pragma("unroll") for (int k = 0; k < 2; ++k) dst[n][k] = *(const LAS bf16x8*)(lds + PG8_SB(b, h) + boff + n * 2048 + k * 1024); } while (0)
#define PG8_MMA(ai, bj, At, Bt) do { __builtin_amdgcn_s_setprio(1); _Pragma("unroll") for (int m = 0; m < 4; ++m) _Pragma("unroll") for (int n = 0; n < 2; ++n) _Pragma("unroll") for (int k = 0; k < 2; ++k) \
        acc[ai][bj][m][n] = __builtin_amdgcn_mfma_f32_16x16x32_bf16(Bt[n][k], At[m][k], acc[ai][bj][m][n], 0, 0, 0); __builtin_amdgcn_s_setprio(0); } while (0)
#define PG8_WAIT_V(n) asm volatile("s_waitcnt vmcnt(" #n ")" ::: "memory")
#define PG8_WAIT_L(n) asm volatile("s_waitcnt lgkmcnt(" #n ")" ::: "memory")
#define PG8_BAR __builtin_amdgcn_s_barrier()
#define PG8_SCHED __builtin_amdgcn_sched_barrier(0)
    Unit cur, nxt; int ui = 0;
    if (!S.next(0, cur)) return;
    if constexpr (Epi::KHOOK) E.prep(cur, ldsx);
    f32x4 acc[2][2][4][2];
#pragma unroll
    for (int a = 0; a < 2; ++a)
#pragma unroll
        for (int b = 0; b < 2; ++b)
#pragma unroll
            for (int m = 0; m < 4; ++m)
#pragma unroll
                for (int n = 0; n < 2; ++n) acc[a][b][m][n] = (f32x4){0.f, 0.f, 0.f, 0.f};
    bf16x8 At[4][2], B0[2][2], B1[2][2];
    const char* cA = (const char*)g.A + (size_t)cur.pm * tstepA; const char* cB = (const char*)g.Bt + (size_t)cur.pn * tstepB;
    PG8_STAGE(PG8_SB(0, 0), cB, voffB); PG8_STAGE(PG8_SB(0, 1), cB + hstep, voffB); PG8_STAGE(PG8_SA(0, 0), cA, voffA); PG8_STAGE(PG8_SA(0, 1), cA + hstep, voffA);
    if (wr == 1) PG8_BAR;
    PG8_WAIT_V(2); PG8_BAR;
    PG8_STAGE(PG8_SB(1, 0), cB + kstep, voffB); PG8_STAGE(PG8_SA(1, 0), cA + kstep, voffA); PG8_STAGE(PG8_SB(1, 1), cB + hstep + kstep, voffB);
    PG8_WAIT_V(6); PG8_BAR;
    for (;;) {
        const bool has_next = S.next(ui + 1, nxt);
        const char* nA = has_next ? (const char*)g.A + (size_t)nxt.pm * tstepA : cA; const char* nB = has_next ? (const char*)g.Bt + (size_t)nxt.pn * tstepB : cB;
        for (int t = 0; t < nt; t += 2) {
            const bool last = (t == nt - 2);
            if constexpr (Epi::KHOOK) { if (t != 0 && (t & 7) == 0) E.khook(acc, t >> 3, wr, fr, ldsx); }
            const char* a1 = cA + (size_t)(t + 1) * kstep;
            const char* a2 = last ? nA : cA + (size_t)(t + 2) * kstep; const char* b2 = last ? nB : cB + (size_t)(t + 2) * kstep;
            const char* a3 = a2 + kstep; const char* b3 = b2 + kstep;
            PG8_LDB(B0, 0, 0); PG8_LDB(B1, 0, 1); PG8_SCHED; PG8_LDA(At, 0, 0); PG8_STAGE(PG8_SA(1, 1), a1 + hstep, voffA);
            PG8_WAIT_V(8); PG8_WAIT_L(0); PG8_BAR; PG8_MMA(0, 0, At, B0); PG8_MMA(0, 1, At, B1); PG8_BAR; PG8_SCHED;
            PG8_LDA(At, 0, 1); PG8_STAGE(PG8_SB(0, 0), b2, voffB); PG8_STAGE(PG8_SB(0, 1), b2 + hstep, voffB); PG8_STAGE(PG8_SA(0, 0), a2, voffA);
            PG8_WAIT_V(8); PG8_WAIT_L(0); PG8_BAR; PG8_MMA(1, 0, At, B0); PG8_MMA(1, 1, At, B1); PG8_BAR; PG8_SCHED;
            PG8_LDB(B0, 1, 0); PG8_LDB(B1, 1, 1); PG8_SCHED; PG8_LDA(At, 1, 0); PG8_STAGE(PG8_SA(0, 1), a2 + hstep, voffA);
            PG8_WAIT_V(8); PG8_WAIT_L(0); PG8_BAR; PG8_MMA(0, 0, At, B0); PG8_MMA(0, 1, At, B1); PG8_BAR; PG8_SCHED;
            PG8_LDA(At, 1, 1); PG8_STAGE(PG8_SB(1, 0), b3, voffB); PG8_STAGE(PG8_SB(1, 1), b3 + hstep, voffB); PG8_STAGE(PG8_SA(1, 0), a3, voffA);
            PG8_WAIT_V(8); PG8_WAIT_L(0); PG8_BAR; PG8_MMA(1, 0, At, B0); PG8_MMA(1, 1, At, B1); PG8_BAR; PG8_SCHED;
        }
        if (wr == 0) PG8_BAR;
        E(acc, cur, wr, wc, fr, fq, ldsx);
        if (!has_next) break;
#pragma unroll
        for (int a = 0; a < 2; ++a)
#pragma unroll
            for (int b = 0; b < 2; ++b)
#pragma unroll
                for (int m = 0; m < 4; ++m)
#pragma unroll
                    for (int n = 0; n < 2; ++n) acc[a][b][m][n] = (f32x4){0.f, 0.f, 0.f, 0.f};
        cur = nxt; cA = nA; cB = nB; ++ui;
        if (wr == 1) PG8_BAR;
    }
    PG8_WAIT_V(0);
    PG8_BAR;
#undef PG8_SA
#undef PG8_SB
#undef PG8_STAGE
#undef PG8_LDA
#undef PG8_LDB
#undef PG8_MMA
#undef PG8_WAIT_V
#undef PG8_WAIT_L
#undef PG8_BAR
#undef PG8_SCHED
}
}
using pg8::Unit;

struct EpiRetIn {
    static constexpr bool PERM = true, KHOOK = false;
    bf16_t *Q, *Kk, *V, *G; const float* tab;
    __device__ __forceinline__ void operator()(const f32x4 (&acc)[2][2][4][2], const Unit& u, int wr, int wc, int fr, int fq, LAS unsigned char*) const {
        const int row0 = u.pm * 256 + wr * 64 + fr, cw = wc * 32 + 8 * fq;
        if (u.pn < 8) {
            const int head = u.pn & 3; const bool isk = u.pn >= 4;
            bf16_t* dst = (isk ? Kk : Q) + head * 256 + cw;
            const float lg = log2f(1.0f - exp2f(-5.0f - (float)head));
#pragma unroll
            for (int ai = 0; ai < 2; ++ai)
#pragma unroll
                for (int m = 0; m < 4; ++m) {
                    const int row = row0 + ai * 128 + m * 16, pos = row & 2047, ci = pos & 127;
                    const float sc = isk ? exp2f(-lg * (float)ci) * 0.0625f : exp2f(lg * (float)ci);
                    const f32x4* tp = (const f32x4*)(tab + ((size_t)pos * 128 + cw) * 2);
                    const f32x4 t0 = tp[0], t1 = tp[1], t2 = tp[2], t3 = tp[3];
                    const f32x4 cs0 = {t0[0], t0[2], t1[0], t1[2]}, sn0 = {t0[1], t0[3], t1[1], t1[3]}, cs1 = {t2[0], t2[2], t3[0], t3[2]}, sn1 = {t2[1], t2[3], t3[1], t3[3]};
                    const f32x4 x10 = acc[ai][0][m][0], x11 = acc[ai][0][m][1], x20 = acc[ai][1][m][0], x21 = acc[ai][1][m][1];
                    const f32x4 o10 = (x10 * cs0 - x20 * sn0) * sc, o11 = (x11 * cs1 - x21 * sn1) * sc;
                    const f32x4 o20 = (x20 * cs0 + x10 * sn0) * sc, o21 = (x21 * cs1 + x11 * sn1) * sc;
                    bf16_t* rp = dst + (size_t)row * 1024;
                    *(u32x4*)rp = pack8(o10, o11); *(u32x4*)(rp + 128) = pack8(o20, o21);
                }
        } else {
            bf16_t* dst = (u.pn < 16 ? V + (u.pn - 8) * 256 : G + (u.pn - 16) * 256) + cw;
#pragma unroll
            for (int ai = 0; ai < 2; ++ai)
#pragma unroll
                for (int m = 0; m < 4; ++m) {
                    bf16_t* rp = dst + (size_t)(row0 + ai * 128 + m * 16) * 2048;
#pragma unroll
                    for (int bj = 0; bj < 2; ++bj) *(u32x4*)(rp + bj * 128) = pack8(acc[ai][bj][m][0], acc[ai][bj][m][1]);
                }
        }
    }
};
struct EpiRes {
    static constexpr bool PERM = false, KHOOK = false;
    const float* base; float* out; const float* gate;
    __device__ __forceinline__ void operator()(const f32x4 (&acc)[2][2][4][2], const Unit& u, int wr, int wc, int fr, int fq, LAS unsigned char*) const {
        const int row0 = u.pm * 256 + wr * 64 + fr, col0 = u.pn * 256 + wc * 32 + 4 * fq;
#pragma unroll
        for (int ai = 0; ai < 2; ++ai)
#pragma unroll
            for (int m = 0; m < 4; ++m) {
                const int row = row0 + ai * 128 + m * 16; const float* gp = gate + (size_t)(row >> 11) * 6144 + col0; const size_t off = (size_t)row * 1024 + col0;
#pragma unroll
                for (int bj = 0; bj < 2; ++bj)
#pragma unroll
                    for (int n = 0; n < 2; ++n) { const int c = bj * 128 + n * 16; const f32x4 gv = *(const f32x4*)(gp + c), bs = *(const f32x4*)(base + off + c);
                        *(f32x4*)(out + off + c) = bs + gv * acc[ai][bj][m][n]; }
            }
    }
};
struct EpiResHead {
    static constexpr bool PERM = false, KHOOK = true;
    const float* base; float* out; const float* gate; const float* ssq;
    __device__ __forceinline__ void prep(const Unit& u, LAS unsigned char* lx) const {
        const int t = threadIdx.x;
        if (t < 256) {
            const f32x4* p = (const f32x4*)(ssq + (size_t)(u.pm * 256 + t) * 32);
            float ri[4];
#pragma unroll
            for (int h = 0; h < 4; ++h) { const f32x4 a = p[2 * h], b = p[2 * h + 1]; const float sm = ((a[0] + a[1]) + (a[2] + a[3])) + ((b[0] + b[1]) + (b[2] + b[3])); ri[h] = 1.0f / sqrtf(sm * (1.0f / 512.0f) + EPS); }
            *(LAS f32x4*)(lx + t * 16) = (f32x4){ri[3], ri[0] / ri[1], ri[1] / ri[2], ri[2] / ri[3]};
        }
        asm volatile("s_waitcnt lgkmcnt(0)" ::: "memory");
    }
    __device__ __forceinline__ void khook(f32x4 (&acc)[2][2][4][2], int hb, int wr, int fr, LAS unsigned char* lx) const {
#pragma unroll
        for (int ai = 0; ai < 2; ++ai)
#pragma unroll
            for (int m = 0; m < 4; ++m) { const float f = ((const LAS float*)lx)[(ai * 128 + wr * 64 + m * 16 + fr) * 4 + hb];
#pragma unroll
                for (int bj = 0; bj < 2; ++bj)
#pragma unroll
                    for (int n = 0; n < 2; ++n) acc[ai][bj][m][n] = acc[ai][bj][m][n] * f; }
    }
    __device__ __forceinline__ void operator()(const f32x4 (&acc)[2][2][4][2], const Unit& u, int wr, int wc, int fr, int fq, LAS unsigned char* lx) const {
        const int row0 = u.pm * 256 + wr * 64 + fr, col0 = u.pn * 256 + wc * 32 + 4 * fq;
#pragma unroll
        for (int ai = 0; ai < 2; ++ai)
#pragma unroll
            for (int m = 0; m < 4; ++m) {
                const int row = row0 + ai * 128 + m * 16; const float* gp = gate + (size_t)(row >> 11) * 6144 + col0; const size_t off = (size_t)row * 1024 + col0;
                const float r3 = ((const LAS float*)lx)[(ai * 128 + wr * 64 + m * 16 + fr) * 4];
#pragma unroll
                for (int bj = 0; bj < 2; ++bj)
#pragma unroll
                    for (int n = 0; n < 2; ++n) { const int c = bj * 128 + n * 16; const f32x4 gv = *(const f32x4*)(gp + c), bs = *(const f32x4*)(base + off + c);
                        *(f32x4*)(out + off + c) = bs + gv * (acc[ai][bj][m][n] * r3); }
            }
    }
};
struct NormOut { bf16_t* dst; const float* gain; const float* sh; const float* sc; int bstride; };
template <bool HEAD, int NX> struct EpiResNorm {
    static constexpr bool PERM = !HEAD, KHOOK = HEAD;
    static constexpr int FQS = PERM ? 8 : 4, NS = PERM ? 4 : 16;
    const float* base; float* out; const float* gate; const float* ssq; NormOut no[2]; float* slots; unsigned* cnt; unsigned target;
    __device__ __forceinline__ void prep(const Unit& u, LAS unsigned char* lx) const {
        const int t = threadIdx.x;
        if (t < 256) {
            const f32x4* p = (const f32x4*)(ssq + (size_t)(u.pm * 256 + t) * 32);
            float ri[4];
#pragma unroll
            for (int h = 0; h < 4; ++h) { const f32x4 a = p[2 * h], b = p[2 * h + 1]; const float sm = ((a[0] + a[1]) + (a[2] + a[3])) + ((b[0] + b[1]) + (b[2] + b[3])); ri[h] = 1.0f / sqrtf(sm * (1.0f / 512.0f) + EPS); }
            *(LAS f32x4*)(lx + t * 16) = (f32x4){ri[3], ri[0] / ri[1], ri[1] / ri[2], ri[2] / ri[3]};
        }
        asm volatile("s_waitcnt lgkmcnt(0)" ::: "memory");
    }
    __device__ __forceinline__ void khook(f32x4 (&acc)[2][2][4][2], int hb, int wr, int fr, LAS unsigned char* lx) const {
        int rb = wr * 64 + fr; asm volatile("" : "+v"(rb));
#pragma unroll
        for (int ai = 0; ai < 2; ++ai)
#pragma unroll
            for (int m = 0; m < 4; ++m) { const float f = ((const LAS float*)lx)[(ai * 128 + rb + m * 16) * 4 + hb];
#pragma unroll
                for (int bj = 0; bj < 2; ++bj)
#pragma unroll
                    for (int n = 0; n < 2; ++n) acc[ai][bj][m][n] = acc[ai][bj][m][n] * f; }
    }
    __device__ __forceinline__ void operator()(f32x4 (&acc)[2][2][4][2], const Unit& u, int wr, int wc, int fr, int fq, LAS unsigned char* lx) const {
        LAS float* P = (LAS float*)(lx + 4096);
        LAS float* Sr = (LAS float*)(lx + 9216);
        const int row0 = u.pm * 256 + wr * 64 + fr, col0 = u.pn * 256 + wc * 32 + FQS * fq, wid = wr * 4 + wc, b = (u.pm * 256) >> 11;
        const int lane = (int)__builtin_amdgcn_mbcnt_hi(~0u, __builtin_amdgcn_mbcnt_lo(~0u, 0u));
        const float* gp = gate + (size_t)b * 6144 + col0;
        int rb = wr * 64 + fr; asm volatile("" : "+v"(rb));
#pragma unroll
        for (int ai = 0; ai < 2; ++ai)
#pragma unroll
            for (int m = 0; m < 4; ++m) {
                const int row = row0 + ai * 128 + m * 16; const size_t off = (size_t)row * 1024 + col0;
                const float r3 = HEAD ? ((const LAS float*)lx)[(ai * 128 + rb + m * 16) * 4] : 1.0f;
                float ss = 0.f;
#pragma unroll
                for (int bj = 0; bj < 2; ++bj)
#pragma unroll
                    for (int n = 0; n < 2; ++n) { const int c = bj * 128 + n * NS; const f32x4 gv = *(const f32x4*)(gp + c), bs = *(const f32x4*)(base + off + c);
                        const f32x4 v = bs + gv * (HEAD ? acc[ai][bj][m][n] * r3 : acc[ai][bj][m][n]); acc[ai][bj][m][n] = v; *(f32x4*)(out + off + c) = v;
                        ss += (v[0] * v[0] + v[1] * v[1]) + (v[2] * v[2] + v[3] * v[3]); }
                ss += __shfl_xor(ss, 16); ss += __shfl_xor(ss, 32);
                if (fq == 0) P[(ai * 128 + rb + m * 16) * 4 + wc] = ss;
            }
        asm volatile("s_waitcnt lgkmcnt(0)" ::: "memory"); __builtin_amdgcn_s_barrier(); asm volatile("" ::: "memory");
        const int rl = wid * 32 + (lane & 31);
        if (lane < 32) { const f32x4 p = *(const LAS f32x4*)(P + rl * 4); const float sm = (p[0] + p[1]) + (p[2] + p[3]);
            __hip_atomic_store(slots + (size_t)(u.pm * 256 + rl) * 4 + u.pn, sm, __ATOMIC_RELAXED, __HIP_MEMORY_SCOPE_AGENT); }
        asm volatile("s_waitcnt vmcnt(0)" ::: "memory");
        if (lane == 0) __hip_atomic_fetch_add(cnt + 16 * u.pm, 1u, __ATOMIC_RELAXED, __HIP_MEMORY_SCOPE_AGENT);
        if (wid == 0) {
            unsigned sp = 0;
            while ((unsigned)__builtin_amdgcn_readfirstlane(__hip_atomic_load(cnt + 16 * u.pm, __ATOMIC_RELAXED, __HIP_MEMORY_SCOPE_AGENT)) < target) { __builtin_amdgcn_s_sleep(2); if (++sp > (1u << 16)) break; }
            __builtin_amdgcn_fence(__ATOMIC_ACQUIRE, "agent");
            asm volatile("s_waitcnt vmcnt(0)" ::: "memory");
        }
        asm volatile("s_waitcnt vmcnt(0) lgkmcnt(0)" ::: "memory"); __builtin_amdgcn_s_barrier(); asm volatile("" ::: "memory");
        if (lane < 32) { const float* sl = slots + (size_t)(u.pm * 256 + rl) * 4; float t = 0.f;
#pragma unroll
            for (int k = 0; k < 4; ++k) t += __hip_atomic_load(sl + k, __ATOMIC_RELAXED, __HIP_MEMORY_SCOPE_AGENT);
            Sr[rl] = 1.0f / sqrtf(t * (1.0f / DM) + EPS); }
        asm volatile("s_waitcnt vmcnt(0) lgkmcnt(0)" ::: "memory"); __builtin_amdgcn_s_barrier(); asm volatile("" ::: "memory");
#pragma unroll
        for (int ai = 0; ai < 2; ++ai)
#pragma unroll
            for (int m = 0; m < 4; ++m) {
                const int rloc = ai * 128 + rb + m * 16; const float ri = Sr[rloc]; const size_t off = (size_t)(u.pm * 256 + rloc) * 1024 + col0;
#pragma unroll
                for (int bj = 0; bj < 2; ++bj)
#pragma unroll
                    for (int n = 0; n < 2; ++n) { const int c = col0 + bj * 128 + n * NS; const f32x4 vr = acc[ai][bj][m][n] * ri;
#pragma unroll
                        for (int x = 0; x < NX; ++x) { const f32x4 g4 = *(const f32x4*)(no[x].gain + c), s4 = *(const f32x4*)(no[x].sc + (size_t)b * no[x].bstride + c), h4 = *(const f32x4*)(no[x].sh + (size_t)b * no[x].bstride + c);
                            const f32x4 h = vr * g4 * (s4 + 1.0f) + h4; u32x2 w; w.x = cvt_pk_bf16(h[0], h[1]); w.y = cvt_pk_bf16(h[2], h[3]); *(u32x2*)(no[x].dst + off + bj * 128 + n * NS) = w; } }
            }
    }
};
struct EpiResFinal {
    static constexpr bool PERM = true, KHOOK = false;
    const float* base; float* out; const float* gate; const float* gain; float* slots; unsigned* cnt; unsigned target;
    __device__ __forceinline__ void operator()(f32x4 (&acc)[2][2][4][2], const Unit& u, int wr, int wc, int fr, int fq, LAS unsigned char* lx) const {
        LAS float* P = (LAS float*)lx;
        LAS float* Sr = (LAS float*)(lx + 4096);
        const int row0 = u.pm * 256 + wr * 64 + fr, col0 = u.pn * 256 + wc * 32 + 8 * fq, wid = wr * 4 + wc;
        const int lane = (int)__builtin_amdgcn_mbcnt_hi(~0u, __builtin_amdgcn_mbcnt_lo(~0u, 0u));
#pragma unroll
        for (int ai = 0; ai < 2; ++ai)
#pragma unroll
            for (int m = 0; m < 4; ++m) {
                const int row = row0 + ai * 128 + m * 16; const float* gp = gate + (size_t)(row >> 11) * 6144 + col0; const size_t off = (size_t)row * 1024 + col0;
                float ss = 0.f;
#pragma unroll
                for (int bj = 0; bj < 2; ++bj)
#pragma unroll
                    for (int n = 0; n < 2; ++n) { const int c = bj * 128 + n * 4; const f32x4 gv = *(const f32x4*)(gp + c), bs = *(const f32x4*)(base + off + c);
                        const f32x4 v = bs + gv * acc[ai][bj][m][n]; acc[ai][bj][m][n] = v; ss += (v[0] * v[0] + v[1] * v[1]) + (v[2] * v[2] + v[3] * v[3]); }
                ss += __shfl_xor(ss, 16); ss += __shfl_xor(ss, 32);
                if (fq == 0) P[(ai * 128 + wr * 64 + m * 16 + fr) * 4 + wc] = ss;
            }
        asm volatile("s_waitcnt lgkmcnt(0)" ::: "memory"); __builtin_amdgcn_s_barrier(); asm volatile("" ::: "memory");
        const int rl = wid * 32 + (lane & 31);
        if (lane < 32) { const f32x4 p = *(const LAS f32x4*)(P + rl * 4); const float sm = (p[0] + p[1]) + (p[2] + p[3]);
            __hip_atomic_store(slots + (size_t)(u.pm * 256 + rl) * 4 + u.pn, sm, __ATOMIC_RELAXED, __HIP_MEMORY_SCOPE_AGENT); }
        asm volatile("s_waitcnt vmcnt(0)" ::: "memory");
        if (lane == 0) __hip_atomic_fetch_add(cnt + 16 * u.pm, 1u, __ATOMIC_RELAXED, __HIP_MEMORY_SCOPE_AGENT);
        if (wid == 0) {
            unsigned sp = 0;
            while ((unsigned)__builtin_amdgcn_readfirstlane(__hip_atomic_load(cnt + 16 * u.pm, __ATOMIC_RELAXED, __HIP_MEMORY_SCOPE_AGENT)) < target) { __builtin_amdgcn_s_sleep(2); if (++sp > (1u << 16)) break; }
            __builtin_amdgcn_fence(__ATOMIC_ACQUIRE, "agent");
            asm volatile("s_waitcnt vmcnt(0)" ::: "memory");
        }
        asm volatile("s_waitcnt vmcnt(0) lgkmcnt(0)" ::: "memory"); __builtin_amdgcn_s_barrier(); asm volatile("" ::: "memory");
        if (lane < 32) { const float* sl = slots + (size_t)(u.pm * 256 + rl) * 4; float t = 0.f;
#pragma unroll
            for (int k = 0; k < 4; ++k) t += __hip_atomic_load(sl + k, __ATOMIC_RELAXED, __HIP_MEMORY_SCOPE_AGENT);
            Sr[rl] = 1.0f / sqrtf(t * (1.0f / DM) + EPS); }
        asm volatile("s_waitcnt vmcnt(0) lgkmcnt(0)" ::: "memory"); __builtin_amdgcn_s_barrier(); asm volatile("" ::: "memory");
#pragma unroll
        for (int ai = 0; ai < 2; ++ai)
#pragma unroll
            for (int m = 0; m < 4; ++m) {
                const int rloc = ai * 128 + wr * 64 + m * 16 + fr; const float ri = Sr[rloc]; const size_t off = (size_t)(u.pm * 256 + rloc) * 1024 + col0;
#pragma unroll
                for (int bj = 0; bj < 2; ++bj)
#pragma unroll
                    for (int n = 0; n < 2; ++n) { const int c = bj * 128 + n * 4; __builtin_nontemporal_store(acc[ai][bj][m][n] * ri * *(const f32x4*)(gain + col0 + c), (f32x4*)(out + off + c)); }
            }
    }
};
struct EpiRope {
    static constexpr bool PERM = true, KHOOK = false;
    bf16_t* dstR; bf16_t* dstV; int nrope; const float* tab; float scale;
    __device__ __forceinline__ void operator()(const f32x4 (&acc)[2][2][4][2], const Unit& u, int wr, int wc, int fr, int fq, LAS unsigned char*) const {
        const int row0 = u.pm * 256 + wr * 64 + fr, cw = wc * 32 + 8 * fq;
        if (u.pn < nrope) {
            const int p = cw >> 6, dd = cw & 63;
            bf16_t* dst = dstR + u.pn * 256 + p * 128 + dd;
#pragma unroll
            for (int ai = 0; ai < 2; ++ai)
#pragma unroll
                for (int m = 0; m < 4; ++m) {
                    const int row = row0 + ai * 128 + m * 16, pos = row & 2047;
                    const f32x4* tp = (const f32x4*)(tab + ((size_t)pos * 64 + dd) * 2);
                    const f32x4 t0 = tp[0], t1 = tp[1], t2 = tp[2], t3 = tp[3];
                    const f32x4 cs0 = {t0[0], t0[2], t1[0], t1[2]}, sn0 = {t0[1], t0[3], t1[1], t1[3]}, cs1 = {t2[0], t2[2], t3[0], t3[2]}, sn1 = {t2[1], t2[3], t3[1], t3[3]};
                    const f32x4 x10 = acc[ai][0][m][0], x11 = acc[ai][0][m][1], x20 = acc[ai][1][m][0], x21 = acc[ai][1][m][1];
                    const f32x4 o10 = (x10 * cs0 - x20 * sn0) * scale, o11 = (x11 * cs1 - x21 * sn1) * scale;
                    const f32x4 o20 = (x20 * cs0 + x10 * sn0) * scale, o21 = (x21 * cs1 + x11 * sn1) * scale;
                    bf16_t* rp = dst + (size_t)row * 1024;
                    *(u32x4*)rp = pack8(o10, o11); *(u32x4*)(rp + 64) = pack8(o20, o21);
                }
        } else {
            bf16_t* dst = dstV + (u.pn - nrope) * 256 + cw;
#pragma unroll
            for (int ai = 0; ai < 2; ++ai)
#pragma unroll
                for (int m = 0; m < 4; ++m) {
                    bf16_t* rp = dst + (size_t)(row0 + ai * 128 + m * 16) * 1024;
#pragma unroll
                    for (int bj = 0; bj < 2; ++bj) *(u32x4*)(rp + bj * 128) = pack8(acc[ai][bj][m][0], acc[ai][bj][m][1]);
                }
        }
    }
};
__device__ __forceinline__ float dpp_shr1(float v) { return __builtin_bit_cast(float, __builtin_amdgcn_update_dpp(0, __builtin_bit_cast(int, v), 0x111, 0xf, 0xf, true)); }
__device__ __forceinline__ float dpp_shr2(float v) { return __builtin_bit_cast(float, __builtin_amdgcn_update_dpp(0, __builtin_bit_cast(int, v), 0x112, 0xf, 0xf, true)); }
__device__ __forceinline__ float dpp_ror1(float v) { return __builtin_bit_cast(float, __builtin_amdgcn_update_dpp(0, __builtin_bit_cast(int, v), 0x121, 0xf, 0xf, false)); }
__device__ __forceinline__ float dpp_shr1_old(float old, float v) { return __builtin_bit_cast(float, __builtin_amdgcn_update_dpp(__builtin_bit_cast(int, old), __builtin_bit_cast(int, v), 0x111, 0xf, 0xf, false)); }
__device__ __forceinline__ float dpp_shr2_old(float old, float v) { return __builtin_bit_cast(float, __builtin_amdgcn_update_dpp(__builtin_bit_cast(int, old), __builtin_bit_cast(int, v), 0x112, 0xf, 0xf, false)); }
__device__ __forceinline__ float dpp_ror2(float v) { return __builtin_bit_cast(float, __builtin_amdgcn_update_dpp(0, __builtin_bit_cast(int, v), 0x122, 0xf, 0xf, false)); }
struct EpiFfn {
    static constexpr bool PERM = true, KHOOK = false;
    bf16_t* U; const float* wconv; const float* bconv;
    __device__ __forceinline__ void operator()(const f32x4 (&acc)[2][2][4][2], const Unit& u, int wr, int wc, int fr, int fq, LAS unsigned char* lx) const {
        const int cw = wc * 32 + 8 * fq, j0 = u.pn * 128 + cw;
        f32x4 w0[2], w1[2], w2[2], bc[2];
#pragma unroll
        for (int n = 0; n < 2; ++n) { w0[n] = *(const f32x4*)(wconv + j0 + 4 * n); w1[n] = *(const f32x4*)(wconv + DFF + j0 + 4 * n); w2[n] = *(const f32x4*)(wconv + 2 * DFF + j0 + 4 * n); bc[n] = *(const f32x4*)(bconv + j0 + 4 * n); }
        LAS float* hx = (LAS float*)lx;
        if (fr >= 14) {
#pragma unroll
            for (int ai = 0; ai < 2; ++ai) { LAS float* p = hx + ((((2 * ai + wr) * 4 + wc) * 2 + (fr - 14)) * 4 + fq) * 8;
                *(LAS f32x4*)p = acc[ai][0][3][0]; *(LAS f32x4*)(p + 4) = acc[ai][0][3][1]; }
        }
        asm volatile("s_waitcnt lgkmcnt(0)" ::: "memory"); __builtin_amdgcn_s_barrier(); asm volatile("" ::: "memory");
        const int rr = fr >= 14 ? fr - 14 : 0;
#pragma unroll
        for (int ai = 0; ai < 2; ++ai) {
            const int qc = 2 * ai + wr;
            f32x4 pv[2] = {(f32x4){0.f, 0.f, 0.f, 0.f}, (f32x4){0.f, 0.f, 0.f, 0.f}};
            if (qc >= 1) { const LAS float* p = hx + (((((qc - 1) * 4 + wc) * 2 + rr) * 4 + fq) * 8); pv[0] = *(const LAS f32x4*)p; pv[1] = *(const LAS f32x4*)(p + 4); }
#pragma unroll
            for (int m = 0; m < 4; ++m) {
                const int trow = ai * 128 + wr * 64 + m * 16 + fr, grow = u.pm * 254 - 2 + trow, pos = grow & 2047;
                f32x4 res[2];
#pragma unroll
                for (int n = 0; n < 2; ++n) {
                    const f32x4 cur = acc[ai][0][m][n], gg = acc[ai][1][m][n];
                    f32x4 cv;
#pragma unroll
                    for (int j = 0; j < 4; ++j) {
                        float a1 = dpp_shr1_old(dpp_ror1(pv[n][j]), cur[j]), a2 = dpp_shr2_old(dpp_ror2(pv[n][j]), cur[j]);
                        a1 = pos < 1 ? 0.f : a1; a2 = pos < 2 ? 0.f : a2;
                        cv[j] = w0[n][j] * a2 + w1[n][j] * a1 + w2[n][j] * cur[j] + bc[n][j];
                    }
                    const f32x2 ga = gelu_pk((f32x2){cv[0], cv[1]}), gb = gelu_pk((f32x2){cv[2], cv[3]});
                    res[n] = (f32x4){ga.x * gg[0], ga.y * gg[1], gb.x * gg[2], gb.y * gg[3]};
                    pv[n] = cur;
                }
                if (trow >= 2 && grow < TOK) *(u32x4*)(U + (size_t)grow * DFF + j0) = pack8(res[0], res[1]);
            }
        }
    }
};

__device__ __forceinline__ int rowmap(int kind, int n) {
    if (kind == 0) return n;
    if (kind == 1) { const int half = n >= DFF ? 1 : 0, j = n - half * DFF; return (j >> 7) * 256 + half * 128 + (j & 127); }
    const int h = n >> 8, p = (n >> 7) & 1, d = n & 127; return h * 256 + (d >> 6) * 128 + p * 64 + (d & 63);
}
__device__ __forceinline__ void transpose_item(const float* W, int ldw, int col0, int ncols, int K, bf16_t* WT, int kind, int row_off, LAS float* scr, int item, int lane) {
    const int nblk = ncols / 32, kb = item / nblk, nb = item % nblk, k0 = 64 * kb, n0 = 32 * nb;
    f32x4 v[8];
#pragma unroll
    for (int i = 0; i < 8; ++i) v[i] = *(const f32x4*)(W + (size_t)(k0 + 8 * i + (lane >> 3)) * ldw + col0 + n0 + 4 * (lane & 7));
#pragma unroll
    for (int i = 0; i < 8; ++i) { LAS float* d = scr + (8 * i + (lane >> 3)) * 33 + 4 * (lane & 7); d[0] = v[i][0]; d[1] = v[i][1]; d[2] = v[i][2]; d[3] = v[i][3]; }
    asm volatile("s_waitcnt lgkmcnt(0)" ::: "memory");
    const int c = lane & 7;
#pragma unroll
    for (int j = 0; j < 4; ++j) { const int n = (lane >> 3) + 8 * j; const LAS float* s = scr + (8 * c) * 33 + n;
        u32x4 o; o.x = cvt_pk_bf16(s[0 * 33], s[1 * 33]); o.y = cvt_pk_bf16(s[2 * 33], s[3 * 33]); o.z = cvt_pk_bf16(s[4 * 33], s[5 * 33]); o.w = cvt_pk_bf16(s[6 * 33], s[7 * 33]);
        *(u32x4*)(WT + (size_t)(row_off + rowmap(kind, n0 + n)) * K + k0 + 8 * c) = o; }
    asm volatile("s_waitcnt lgkmcnt(0)" ::: "memory");
}
__device__ __forceinline__ void mods_item(const float* c, const float* W, int N, int strip, int kc, LAS float* scr, LAS float* red, int lane) {
    const int k0 = kc * 128, n0 = strip * 64;
#pragma unroll
    for (int i = 0; i < 16; ++i) { const int idx = lane + 64 * i, b = idx >> 7, kk = idx & 127; scr[kk * 8 + b] = silu_f(c[b * 1024 + k0 + kk]); }
    asm volatile("s_waitcnt lgkmcnt(0)" ::: "memory");
    float a0 = 0.f, a1 = 0.f, a2 = 0.f, a3 = 0.f, a4 = 0.f, a5 = 0.f, a6 = 0.f, a7 = 0.f;
#pragma unroll 32
    for (int kk = 0; kk < 128; ++kk) {
        const float wv = __builtin_nontemporal_load(W + (size_t)(k0 + kk) * N + n0 + lane);
        const f32x4 s0 = *(const LAS f32x4*)(scr + kk * 8), s1 = *(const LAS f32x4*)(scr + kk * 8 + 4);
        a0 += s0[0] * wv; a1 += s0[1] * wv; a2 += s0[2] * wv; a3 += s0[3] * wv; a4 += s1[0] * wv; a5 += s1[1] * wv; a6 += s1[2] * wv; a7 += s1[3] * wv;
    }
    red[0 * 64 + lane] = a0; red[1 * 64 + lane] = a1; red[2 * 64 + lane] = a2; red[3 * 64 + lane] = a3;
    red[4 * 64 + lane] = a4; red[5 * 64 + lane] = a5; red[6 * 64 + lane] = a6; red[7 * 64 + lane] = a7;
}
__device__ __forceinline__ void sincos_acc(float ang, float& s, float& c) {
    const double x = (double)ang;
    const double k = __builtin_rint(x * 0.6366197723675814);
    double y = __builtin_fma(-k, 1.5707963267948966, x); y = __builtin_fma(-k, 6.123233995736766e-17, y);
    const int q = ((int)k) & 3;
    const double y2 = y * y;
    const double sp = y * (1.0 + y2 * (-1.0 / 6.0 + y2 * (1.0 / 120.0 + y2 * (-1.0 / 5040.0 + y2 * (1.0 / 362880.0 + y2 * (-1.0 / 39916800.0 + y2 * (1.0 / 6227020800.0)))))));
    const double cp = 1.0 + y2 * (-0.5 + y2 * (1.0 / 24.0 + y2 * (-1.0 / 720.0 + y2 * (1.0 / 40320.0 + y2 * (-1.0 / 3628800.0 + y2 * (1.0 / 479001600.0))))));
    const double ss = (q == 0) ? sp : (q == 1) ? cp : (q == 2) ? -sp : -cp;
    const double cc = (q == 0) ? cp : (q == 1) ? -sp : (q == 2) ? -cp : sp;
    s = (float)ss; c = (float)cc;
}

struct Args { const float* in[20]; float* out; unsigned char* ws; int ph_lo, ph_hi; };

template <int PART> __device__ __forceinline__ void p0_prologue(const Args& a, LAS unsigned char* lds, int wave, int lane, int G) {
    LAS float* scr = (LAS float*)(lds + wave * 16384);
    const int gw = blockIdx.x * 8 + wave, NGW = G * 8;
    unsigned char* ws = a.ws;
    if (PART == 0) {
    for (int strip = blockIdx.x; strip < 224; strip += G) {
        LAS float* red = (LAS float*)(lds + wave * 16384 + 8192);
        const float* W; const float* bias; float* out; int N, st;
        if (strip < 96) { W = a.in[3]; bias = a.in[4]; out = (float*)(ws + WS_MOD0); N = 6144; st = strip; }
        else if (strip < 192) { W = a.in[3] + (size_t)1024 * 6144; bias = a.in[4] + 6144; out = (float*)(ws + WS_MOD1); N = 6144; st = strip - 96; }
        else { W = a.in[12]; bias = a.in[13]; out = (float*)(ws + WS_KVMOD); N = 2048; st = strip - 192; }
        mods_item(a.in[1], W, N, st, wave, scr, red, lane);
        __syncthreads();
        { float sum = bias[st * 64 + lane];
#pragma unroll
          for (int kc = 0; kc < 8; ++kc) sum += ((const LAS float*)(lds + kc * 16384 + 8192))[wave * 64 + lane];
          out[(size_t)wave * N + st * 64 + lane] = sum; }
        __syncthreads();
    }
    }
    if (PART == 1) {
    {
        constexpr int T_RIN = (1024 / 128) * (6144 / 64), T_ROUT = (2048 / 128) * (1024 / 64), T_FIN = (1024 / 128) * (NFF / 64), T_FDN = (DFF / 128) * (1024 / 64), T_SQ = (1024 / 128) * (1024 / 64);
        constexpr int NTILES = T_RIN + T_ROUT + 2 * T_FIN + 2 * T_FDN + 4 * T_SQ;
        struct TrJob { const float* W; int ldw, col0, ncols, K; bf16_t* WT; int kind, row_off, item; };
        auto decode = [&](int it) -> TrJob {
            int r = it;
            if (r < T_RIN) return TrJob{a.in[5], 6144, 0, 6144, 1024, (bf16_t*)(ws + WS_WRIN), 0, 0, r}; r -= T_RIN;
            if (r < T_ROUT) return TrJob{a.in[6], 1024, 0, 1024, 2048, (bf16_t*)(ws + WS_WROUT), 0, 0, r}; r -= T_ROUT;
            if (r < T_FIN) return TrJob{a.in[7], NFF, 0, NFF, 1024, (bf16_t*)(ws + WS_WFIN0), 1, 0, r}; r -= T_FIN;
            if (r < T_FIN) return TrJob{a.in[7] + (size_t)1024 * NFF, NFF, 0, NFF, 1024, (bf16_t*)(ws + WS_WFIN1), 1, 0, r}; r -= T_FIN;
            if (r < T_FDN) return TrJob{a.in[10], 1024, 0, 1024, DFF, (bf16_t*)(ws + WS_WFDN0), 0, 0, r}; r -= T_FDN;
            if (r < T_FDN) return TrJob{a.in[10] + (size_t)DFF * 1024, 1024, 0, 1024, DFF, (bf16_t*)(ws + WS_WFDN1), 0, 0, r}; r -= T_FDN;
            if (r < T_SQ) return TrJob{a.in[14], 2048, 0, 1024, 1024, (bf16_t*)(ws + WS_WKV), 2, 0, r}; r -= T_SQ;
            if (r < T_SQ) return TrJob{a.in[14], 2048, 1024, 1024, 1024, (bf16_t*)(ws + WS_WKV), 0, 1024, r}; r -= T_SQ;
            if (r < T_SQ) return TrJob{a.in[15], 1024, 0, 1024, 1024, (bf16_t*)(ws + WS_WQ), 2, 0, r}; r -= T_SQ;
            return TrJob{a.in[18], 1024, 0, 1024, 1024, (bf16_t*)(ws + WS_WO), 0, 0, r};
        };
        const int tid = threadIdx.x, c4 = tid & 15, rp = tid >> 4;
        f32x4 v[4];
        int it = blockIdx.x;
        TrJob cur = decode(it < NTILES ? it : 0);
#define TR_LOAD(j_) do { const int nblk_ = (j_).ncols / 64, k0_ = 128 * ((j_).item / nblk_), n0_ = 64 * ((j_).item % nblk_); \
        _Pragma("unroll") for (int i = 0; i < 2; ++i) { const float* p_ = (j_).W + (size_t)(k0_ + 2 * (32 * i + rp)) * (j_).ldw + (j_).col0 + n0_ + 4 * c4; v[2 * i] = __builtin_nontemporal_load((const f32x4*)p_); v[2 * i + 1] = __builtin_nontemporal_load((const f32x4*)(p_ + (j_).ldw)); } } while (0)
        if (it < NTILES) TR_LOAD(cur);
        int buf = 0;
        for (; it < NTILES; it += G) {
            LAS unsigned* tile = (LAS unsigned*)(lds + buf * 16896);
#pragma unroll
            for (int i = 0; i < 2; ++i) { LAS unsigned* d = tile + (32 * i + rp) * 65 + 4 * c4;
                d[0] = cvt_pk_bf16(v[2 * i][0], v[2 * i + 1][0]); d[1] = cvt_pk_bf16(v[2 * i][1], v[2 * i + 1][1]); d[2] = cvt_pk_bf16(v[2 * i][2], v[2 * i + 1][2]); d[3] = cvt_pk_bf16(v[2 * i][3], v[2 * i + 1][3]); }
            __syncthreads();
            const TrJob job = cur;
            if (it + G < NTILES) { cur = decode(it + G); TR_LOAD(cur); }
            { const int nblk = job.ncols / 64, k0 = 128 * (job.item / nblk), n0 = 64 * (job.item % nblk);
#pragma unroll
              for (int p = 0; p < 2; ++p) { const int n = 32 * p + rp; const LAS unsigned* sp = tile + (4 * c4) * 65 + n;
                  u32x4 o; o.x = sp[0]; o.y = sp[65]; o.z = sp[130]; o.w = sp[195];
                  __builtin_nontemporal_store(o, (u32x4*)(job.WT + (size_t)(job.row_off + rowmap(job.kind, n0 + n)) * job.K + k0 + 8 * c4)); } }
            buf ^= 1;
        }
#undef TR_LOAD
        __syncthreads();
    }
    const int gt = blockIdx.x * 512 + threadIdx.x, NGT = G * 512;
    f32x2* tabR = (f32x2*)(ws + WS_TABR); f32x2* tabD = (f32x2*)(ws + WS_TABD);
    for (int i = gt; i < 2048 * 128; i += NGT) { const int pos = i >> 7, f = i & 127; const float fr = exp2f(-13.287712379549449f * ((float)f / 127.0f)); float s, c; sincos_acc((float)pos * fr, s, c); tabR[i] = (f32x2){c, s}; }
    for (int i = gt; i < 2048 * 64; i += NGT) { const int pos = i >> 6, f = i & 63; const float fr = exp2f(-13.287712379549449f * ((float)f / 64.0f)); float s, c; sincos_acc((float)pos * fr, s, c); tabD[i] = (f32x2){c, s}; }
    }
    if (PART == 0 && gw == 0) {
        const float* lv = a.in[16];
        float d0 = lv[lane] * lv[128 + lane] + lv[64 + lane] * lv[128 + 64 + lane];
        float d1 = lv[256 + lane] * lv[384 + lane] + lv[256 + 64 + lane] * lv[384 + 64 + lane];
        d0 = wave_sum(d0); d1 = wave_sum(d1);
        const float lam_init = 0.8f - 0.6f * expf(-0.3f);
        if (lane == 0) { float* lp = (float*)(ws + WS_LAM); lp[0] = expf(d0) - expf(d1) + lam_init; lp[1] = 1.0f - lam_init; }
    }
}

struct NM { const float* gain; const float* sh; const float* sc; int bstride; bf16_t* dst; };
constexpr int RW = 4;
template <bool TWO>
__device__ __forceinline__ void normmod_phase(const float* src, const NM A, const NM Bq, int gw, int NGW, int lane) {
    for (int row = gw; row < TOK; row += RW * NGW) {
        f32x4 v[RW][4]; float rinv[RW];
#pragma unroll
        for (int r = 0; r < RW; ++r) { const int rw = row + r * NGW < TOK ? row + r * NGW : row; const f32x4* xr = (const f32x4*)(src + (size_t)rw * DM) + lane;
#pragma unroll
            for (int j = 0; j < 4; ++j) v[r][j] = xr[64 * j]; }
#pragma unroll
        for (int r = 0; r < RW; ++r) { float ss = 0.f;
#pragma unroll
            for (int j = 0; j < 4; ++j) ss += (v[r][j][0] * v[r][j][0] + v[r][j][1] * v[r][j][1]) + (v[r][j][2] * v[r][j][2] + v[r][j][3] * v[r][j][3]);
            rinv[r] = 1.0f / sqrtf(wave_sum(ss) * (1.0f / DM) + EPS); }
#pragma unroll
        for (int r = 0; r < RW; ++r) {
            const int rw = row + r * NGW; if (rw >= TOK) break;
            const int b = rw >> 11;
#pragma unroll
            for (int j = 0; j < 4; ++j) {
                const int k0 = 256 * j + 4 * lane;
                { const f32x4 g = *(const f32x4*)(A.gain + k0), sc = *(const f32x4*)(A.sc + (size_t)b * A.bstride + k0), sh = *(const f32x4*)(A.sh + (size_t)b * A.bstride + k0);
                  const f32x4 o = v[r][j] * rinv[r] * g * (sc + 1.0f) + sh; u32x2 w; w.x = cvt_pk_bf16(o[0], o[1]); w.y = cvt_pk_bf16(o[2], o[3]); *(u32x2*)(A.dst + (size_t)rw * DM + k0) = w; }
                if (TWO) { const f32x4 g = *(const f32x4*)(Bq.gain + k0), sc = *(const f32x4*)(Bq.sc + (size_t)b * Bq.bstride + k0), sh = *(const f32x4*)(Bq.sh + (size_t)b * Bq.bstride + k0);
                  const f32x4 o = v[r][j] * rinv[r] * g * (sc + 1.0f) + sh; u32x2 w; w.x = cvt_pk_bf16(o[0], o[1]); w.y = cvt_pk_bf16(o[2], o[3]); *(u32x2*)(Bq.dst + (size_t)rw * DM + k0) = w; }
            }
        }
    }
}
__device__ __forceinline__ void gate_phase(const bf16_t* O, const bf16_t* Gt, bf16_t* Y, int gw, int NGW, int lane) {
    for (int idx0 = gw; idx0 < TOK * 4; idx0 += RW * NGW) {
        u32x4 ov[RW], gv[RW];
#pragma unroll
        for (int r = 0; r < RW; ++r) { const int ix = idx0 + r * NGW < TOK * 4 ? idx0 + r * NGW : idx0; const size_t off = (size_t)ix * 512 + 8 * lane; ov[r] = *(const u32x4*)(O + off); gv[r] = *(const u32x4*)(Gt + off); }
#pragma unroll
        for (int r = 0; r < RW; ++r) {
            const int ix = idx0 + r * NGW; if (ix >= TOK * 4) break;
            float o[8], g[8];
            o[0] = bf_lo(ov[r].x); o[1] = bf_hi(ov[r].x); o[2] = bf_lo(ov[r].y); o[3] = bf_hi(ov[r].y); o[4] = bf_lo(ov[r].z); o[5] = bf_hi(ov[r].z); o[6] = bf_lo(ov[r].w); o[7] = bf_hi(ov[r].w);
            g[0] = bf_lo(gv[r].x); g[1] = bf_hi(gv[r].x); g[2] = bf_lo(gv[r].y); g[3] = bf_hi(gv[r].y); g[4] = bf_lo(gv[r].z); g[5] = bf_hi(gv[r].z); g[6] = bf_lo(gv[r].w); g[7] = bf_hi(gv[r].w);
            float ss = 0.f;
#pragma unroll
            for (int i = 0; i < 8; ++i) ss += o[i] * o[i];
            const float rinv = 1.0f / sqrtf(wave_sum(ss) * (1.0f / 512.0f) + EPS);
            float y[8];
#pragma unroll
            for (int i = 0; i < 8; ++i) y[i] = silu_f(g[i]) * o[i] * rinv;
            u32x4 w; w.x = cvt_pk_bf16(y[0], y[1]); w.y = cvt_pk_bf16(y[2], y[3]); w.z = cvt_pk_bf16(y[4], y[5]); w.w = cvt_pk_bf16(y[6], y[7]);
            *(u32x4*)(Y + (size_t)ix * 512 + 8 * lane) = w;
        }
    }
}
__device__ __forceinline__ void combine_phase(const bf16_t* O0, const bf16_t* O1, bf16_t* Od, const float* gain, const float* lamp, int gw, int NGW, int lane) {
    const float lam = lamp[0], oml = lamp[1];
    const f32x4 gn = *(const f32x4*)(gain + 4 * lane);
    for (int idx0 = gw; idx0 < TOK * 4; idx0 += RW * NGW) {
        u32x2 av[RW], bv[RW];
#pragma unroll
        for (int r = 0; r < RW; ++r) { const int ix = idx0 + r * NGW < TOK * 4 ? idx0 + r * NGW : idx0; const size_t off = (size_t)ix * 256 + 4 * lane; av[r] = *(const u32x2*)(O0 + off); bv[r] = *(const u32x2*)(O1 + off); }
#pragma unroll
        for (int r = 0; r < RW; ++r) {
            const int ix = idx0 + r * NGW; if (ix >= TOK * 4) break;
            const u32x2 a = av[r], b = bv[r];
            f32x4 o = {bf_lo(a.x) - lam * bf_lo(b.x), bf_hi(a.x) - lam * bf_hi(b.x), bf_lo(a.y) - lam * bf_lo(b.y), bf_hi(a.y) - lam * bf_hi(b.y)};
            const float ss = (o[0] * o[0] + o[1] * o[1]) + (o[2] * o[2] + o[3] * o[3]);
            const float rinv = 1.0f / sqrtf(wave_sum(ss) * (1.0f / 256.0f) + EPS);
            o = o * (rinv * oml) * gn;
            u32x2 w; w.x = cvt_pk_bf16(o[0], o[1]); w.y = cvt_pk_bf16(o[2], o[3]); *(u32x2*)(Od + (size_t)ix * 256 + 4 * lane) = w;
        }
    }
}
__device__ __forceinline__ void final_norm_phase(float* X, const float* gain, int gw, int NGW, int lane) {
    for (int row = gw; row < TOK; row += RW * NGW) {
        f32x4 v[RW][4]; float rinv[RW];
#pragma unroll
        for (int r = 0; r < RW; ++r) { const int rw = row + r * NGW < TOK ? row + r * NGW : row; const f32x4* xr = (const f32x4*)(X + (size_t)rw * DM) + lane;
#pragma unroll
            for (int j = 0; j < 4; ++j) v[r][j] = xr[64 * j]; }
#pragma unroll
        for (int r = 0; r < RW; ++r) { float ss = 0.f;
#pragma unroll
            for (int j = 0; j < 4; ++j) ss += (v[r][j][0] * v[r][j][0] + v[r][j][1] * v[r][j][1]) + (v[r][j][2] * v[r][j][2] + v[r][j][3] * v[r][j][3]);
            rinv[r] = 1.0f / sqrtf(wave_sum(ss) * (1.0f / DM) + EPS); }
#pragma unroll
        for (int r = 0; r < RW; ++r) {
            const int rw = row + r * NGW; if (rw >= TOK) break;
            f32x4* xw = (f32x4*)(X + (size_t)rw * DM) + lane;
#pragma unroll
            for (int j = 0; j < 4; ++j) __builtin_nontemporal_store(v[r][j] * rinv[r] * *(const f32x4*)(gain + 256 * j + 4 * lane), xw + 64 * j);
        }
    }
}

__device__ __forceinline__ void retention_phase(LAS unsigned char* lds, const bf16_t* Q, const bf16_t* K, bf16_t* V, const bf16_t* Gt, float* ssqb, int G) {
    const int tid = threadIdx.x, lane = tid & 63, w = __builtin_amdgcn_readfirstlane(tid >> 6), li = lane & 15, fq = lane >> 4, q4 = li >> 2, p4 = li & 3;
    constexpr int KS = 528, VS = 144, SS = 528;
    LAS unsigned char* Ks = lds; LAS unsigned char* Vs = lds + 128 * KS; LAS unsigned char* StT = Vs + 128 * VS;
    const int bx = blockIdx.x; const int vcu = (G % 8 == 0) ? (bx % 8) * (G / 8) + bx / 8 : bx;
    for (int item = vcu; item < 256; item += G) {
        const int bh = item >> 3, sl = item & 7, b = bh >> 2, h = bh & 3;
        const float gam = 1.0f - exp2f(-5.0f - (float)h);
        float g128 = gam;
#pragma unroll
        for (int i = 0; i < 7; ++i) g128 *= g128;
        const float g127 = g128 / gam;
        const bf16_t* Qb = Q + (size_t)b * SEQ * 1024 + h * 256;
        const bf16_t* Kb = K + (size_t)b * SEQ * 1024 + h * 256;
        const bf16_t* Vb = V + (size_t)b * SEQ * 2048 + h * 512 + sl * 64;
        bf16_t* Ob = V + (size_t)b * SEQ * 2048 + h * 512 + sl * 64;
        const bf16_t* Gb = Gt + (size_t)b * SEQ * 2048 + h * 512 + sl * 64;
        __syncthreads();
        for (int i = tid; i < 64 * SS / 16; i += 512) *(LAS u32x4*)(StT + i * 16) = (u32x4){0u, 0u, 0u, 0u};
        f32x4 St[2][4];
#pragma unroll
        for (int mt = 0; mt < 2; ++mt)
#pragma unroll
            for (int nt = 0; nt < 4; ++nt) St[mt][nt] = (f32x4){0.f, 0.f, 0.f, 0.f};
        u32x4 kreg[8], vreg[2]; bf16x8 Qf[8];
        const unsigned voK = (unsigned)((tid >> 5) * 1024 + (tid & 31) * 8) * 2u, voV = (unsigned)((tid >> 3) * 2048 + (tid & 7) * 8) * 2u, voQ = (unsigned)(li * 1024 + 8 * fq) * 2u;
#define RET_LOAD_KV(t0_) do { \
        _Pragma("unroll") for (int i = 0; i < 8; ++i) kreg[i] = *(const u32x4*)((const char*)Kb + (size_t)((t0_) + 16 * i) * 2048 + voK); \
        _Pragma("unroll") for (int i = 0; i < 2; ++i) vreg[i] = *(const u32x4*)((const char*)Vb + (size_t)((t0_) + 64 * i) * 4096 + voV); } while (0)
#define RET_LOAD_Q(t0_) do { _Pragma("unroll") for (int ks = 0; ks < 8; ++ks) Qf[ks] = *(const bf16x8*)((const char*)Qb + (size_t)((t0_) + 16 * w) * 2048 + ks * 64 + voQ); } while (0)
#define RET_WRITE_KV() do { \
        _Pragma("unroll") for (int i = 0; i < 8; ++i) { const int id = tid + 512 * i, r = id >> 5, pc = id & 31; *(LAS u32x4*)(Ks + r * KS + pc * 16) = kreg[i]; } \
        _Pragma("unroll") for (int i = 0; i < 2; ++i) { const int id = tid + 512 * i, r = id >> 3, pc = id & 7; *(LAS u32x4*)(Vs + r * VS + pc * 16) = vreg[i]; } } while (0)
        RET_LOAD_KV(0); RET_LOAD_Q(0);
        RET_WRITE_KV();
        __syncthreads();
#pragma nounroll
        for (int n = 0; n < 16; ++n) {
            const int t0 = n * 128;
            if (n + 1 < 16) RET_LOAD_KV(t0 + 128);
            u32x2 greg[4];
#pragma unroll
            for (int nt = 0; nt < 4; ++nt) greg[nt] = *(const u32x2*)(Gb + (size_t)(t0 + 16 * w + li) * 2048 + 16 * nt + 4 * fq);
            f32x4 accS[8];
#pragma unroll
            for (int kt = 0; kt < 8; ++kt) {
                accS[kt] = (f32x4){0.f, 0.f, 0.f, 0.f};
                if (kt <= w) {
#pragma unroll
                    for (int ks = 0; ks < 8; ++ks) accS[kt] = MFMA16(lds_b128(Ks + (16 * kt + li) * KS + (32 * ks + 8 * fq) * 2), Qf[ks], accS[kt]);
                    __builtin_amdgcn_sched_barrier(0);
                    if (kt == w) {
#pragma unroll
                        for (int r = 0; r < 4; ++r) if (4 * fq + r > li) accS[kt][r] = 0.f;
                    }
                }
            }
            bf16x8 P[4];
#pragma unroll
            for (int s = 0; s < 4; ++s) P[s] = pack_frag(accS[2 * s], accS[2 * s + 1]);
            f32x4 o1[4], o2[4];
#pragma unroll
            for (int nt = 0; nt < 4; ++nt) { o1[nt] = (f32x4){0.f, 0.f, 0.f, 0.f}; o2[nt] = (f32x4){0.f, 0.f, 0.f, 0.f}; }
#pragma unroll
            for (int s = 0; s < 4; ++s) {
                if (2 * s <= w) {
#pragma unroll
                    for (int nt = 0; nt < 4; ++nt) {
                        const bf16x8 av = cat4(lds_tr(Vs + (32 * s + 4 * fq + q4) * VS + (16 * nt + 4 * p4) * 2), lds_tr(Vs + (32 * s + 16 + 4 * fq + q4) * VS + (16 * nt + 4 * p4) * 2));
                        o1[nt] = MFMA16(av, P[s], o1[nt]);
                    }
                }
            }
#pragma unroll
            for (int ks = 0; ks < 8; ++ks)
#pragma unroll
                for (int nt = 0; nt < 4; ++nt) { o2[nt] = MFMA16(lds_b128(StT + (16 * nt + li) * SS + (32 * ks + 8 * fq) * 2), Qf[ks], o2[nt]); if (nt == 3 && (ks & 1)) __builtin_amdgcn_sched_barrier(0); }
            {
                bf16_t* op = Ob + (size_t)(t0 + 16 * w + li) * 2048 + 4 * fq;
                float sq = 0.f;
#pragma unroll
                for (int nt = 0; nt < 4; ++nt) { const f32x4 o = o1[nt] + o2[nt] * gam;
                    sq += (o[0] * o[0] + o[1] * o[1]) + (o[2] * o[2] + o[3] * o[3]);
                    const float y0 = silu_f(bf_lo(greg[nt].x)) * o[0], y1 = silu_f(bf_hi(greg[nt].x)) * o[1], y2 = silu_f(bf_lo(greg[nt].y)) * o[2], y3 = silu_f(bf_hi(greg[nt].y)) * o[3];
                    u32x2 wv; wv.x = cvt_pk_bf16(y0, y1); wv.y = cvt_pk_bf16(y2, y3); *(u32x2*)(op + 16 * nt) = wv; }
                sq += __shfl_xor(sq, 16); sq += __shfl_xor(sq, 32);
                if (fq == 0) ssqb[((size_t)(b * SEQ + t0 + 16 * w + li) * 4 + h) * 8 + sl] = sq;
            }
            if (n + 1 < 16) RET_LOAD_Q(t0 + 128);
            f32x4 tmp[2][4];
#pragma unroll
            for (int mt = 0; mt < 2; ++mt)
#pragma unroll
                for (int nt = 0; nt < 4; ++nt) tmp[mt][nt] = (f32x4){0.f, 0.f, 0.f, 0.f};
#pragma unroll
            for (int s = 0; s < 4; ++s) {
                bf16x8 bv[4];
#pragma unroll
                for (int nt = 0; nt < 4; ++nt) bv[nt] = cat4(lds_tr(Vs + (32 * s + 8 * fq + q4) * VS + (16 * nt + 4 * p4) * 2), lds_tr(Vs + (32 * s + 8 * fq + 4 + q4) * VS + (16 * nt + 4 * p4) * 2));
#pragma unroll
                for (int mt = 0; mt < 2; ++mt) {
                    const bf16x8 ak = cat4(lds_tr(Ks + (32 * s + 8 * fq + q4) * KS + (32 * w + 16 * mt + 4 * p4) * 2), lds_tr(Ks + (32 * s + 8 * fq + 4 + q4) * KS + (32 * w + 16 * mt + 4 * p4) * 2));
#pragma unroll
                    for (int nt = 0; nt < 4; ++nt) tmp[mt][nt] = MFMA16(ak, bv[nt], tmp[mt][nt]);
                }
            }
#pragma unroll
            for (int mt = 0; mt < 2; ++mt)
#pragma unroll
                for (int nt = 0; nt < 4; ++nt) St[mt][nt] = St[mt][nt] * g128 + tmp[mt][nt] * g127;
            if (n + 1 < 16) {
                __syncthreads();
#pragma unroll
                for (int mt = 0; mt < 2; ++mt)
#pragma unroll
                    for (int nt = 0; nt < 4; ++nt) {
                        u32x2 wv; wv.x = cvt_pk_bf16(St[mt][nt][0], St[mt][nt][1]); wv.y = cvt_pk_bf16(St[mt][nt][2], St[mt][nt][3]);
                        *(LAS u32x2*)(StT + (16 * nt + li) * SS + (32 * w + 16 * mt + 4 * fq) * 2) = wv;
                    }
                RET_WRITE_KV();
                __syncthreads();
            }
        }
    }
#undef RET_WRITE_KV
#undef RET_LOAD_KV
#undef RET_LOAD_Q
    __syncthreads();
}

__device__ __forceinline__ void attn_phase(LAS unsigned char* lds, const bf16_t* Qd, const bf16_t* Kd, const bf16_t* Vd, bf16_t* O0, bf16_t* O1, int G) {
    const int tid = threadIdx.x, lane = tid & 63, w = __builtin_amdgcn_readfirstlane(tid >> 6), li = lane & 15, fq = lane >> 4, q4 = li >> 2, p4 = li & 3;
    constexpr int KS = 272, VS = 544, SLOT = 32768;
    const float NEG = -__builtin_inff();
    const unsigned ldsb = (unsigned)(size_t)lds;
    int soff[4]; bool isv[4];
#pragma unroll
    for (int i = 0; i < 4; ++i) {
        const int q = (w * 4 + i) * 64 + lane;
        if (q < 544) { const int row = q / 17, pc = q % 17; soff[i] = row * 1024 + (pc < 16 ? pc : 15) * 8; isv[i] = false; }
        else if (q < 1632) { const int q2 = q - 544, row = q2 / 34, pc = q2 % 34; soff[i] = row * 1024 + (pc < 32 ? pc : 31) * 8; isv[i] = true; }
        else { soff[i] = 0; isv[i] = false; }
    }
    for (int idx = blockIdx.x; idx < 512; idx += G) {
        const int r = idx >> 8, c = idx & 255, xc = c & 7, l = c >> 3, qbi = l & 7;
        const int bh = 4 * xc + 2 * r + (l >> 4), p = (l >> 3) & 1, b = bh >> 2, h = bh & 3;
        const int qb = r ? 7 - qbi : qbi;
        const int q0 = qb * 256, nkt = 8 * (qb + 1);
        const int r0 = q0 + 16 * w, r1 = q0 + 16 * (15 - w);
        const bf16_t* Kp = Kd + (size_t)b * SEQ * 1024 + h * 256 + p * 128;
        const bf16_t* Vp = Vd + (size_t)b * SEQ * 1024 + h * 256;
        const bf16_t* src[4];
#pragma unroll
        for (int i = 0; i < 4; ++i) src[i] = (isv[i] ? Vp : Kp) + soff[i];
        bf16x8 Qf[2][4];
#pragma unroll
        for (int u = 0; u < 2; ++u)
#pragma unroll
            for (int ks = 0; ks < 4; ++ks) Qf[u][ks] = *(const bf16x8*)(Qd + (size_t)(b * SEQ + (u ? r1 : r0) + li) * 1024 + h * 256 + p * 128 + 32 * ks + 8 * fq);
#define ATT_DMA(tile_, slot_) do { const size_t ko_ = (size_t)(tile_) * (32 * 1024); const unsigned lb_ = ldsb + (unsigned)(slot_) * SLOT + (unsigned)(w * 4) * 1024u; _Pragma("unroll") for (int i = 0; i < 4; ++i) \
        glds16_asm(src[i] + ko_, __builtin_amdgcn_readfirstlane(lb_ + i * 1024)); } while (0)
#pragma unroll
        for (int u = 0; u < 2; ++u)
#pragma unroll
            for (int ks = 0; ks < 4; ++ks) asm volatile("" : "+v"(Qf[u][ks]));
        asm volatile("s_waitcnt lgkmcnt(0)\n\ts_barrier" ::: "memory");
        ATT_DMA(0, 0); ATT_DMA(1, 1); ATT_DMA(2, 2);
        float mrun[2] = {NEG, NEG}, lrun[2] = {0.f, 0.f};
        f32x4 O[2][16];
#pragma unroll
        for (int u = 0; u < 2; ++u)
#pragma unroll
            for (int nt = 0; nt < 16; ++nt) O[u][nt] = (f32x4){0.f, 0.f, 0.f, 0.f};
#define ATT_BODY(A0) do { \
                const LAS unsigned char* Kt = lds + (kt & 3) * SLOT; const LAS unsigned char* Vt = Kt + 32 * KS; \
                f32x4 sv[2][2]; \
                _Pragma("unroll") for (int u = 0; u < 2; ++u) _Pragma("unroll") for (int kk = 0; kk < 2; ++kk) sv[u][kk] = (f32x4){0.f, 0.f, 0.f, 0.f}; \
                __builtin_amdgcn_s_setprio(1); \
                _Pragma("unroll") for (int kk = 0; kk < 2; ++kk) _Pragma("unroll") for (int ks = 0; ks < 4; ++ks) { \
                    const bf16x8 a = lds_b128(Kt + (16 * kk + li) * KS + (32 * ks + 8 * fq) * 2); \
                    if (A0) sv[0][kk] = MFMA16(a, Qf[0][ks], sv[0][kk]); sv[1][kk] = MFMA16(a, Qf[1][ks], sv[1][kk]); } \
                __builtin_amdgcn_s_setprio(0); \
                _Pragma("unroll") for (int u = (A0) ? 0 : 1; u < 2; ++u) { const int rb = u ? r1 : r0; \
                    if (k0 + 31 > rb) { _Pragma("unroll") for (int kk = 0; kk < 2; ++kk) _Pragma("unroll") for (int rg = 0; rg < 4; ++rg) if (k0 + 16 * kk + 4 * fq + rg > rb + li) sv[u][kk][rg] = NEG; } } \
                float alpha[2] = {1.0f, 1.0f}; \
                _Pragma("unroll") for (int u = (A0) ? 0 : 1; u < 2; ++u) { \
                    float mx = fmaxf(fmaxf(fmaxf(sv[u][0][0], sv[u][0][1]), fmaxf(sv[u][0][2], sv[u][0][3])), fmaxf(fmaxf(sv[u][1][0], sv[u][1][1]), fmaxf(sv[u][1][2], sv[u][1][3]))); \
                    mx = fmaxf(mx, __shfl_xor(mx, 16)); mx = fmaxf(mx, __shfl_xor(mx, 32)); \
                    const float mn = fmaxf(mrun[u], mx); alpha[u] = __builtin_amdgcn_exp2f(mrun[u] - mn); mrun[u] = mn; \
                    float ls = 0.f; \
                    _Pragma("unroll") for (int kk = 0; kk < 2; ++kk) _Pragma("unroll") for (int rg = 0; rg < 4; ++rg) { sv[u][kk][rg] = __builtin_amdgcn_exp2f(sv[u][kk][rg] - mn); ls += sv[u][kk][rg]; } \
                    lrun[u] = lrun[u] * alpha[u] + ls; } \
                if (__any((alpha[0] != 1.0f) || (alpha[1] != 1.0f))) { \
                    _Pragma("unroll") for (int u = (A0) ? 0 : 1; u < 2; ++u) _Pragma("unroll") for (int nt = 0; nt < 16; ++nt) O[u][nt] = O[u][nt] * alpha[u]; } \
                const bf16x8 P0 = pack_frag(sv[0][0], sv[0][1]), P1 = pack_frag(sv[1][0], sv[1][1]); \
                __builtin_amdgcn_sched_barrier(0); \
                __builtin_amdgcn_s_setprio(1); \
                _Pragma("unroll") for (int nt = 0; nt < 16; ++nt) { \
                    const bf16x8 av = cat4(lds_tr(Vt + (4 * fq + q4) * VS + (16 * nt + 4 * p4) * 2), lds_tr(Vt + (16 + 4 * fq + q4) * VS + (16 * nt + 4 * p4) * 2)); \
                    if (A0) O[0][nt] = MFMA16(av, P0, O[0][nt]); O[1][nt] = MFMA16(av, P1, O[1][nt]); \
                    if ((nt & 3) == 3) __builtin_amdgcn_sched_barrier(0); } \
                __builtin_amdgcn_s_setprio(0); } while (0)
#define ATT_STEP() do { asm volatile("s_waitcnt vmcnt(8) lgkmcnt(0)\n\ts_barrier" ::: "memory"); \
                const int tn_ = kt + 3 < nkt ? kt + 3 : nkt - 1; ATT_DMA(tn_, (kt + 3) & 3); } while (0)
        const int ktA = (r0 + 15) / 32 + 1;
        int kt = 0;
#pragma nounroll
        for (; kt < ktA; ++kt) { const int k0 = 32 * kt; ATT_STEP(); ATT_BODY(1); }
#pragma nounroll
        for (; kt < nkt; ++kt) { const int k0 = 32 * kt; ATT_STEP(); if (k0 <= r1 + 15) ATT_BODY(0); }
#undef ATT_BODY
#undef ATT_STEP
#undef ATT_DMA
#pragma unroll
        for (int u = 0; u < 2; ++u) {
            float l = lrun[u]; l += __shfl_xor(l, 16); l += __shfl_xor(l, 32);
            const float inv = 1.0f / l;
            bf16_t* op = (p ? O1 : O0) + (size_t)(b * SEQ + (u ? r1 : r0) + li) * 1024 + h * 256 + 4 * fq;
#pragma unroll
            for (int nt = 0; nt < 16; ++nt) { const f32x4 o = O[u][nt] * inv; u32x2 wv; wv.x = cvt_pk_bf16(o[0], o[1]); wv.y = cvt_pk_bf16(o[2], o[3]); *(u32x2*)(op + 16 * nt) = wv; }
        }
    }
    asm volatile("s_waitcnt vmcnt(0) lgkmcnt(0)\n\ts_barrier" ::: "memory");
}

#define XB_TMO      128
#define XB_XCNT(j)  (256  + 64 * (j))
#define XB_XSUB(j)  (1280 + 64 * (j))
#define XB_XGEN(j)  (2304 + 64 * (j))
#define XB_TOP      3328
#define XB_TOPGEN   3392
#define XCD_BAR_WORDS 3456
#define XB_SPIN_CAP (1u << 18)
__device__ __forceinline__ unsigned xb_ld(unsigned* p)              { return __hip_atomic_load(p, __ATOMIC_RELAXED, __HIP_MEMORY_SCOPE_AGENT); }
__device__ __forceinline__ unsigned xb_add(unsigned* p, unsigned v) { return __hip_atomic_fetch_add(p, v, __ATOMIC_RELAXED, __HIP_MEMORY_SCOPE_AGENT); }
__device__ __forceinline__ unsigned xb_xcc_id() { return (unsigned)__builtin_amdgcn_s_getreg((3 << 11) | 20) & 0xFu; }
#define XB_SPIN(cond, bar) do { unsigned _sp = 0; while (cond) { __builtin_amdgcn_s_sleep(1); \
    if ((++_sp & 255u) == 0u) { if (xb_ld(&(bar)[XB_TMO])) break; if (_sp > XB_SPIN_CAP) { atomicAdd(&(bar)[XB_TMO], 1u); break; } } } } while (0)
struct XcdBarrier { unsigned* bar; unsigned x; volatile LAS unsigned* st; };
__device__ __forceinline__ XcdBarrier xcd_barrier_post(unsigned* bar, volatile LAS unsigned* st) {
    XcdBarrier b; b.bar = bar; b.x = xb_xcc_id(); b.st = st;
    if (threadIdx.x == 0) (void)xb_add(&bar[XB_XCNT(b.x)], 1u);
    return b;
}
__device__ __forceinline__ void xcd_barrier_complete(unsigned* bar, unsigned x, unsigned& nloc, unsigned& nx) {
    const unsigned G = gridDim.x * gridDim.y * gridDim.z;
    unsigned sum, cnt, mine, sp = 0u;
    for (;;) {
        sum = 0u; cnt = 0u; mine = 0u;
#pragma unroll
        for (unsigned j = 0; j < 16; ++j) { const unsigned c = xb_ld(&bar[XB_XCNT(j)]); sum += c; cnt += (c > 0u) ? 1u : 0u; mine = (j == x) ? c : mine; }
        if (sum == G) break;
        __builtin_amdgcn_s_sleep(1);
        if ((++sp & 255u) == 0u) { if (xb_ld(&bar[XB_TMO])) break; if (sp > XB_SPIN_CAP) { atomicAdd(&bar[XB_TMO], 1u); break; } }
    }
    nloc = mine > 0u ? mine : 1u; nx = cnt > 0u ? cnt : 1u;
}
__device__ __forceinline__ void xcd_barrier(const XcdBarrier& b) {
    asm volatile("s_waitcnt vmcnt(0)" ::: "memory");
    __syncthreads();
    if (threadIdx.x == 0) {
        unsigned* bar = b.bar;
        __builtin_amdgcn_s_waitcnt(0);
        unsigned nloc = b.st[0], nx = b.st[1];
        if (nloc == 0u) { xcd_barrier_complete(bar, b.x, nloc, nx); b.st[0] = nloc; b.st[1] = nx; }
        const unsigned old = xb_add(&bar[XB_XSUB(b.x)], 1u);
        const unsigned gen = old / nloc;
        if (old + 1u == (gen + 1u) * nloc) {
            __builtin_amdgcn_fence(__ATOMIC_RELEASE, "agent");
            asm volatile("s_waitcnt vmcnt(0)" ::: "memory");
            const unsigned og = xb_add(&bar[XB_TOP], 1u);
            const unsigned tg = og / nx;
            if (og + 1u == (tg + 1u) * nx) xb_add(&bar[XB_TOPGEN], 1u);
            else XB_SPIN(xb_ld(&bar[XB_TOPGEN]) == tg, bar);
            __builtin_amdgcn_fence(__ATOMIC_ACQUIRE, "agent");
            xb_add(&bar[XB_XGEN(b.x)], 1u);
            asm volatile("s_waitcnt vmcnt(0)" ::: "memory");
        } else {
            XB_SPIN(xb_ld(&bar[XB_XGEN(b.x)]) == gen, bar);
            __builtin_amdgcn_fence(__ATOMIC_ACQUIRE, "agent");
            asm volatile("s_waitcnt vmcnt(0)" ::: "memory");
        }
    }
    __syncthreads();
}

__global__ void __launch_bounds__(512, 2) yoco_fwd(Args args) {
    extern __shared__ __attribute__((aligned(16))) unsigned char lds_raw[];
    LAS unsigned char* lds = (LAS unsigned char*)lds_raw;
    LAS unsigned char* ldsx = lds + LDS_XOFF;
    cg::grid_group grid = cg::this_grid();
    const int tid = threadIdx.x, lane = tid & 63, wave = __builtin_amdgcn_readfirstlane(tid >> 6);
    const int G = gridDim.x, gw = blockIdx.x * 8 + wave, NGW = G * 8;
    unsigned char* ws = args.ws;
    const int lo = args.ph_lo, hi = args.ph_hi;
    volatile LAS unsigned* xst = (volatile LAS unsigned*)(lds + LDS_XOFF + 8192);
    if (tid < 2) xst[tid] = 0u;
    if (blockIdx.x == 0 && tid < 64) __hip_atomic_store((unsigned*)(ws + WS_XCNT) + 16 * tid, 0u, __ATOMIC_RELAXED, __HIP_MEMORY_SCOPE_AGENT);
    if (blockIdx.x == 0) { for (int i = tid; i < XCD_BAR_WORDS; i += 512) __hip_atomic_store((unsigned*)(ws + WS_BAR) + i, 0u, __ATOMIC_RELAXED, __HIP_MEMORY_SCOPE_AGENT); }
    asm volatile("s_waitcnt vmcnt(0)" ::: "memory");
    __syncthreads();
#define IN(k) (lo <= (k) && (k) < hi)
#define SEAM(k) do { if (IN(k) && hi > (k) + 1 && (k) != 16) xcd_barrier(xbar); } while (0)
    grid.sync();
    asm volatile("" ::: "memory");
    const XcdBarrier xbar = xcd_barrier_post((unsigned*)(ws + WS_BAR), xst);
    float* X = args.out;
    const float* mod0 = (const float*)(ws + WS_MOD0); const float* mod1 = (const float*)(ws + WS_MOD1); const float* kvmod = (const float*)(ws + WS_KVMOD);
    bf16_t* H = (bf16_t*)(ws + WS_H);
    bf16_t* U = (bf16_t*)(ws + WS_U);
    const float* tabR = (const float*)(ws + WS_TABR); const float* tabD = (const float*)(ws + WS_TABD);
    pg8::StaticOrder S;

#define PH(k, ...) do { if (IN(k)) { __VA_ARGS__ if (MK_DUP == (k)) { __VA_ARGS__ } } SEAM(k); if (MK_DUPSYNC) SEAM(k); } while (0)
    PH(0, { p0_prologue<0>(args, lds, wave, lane, G); });
    PH(1, { p0_prologue<1>(args, lds, wave, lane, G); NM a{args.in[2], mod0, mod0 + 1024, 6144, (bf16_t*)args.out}; normmod_phase<false>(args.in[0], a, a, gw, NGW, lane); });
    PH(2, {
        pg8::Gemm g{(const bf16_t*)args.out, (const bf16_t*)(ws + WS_WRIN), TOK, 6144, 1024, 256}; S.init(TOK, 6144, G, (int)blockIdx.x);
        EpiRetIn E{(bf16_t*)(ws + WS_Q), (bf16_t*)(ws + WS_K), (bf16_t*)(ws + WS_V), (bf16_t*)(ws + WS_G), tabR};
        pg8::gemm_phase<EpiRetIn>(lds, ldsx, g, S, E); });
    PH(3, { retention_phase(lds, (const bf16_t*)(ws + WS_Q), (const bf16_t*)(ws + WS_K), (bf16_t*)(ws + WS_V), (const bf16_t*)(ws + WS_G), (float*)(ws + WS_SSQ), G); });
    PH(5, {
        pg8::Gemm g{(const bf16_t*)(ws + WS_V), (const bf16_t*)(ws + WS_WROUT), TOK, 1024, 2048, 256}; S.init(TOK, 1024, G, (int)blockIdx.x);
        EpiResNorm<true, 1> E{args.in[0], X, mod0 + 2048, (const float*)(ws + WS_SSQ), {{H, args.in[2] + 1024, mod0 + 3072, mod0 + 4096, 6144}, {H, args.in[2] + 1024, mod0 + 3072, mod0 + 4096, 6144}}, (float*)(ws + WS_XSLOT), (unsigned*)(ws + WS_XCNT), 32u};
        pg8::gemm_phase<EpiResNorm<true, 1>>(lds, ldsx, g, S, E); });
    PH(7, {
        pg8::Gemm g{H - 2 * 1024, (const bf16_t*)(ws + WS_WFIN0), 65 * 256, NFF, 1024, 254}; S.init(65 * 256, NFF, G, (int)blockIdx.x);
        EpiFfn E{U, args.in[8], args.in[9]};
        pg8::gemm_phase<EpiFfn>(lds, ldsx, g, S, E); });
    PH(8, {
        pg8::Gemm g{U, (const bf16_t*)(ws + WS_WFDN0), TOK, 1024, DFF, 256}; S.init(TOK, 1024, G, (int)blockIdx.x);
        EpiResNorm<false, 2> E{X, X, mod0 + 5120, nullptr, {{H, args.in[11], kvmod, kvmod + 1024, 2048}, {(bf16_t*)(ws + WS_H3), args.in[2] + 2048, mod1, mod1 + 1024, 6144}}, (float*)(ws + WS_XSLOT), (unsigned*)(ws + WS_XCNT), 64u};
        pg8::gemm_phase<EpiResNorm<false, 2>>(lds, ldsx, g, S, E); });
    PH(10, {
        { pg8::Gemm g{H, (const bf16_t*)(ws + WS_WKV), TOK, 2048, 1024, 256}; S.init(TOK, 2048, G, (int)blockIdx.x);
          EpiRope E{(bf16_t*)(ws + WS_KSH), (bf16_t*)(ws + WS_VSH), 4, tabD, 1.0f};
          pg8::gemm_phase<EpiRope>(lds, ldsx, g, S, E); }
        { pg8::Gemm g{(const bf16_t*)(ws + WS_H3), (const bf16_t*)(ws + WS_WQ), TOK, 1024, 1024, 256}; S.init(TOK, 1024, G, (int)blockIdx.x);
          EpiRope E{(bf16_t*)(ws + WS_QD), (bf16_t*)(ws + WS_QD), 4, tabD, 0.08838834764831845f * 1.4426950408889634f};
          pg8::gemm_phase<EpiRope>(lds, ldsx, g, S, E); } });
    PH(11, { attn_phase(lds, (const bf16_t*)(ws + WS_QD), (const bf16_t*)(ws + WS_KSH), (const bf16_t*)(ws + WS_VSH), (bf16_t*)(ws + WS_O0), (bf16_t*)(ws + WS_O1), G); });
    PH(12, { combine_phase((const bf16_t*)(ws + WS_O0), (const bf16_t*)(ws + WS_O1), (bf16_t*)(ws + WS_OD), args.in[17], (const float*)(ws + WS_LAM), gw, NGW, lane); });
    PH(13, {
        pg8::Gemm g{(const bf16_t*)(ws + WS_OD), (const bf16_t*)(ws + WS_WO), TOK, 1024, 1024, 256}; S.init(TOK, 1024, G, (int)blockIdx.x);
        EpiResNorm<false, 1> E{X, X, mod1 + 2048, nullptr, {{H, args.in[2] + 3072, mod1 + 3072, mod1 + 4096, 6144}, {H, args.in[2] + 3072, mod1 + 3072, mod1 + 4096, 6144}}, (float*)(ws + WS_XSLOT), (unsigned*)(ws + WS_XCNT), 96u};
        pg8::gemm_phase<EpiResNorm<false, 1>>(lds, ldsx, g, S, E); });
    PH(15, {
        pg8::Gemm g{H - 2 * 1024, (const bf16_t*)(ws + WS_WFIN1), 65 * 256, NFF, 1024, 254}; S.init(65 * 256, NFF, G, (int)blockIdx.x);
        EpiFfn E{U, args.in[8] + 3 * DFF, args.in[9] + DFF};
        pg8::gemm_phase<EpiFfn>(lds, ldsx, g, S, E); });
    PH(16, {
        pg8::Gemm g{U, (const bf16_t*)(ws + WS_WFDN1), TOK, 1024, DFF, 256}; S.init(TOK, 1024, G, (int)blockIdx.x);
        EpiResFinal E{X, X, mod1 + 5120, args.in[19], (float*)(ws + WS_XSLOT), (unsigned*)(ws + WS_XCNT), 128u};
        pg8::gemm_phase<EpiResFinal>(lds, ldsx, g, S, E); });
#undef PH
#undef IN
#undef SEAM
}

extern "C" void kernel_launch(void* const* d_in, const int* in_sizes, int n_in, void* d_out, int out_size, void* d_ws, size_t ws_size, hipStream_t stream) {
    static int grid = 0;
    if (grid == 0) {
        if (n_in != 20 || out_size != TOK * DM || ws_size < WS_END) { fprintf(stderr, "kernel_launch: unexpected shapes (n_in %d, out %d, ws %zu)\n", n_in, out_size, ws_size); grid = -1; return; }
        int dev = 0, cus = 0, per_cu = 0;
        if (hipGetDevice(&dev) != hipSuccess || hipDeviceGetAttribute(&cus, hipDeviceAttributeMultiprocessorCount, dev) != hipSuccess) { grid = -1; return; }
        if (hipFuncSetAttribute((const void*)yoco_fwd, hipFuncAttributeMaxDynamicSharedMemorySize, LDS_BYTES) != hipSuccess) { fprintf(stderr, "kernel_launch: hipFuncSetAttribute failed\n"); grid = -1; return; }
        if (hipOccupancyMaxActiveBlocksPerMultiprocessor(&per_cu, (const void*)yoco_fwd, 512, LDS_BYTES) != hipSuccess || per_cu < 1) { fprintf(stderr, "kernel_launch: occupancy query failed (%d)\n", per_cu); (void)hipGetLastError(); grid = -1; return; }
        if (cus != 256) { fprintf(stderr, "kernel_launch: built for a 256-CU device (one 256x256 unit per workgroup in the fused final-norm GEMM), found %d CUs\n", cus); grid = -1; return; }
        grid = cus;
    }
    if (grid < 0) return;
    Args a{};
    for (int i = 0; i < 20; ++i) a.in[i] = (const float*)d_in[i];
    a.out = (float*)d_out; a.ws = (unsigned char*)d_ws;
#if MK_PER_PHASE
    for (int ph = 0; ph < NPHASE; ++ph) {
        a.ph_lo = ph; a.ph_hi = ph + 1; void* kargs[] = {&a};
        hipError_t e = hipLaunchCooperativeKernel((const void*)yoco_fwd, dim3(grid), dim3(512), kargs, LDS_BYTES, stream);
        if (e != hipSuccess) { fprintf(stderr, "cooperative launch failed: %s\n", hipGetErrorString(e)); break; }
    }
#else
    a.ph_lo = 0; a.ph_hi = NPHASE; void* kargs[] = {&a};
    hipError_t e = hipLaunchCooperativeKernel((const void*)yoco_fwd, dim3(grid), dim3(512), kargs, LDS_BYTES, stream);
    if (e != hipSuccess) fprintf(stderr, "cooperative launch failed: %s (grid %d)\n", hipGetErrorString(e), grid);
#endif
}
```

```cpp
#include <hip/hip_runtime.h>
#include <hip/hip_cooperative_groups.h>
#include <cstdio>
#include <cstdint>
namespace cg = cooperative_groups;

#define LAS __attribute__((address_space(3)))
typedef unsigned short bf16_t;
typedef short bf16x8 __attribute__((ext_vector_type(8)));
typedef short s16x4 __attribute__((ext_vector_type(4)));
typedef float f32x4 __attribute__((ext_vector_type(4)));
typedef float f32x2 __attribute__((ext_vector_type(2)));
typedef unsigned u32x4 __attribute__((ext_vector_type(4)));
typedef unsigned u32x2 __attribute__((ext_vector_type(2)));

#ifndef MK_DUP
#define MK_DUP -1
#endif
#ifndef MK_DUPSYNC
#define MK_DUPSYNC 0
#endif
#ifndef MK_PER_PHASE
#define MK_PER_PHASE 0
#endif

constexpr int NB = 8, SEQ = 2048, DM = 1024, TOK = NB * SEQ;
constexpr int DFF = 2816, NFF = 2 * DFF;
constexpr float EPS = 1e-6f;
constexpr int NPHASE = 18;

constexpr size_t MiB = 1u << 20;
constexpr size_t WS_MOD0 = 0, WS_MOD1 = 196608, WS_KVMOD = 393216, WS_LAM = 458752, CTL_ZERO_BYTES = 1 * MiB;
constexpr size_t WS_BAR = 524288, BAR_ZERO_BYTES = 16384;
constexpr size_t WS_TABR = 1 * MiB, WS_TABD = 3 * MiB;
constexpr size_t WS_WRIN = 4 * MiB, WS_WROUT = 16 * MiB, WS_WFIN0 = 20 * MiB, WS_WFIN1 = 31 * MiB, WS_WFDN0 = 42 * MiB, WS_WFDN1 = 42 * MiB + 5632 * 1024,
                 WS_WKV = 53 * MiB, WS_WQ = 57 * MiB, WS_WO = 59 * MiB;
constexpr size_t WS_A0 = 61 * MiB;
constexpr size_t WS_Q = WS_A0, WS_K = 93 * MiB, WS_V = 125 * MiB, WS_G = 189 * MiB;
constexpr size_t WS_H = WS_A0 + 8192;
constexpr size_t WS_U = 126 * MiB;
constexpr size_t WS_H3 = 94 * MiB, WS_KSH = 126 * MiB, WS_VSH = 158 * MiB, WS_QD = 190 * MiB, WS_O0 = 222 * MiB, WS_O1 = WS_H, WS_OD = 94 * MiB;
constexpr size_t WS_SSQ = 253 * MiB;
constexpr size_t WS_XSLOT = 255 * MiB;
constexpr size_t WS_XCNT = 700000;
constexpr size_t WS_END = 256 * MiB;

constexpr int LDS_BYTES = 147456;
constexpr int LDS_XOFF = 131072;

__device__ __forceinline__ unsigned cvt_pk_bf16(float lo, float hi) { unsigned r; asm volatile("v_cvt_pk_bf16_f32 %0, %1, %2" : "=v"(r) : "v"(lo), "v"(hi)); return r; }
__device__ __forceinline__ float bf_lo(unsigned u) { return __uint_as_float(u << 16); }
__device__ __forceinline__ float bf_hi(unsigned u) { return __uint_as_float(u & 0xffff0000u); }
__device__ __forceinline__ float wave_sum(float v) {
#pragma unroll
    for (int o = 1; o < 64; o <<= 1) v += __shfl_xor(v, o);
    return v;
}
__device__ __forceinline__ float silu_f(float x) { return x / (1.0f + __expf(-x)); }
__device__ __forceinline__ f32x2 gelu_pk(f32x2 v) {
    const f32x2 av = __builtin_elementwise_abs(v), d = av * 0.2316418882f + 1.0f;
    f32x2 t; t.x = __builtin_amdgcn_rcpf(d.x); t.y = __builtin_amdgcn_rcpf(d.y);
    f32x2 q = t * 0.5307027145f + (-0.7265760135f); q = q * t + 0.7107068705f; q = q * t + (-0.142248368f); q = q * t + 0.127414796f; q = q * t;
    const f32x2 s = (v * v) * (-0.72134752044f);
    f32x2 e; e.x = __builtin_amdgcn_exp2f(s.x); e.y = __builtin_amdgcn_exp2f(s.y);
    const f32x2 m = v * (q * e), r = v - m;
    f32x2 o; o.x = v.x < 0.f ? m.x : r.x; o.y = v.y < 0.f ? m.y : r.y; return o;
}
__device__ __forceinline__ u32x4 pack8(const f32x4 a, const f32x4 b) { u32x4 w; w.x = cvt_pk_bf16(a[0], a[1]); w.y = cvt_pk_bf16(a[2], a[3]); w.z = cvt_pk_bf16(b[0], b[1]); w.w = cvt_pk_bf16(b[2], b[3]); return w; }
__device__ __forceinline__ bf16x8 lds_b128(const LAS unsigned char* p) { return *(const LAS bf16x8*)p; }
__device__ __forceinline__ s16x4 lds_tr(const LAS unsigned char* p) { return __builtin_amdgcn_ds_read_tr16_b64_v4i16((LAS s16x4*)p); }
__device__ __forceinline__ void glds16_asm(const void* gsrc, unsigned lds_dst) { unsigned keep;
    asm volatile("s_mov_b32 %0, m0\n\ts_mov_b32 m0, %2\n\ts_nop 0\n\tglobal_load_lds_dwordx4 %1, off\n\ts_mov_b32 m0, %0" : "=&s"(keep) : "v"(gsrc), "s"(lds_dst) : "memory"); }
template <int OFF> __device__ __forceinline__ s16x4 lds_tr_asm(unsigned addr) { s16x4 d; asm volatile("ds_read_b64_tr_b16 %0, %1 offset:%2" : "=v"(d) : "v"(addr), "n"(OFF)); return d; }
#define LGKM_WAIT8(n, r) asm volatile("s_waitcnt lgkmcnt(" #n ")" : "+v"(r[0]), "+v"(r[1]), "+v"(r[2]), "+v"(r[3]), "+v"(r[4]), "+v"(r[5]), "+v"(r[6]), "+v"(r[7]))
__device__ __forceinline__ bf16x8 cat4(s16x4 a, s16x4 b) { return __builtin_shufflevector(a, b, 0, 1, 2, 3, 4, 5, 6, 7); }
__device__ __forceinline__ bf16x8 pack_frag(const f32x4 a, const f32x4 b) { u32x4 w = pack8(a, b); return __builtin_bit_cast(bf16x8, w); }
#define MFMA16(a, b, c) __builtin_amdgcn_mfma_f32_16x16x32_bf16((a), (b), (c), 0, 0, 0)

namespace pg8 {
constexpr int BM = 256, BK = 64, HALF = 128, HTB = HALF * BK * 2, STAGE_BYTES = 8 * HTB, NXCD = 8, WGM = 8;
__host__ __device__ __forceinline__ int lds_byte(int r, int c) { const int st = (r >> 4) * 2 + (c >> 5), rr = r & 15, cc = c & 31, ob = rr * 64 + cc * 2; return st * 1024 + (ob ^ (((ob >> 9) & 1) << 5)); }
__host__ __device__ __forceinline__ void stage_rc(int b, int& R, int& C) { const int st = b / 1024, sb = b % 1024, swz = sb ^ (((sb >> 9) & 1) << 5); R = (st >> 1) * 16 + swz / 64; C = (st & 1) * 32 + (swz % 64) / 2; }
__host__ __device__ __forceinline__ int perm32(int rho) { const int n = rho >> 4, i = rho & 15; return 8 * (i >> 2) + 4 * n + (i & 3); }

struct Unit { int pm, pn; };
struct Gemm { const bf16_t* A; const bf16_t* Bt; int M, N, K; int a_rows; const bf16_t* A2 = nullptr; int pn2 = 0x7fffffff; };

struct StaticOrder {
    int nM, nN, nwg, G, c;
    __host__ __device__ void init(int M, int N, int G_, int c_) { nM = M / BM; nN = N / BM; nwg = nM * nN; G = G_; c = c_; }
    __host__ __device__ bool next(int i, Unit& u) const {
        const long L = (long)i * G + c; if (L >= nwg) return false;
        int wgid = (int)L; { const int q = nwg / NXCD, r = nwg % NXCD, xcd = wgid % NXCD, off = wgid / NXCD; wgid = (xcd < r ? xcd * (q + 1) : r * (q + 1) + (xcd - r) * q) + off; }
        const int nig = WGM * nN, gid = wgid / nig, fm = gid * WGM, gsz = (nM - fm) < WGM ? (nM - fm) : WGM;
        u.pm = fm + ((wgid % nig) % gsz); u.pn = (wgid % nig) / gsz; return true;
    }
};

template <class Epi>
__device__ __forceinline__ void gemm_phase(LAS unsigned char* lds, LAS unsigned char* ldsx, const Gemm g, const StaticOrder& S, const Epi& E) {
    const int tid = threadIdx.x, wid = __builtin_amdgcn_readfirstlane(tid >> 6), lane = tid & 63, wr = wid >> 2, wc = wid & 3, fr = lane & 15, fq = lane >> 4;
    const int K = g.K, nt = K / BK;
    unsigned voffA[2], voffB[2];
#pragma unroll
    for (int i = 0; i < 2; ++i) { int R, C; stage_rc(tid * 16 + i * 8192, R, C); const int Rb = Epi::PERM ? ((R & ~31) + perm32(R & 31)) : R;
        voffA[i] = (unsigned)(R * K + C) * 2u; voffB[i] = (unsigned)(Rb * K + C) * 2u; }
    const size_t kstep = (size_t)(BK * 2);
    const size_t hstep = (size_t)HALF * K * 2;
    const size_t tstepB = 2 * hstep;
    const size_t tstepA = (size_t)g.a_rows * K * 2;
    const unsigned ldsw = (unsigned)wid * 1024u;
    const int aoff = lds_byte(wr * 64 + fr, fq * 8), boff = lds_byte(wc * 32 + fr, fq * 8);
#define PG8_SA(b, h) (((b) * 2 + (h)) * HTB)
#define PG8_SB(b, h) ((4 + (b) * 2 + (h)) * HTB)
#define PG8_STAGE(bufoff, gbase, voff) do { _Pragma("unroll") for (int _i = 0; _i < 2; ++_i) \
        __builtin_amdgcn_global_load_lds((const unsigned*)((const char*)(gbase) + (voff)[_i]), (LAS unsigned*)(lds + (bufoff) + ldsw + _i * 8192), 16, 0, 0); } while (0)
#define PG8_LDA(dst, b, h) do { _Pragma("unroll") for (int m = 0; m < 4; ++m) _Pragma("unroll") for (int k = 0; k < 2; ++k) dst[m][k] = *(const LAS bf16x8*)(lds + PG8_SA(b, h) + aoff + m * 2048 + k * 1024); } while (0)
#define PG8_LDB(dst, b, h) do { _Pragma("unroll") for (int n = 0; n < 2; ++n) _Pragma("unroll") for (int k = 0; k < 2; ++k) dst[n][k] = *(const LAS bf16x8*)(lds + PG8_SB(b, h) + boff + n * 2048 + k * 1024); } while (0)
#define PG8_MMA(ai, bj, At, Bt) do { __builtin_amdgcn_s_setprio(1); _Pragma("unroll") for (int m = 0; m < 4; ++m) _Pragma("unroll") for (int n = 0; n < 2; ++n) _Pragma("unroll") for (int k = 0; k < 2; ++k) \
        acc[ai][bj][m][n] = __builtin_amdgcn_mfma_f32_16x16x32_bf16(Bt[n][k], At[m][k], acc[ai][bj][m][n], 0, 0, 0); __builtin_amdgcn_s_setprio(0); } while (0)
#define PG8_WAIT_V(n) asm volatile("s_waitcnt vmcnt(" #n ")" ::: "memory")
#define PG8_WAIT_L(n) asm volatile("s_waitcnt lgkmcnt(" #n ")" ::: "memory")
#define PG8_BAR __builtin_amdgcn_s_barrier()
#define PG8_SCHED __builtin_amdgcn_sched_barrier(0)
    Unit cur, nxt; int ui = 0;
    if (!S.next(0, cur)) return;
    if constexpr (Epi::KHOOK) E.prep(cur, ldsx);
    f32x4 acc[2][2][4][2];
#pragma unroll
    for (int a = 0; a < 2; ++a)
#pragma unroll
        for (int b = 0; b < 2; ++b)
#pragma unroll
            for (int m = 0; m < 4; ++m)
#pragma unroll
                for (int n = 0; n < 2; ++n) acc[a][b][m][n] = (f32x4){0.f, 0.f, 0.f, 0.f};
    bf16x8 At[4][2], B0[2][2], B1[2][2];
    const char* cA = (const char*)(cur.pn >= g.pn2 ? g.A2 : g.A) + (size_t)cur.pm * tstepA; const char* cB = (const char*)g.Bt + (size_t)cur.pn * tstepB;
    PG8_STAGE(PG8_SB(0, 0), cB, voffB); PG8_STAGE(PG8_SB(0, 1), cB + hstep, voffB); PG8_STAGE(PG8_SA(0, 0), cA, voffA); PG8_STAGE(PG8_SA(0, 1), cA + hstep, voffA);
    if (wr == 1) PG8_BAR;
    PG8_WAIT_V(2); PG8_BAR;
    PG8_STAGE(PG8_SB(1, 0), cB + kstep, voffB); PG8_STAGE(PG8_SA(1, 0), cA + kstep, voffA); PG8_STAGE(PG8_SB(1, 1), cB + hstep + kstep, voffB);
    PG8_WAIT_V(6); PG8_BAR;
    for (;;) {
        const bool has_next = S.next(ui + 1, nxt);
        const char* nA = has_next ? (const char*)(nxt.pn >= g.pn2 ? g.A2 : g.A) + (size_t)nxt.pm * tstepA : cA; const char* nB = has_next ? (const char*)g.Bt + (size_t)nxt.pn * tstepB : cB;
        for (int t = 0; t < nt; t += 2) {
            const bool last = (t == nt - 2);
            if constexpr (Epi::KHOOK) { if (t != 0 && (t & 7) == 0) E.khook(acc, t >> 3, wr, fr, ldsx); }
            const char* a1 = cA + (size_t)(t + 1) * kstep;
            const char* a2 = last ? nA : cA + (size_t)(t + 2) * kstep; const char* b2 = last ? nB : cB + (size_t)(t + 2) * kstep;
            const char* a3 = a2 + kstep; const char* b3 = b2 + kstep;
            PG8_LDB(B0, 0, 0); PG8_LDB(B1, 0, 1); PG8_SCHED; PG8_LDA(At, 0, 0); PG8_STAGE(PG8_SA(1, 1), a1 + hstep, voffA);
            PG8_WAIT_V(8); PG8_WAIT_L(0); PG8_BAR; PG8_MMA(0, 0, At, B0); PG8_MMA(0, 1, At, B1); PG8_BAR; PG8_SCHED;
            PG8_LDA(At, 0, 1); PG8_STAGE(PG8_SB(0, 0), b2, voffB); PG8_STAGE(PG8_SB(0, 1), b2 + hstep, voffB); PG8_STAGE(PG8_SA(0, 0), a2, voffA);
            PG8_WAIT_V(8); PG8_WAIT_L(0); PG8_BAR; PG8_MMA(1, 0, At, B0); PG8_MMA(1, 1, At, B1); PG8_BAR; PG8_SCHED;
            PG8_LDB(B0, 1, 0); PG8_LDB(B1, 1, 1); PG8_SCHED; PG8_LDA(At, 1, 0); PG8_STAGE(PG8_SA(0, 1), a2 + hstep, voffA);
            PG8_WAIT_V(8); PG8_WAIT_L(0); PG8_BAR; PG8_MMA(0, 0, At, B0); PG8_MMA(0, 1, At, B1); PG8_BAR; PG8_SCHED;
            PG8_LDA(At, 1, 1); PG8_STAGE(PG8_SB(1, 0), b3, voffB); PG8_STAGE(PG8_SB(1, 1), b3 + hstep, voffB); PG8_STAGE(PG8_SA(1, 0), a3, voffA);
            PG8_WAIT_V(8); PG8_WAIT_L(0); PG8_BAR; PG8_MMA(1, 0, At, B0); PG8_MMA(1, 1, At, B1); PG8_BAR; PG8_SCHED;
        }
        if (wr == 0) PG8_BAR;
        E(acc, cur, wr, wc, fr, fq, ldsx);
        if (!has_next) break;
#pragma unroll
        for (int a = 0; a < 2; ++a)
#pragma unroll
            for (int b = 0; b < 2; ++b)
#pragma unroll
                for (int m = 0; m < 4; ++m)
#pragma unroll
                    for (int n = 0; n < 2; ++n) acc[a][b][m][n] = (f32x4){0.f, 0.f, 0.f, 0.f};
        cur = nxt; cA = nA; cB = nB; ++ui;
        if (wr == 1) PG8_BAR;
    }
    PG8_WAIT_V(0);
    PG8_BAR;
#undef PG8_SA
#undef PG8_SB
#undef PG8_STAGE
#undef PG8_LDA
#undef PG8_LDB
#undef PG8_MMA
#undef PG8_WAIT_V
#undef PG8_WAIT_L
#undef PG8_BAR
#undef PG8_SCHED
}
}
using pg8::Unit;

struct EpiRetIn {
    static constexpr bool PERM = true, KHOOK = false;
    bf16_t *Q, *Kk, *V, *G; const float* tab;
    __device__ __forceinline__ void operator()(const f32x4 (&acc)[2][2][4][2], const Unit& u, int wr, int wc, int fr, int fq, LAS unsigned char*) const {
        const int row0 = u.pm * 256 + wr * 64 + fr, cw = wc * 32 + 8 * fq;
        if (u.pn < 8) {
            const int head = u.pn & 3; const bool isk = u.pn >= 4;
            bf16_t* dst = (isk ? Kk : Q) + head * 256 + cw;
            const float lg = log2f(1.0f - exp2f(-5.0f - (float)head));
#pragma unroll
            for (int ai = 0; ai < 2; ++ai)
#pragma unroll
                for (int m = 0; m < 4; ++m) {
                    const int row = row0 + ai * 128 + m * 16, pos = row & 2047, ci = pos & 127;
                    const float sc = isk ? exp2f(-lg * (float)ci) * 0.0625f : exp2f(lg * (float)ci);
                    const f32x4* tp = (const f32x4*)(tab + ((size_t)pos * 128 + cw) * 2);
                    const f32x4 t0 = tp[0], t1 = tp[1], t2 = tp[2], t3 = tp[3];
                    const f32x4 cs0 = {t0[0], t0[2], t1[0], t1[2]}, sn0 = {t0[1], t0[3], t1[1], t1[3]}, cs1 = {t2[0], t2[2], t3[0], t3[2]}, sn1 = {t2[1], t2[3], t3[1], t3[3]};
                    const f32x4 x10 = acc[ai][0][m][0], x11 = acc[ai][0][m][1], x20 = acc[ai][1][m][0], x21 = acc[ai][1][m][1];
                    const f32x4 o10 = (x10 * cs0 - x20 * sn0) * sc, o11 = (x11 * cs1 - x21 * sn1) * sc;
                    const f32x4 o20 = (x20 * cs0 + x10 * sn0) * sc, o21 = (x21 * cs1 + x11 * sn1) * sc;
                    bf16_t* rp = dst + (size_t)row * 1024;
                    *(u32x4*)rp = pack8(o10, o11); *(u32x4*)(rp + 128) = pack8(o20, o21);
                }
        } else {
            bf16_t* dst = (u.pn < 16 ? V + (u.pn - 8) * 256 : G + (u.pn - 16) * 256) + cw;
#pragma unroll
            for (int ai = 0; ai < 2; ++ai)
#pragma unroll
                for (int m = 0; m < 4; ++m) {
                    bf16_t* rp = dst + (size_t)(row0 + ai * 128 + m * 16) * 2048;
#pragma unroll
                    for (int bj = 0; bj < 2; ++bj) *(u32x4*)(rp + bj * 128) = pack8(acc[ai][bj][m][0], acc[ai][bj][m][1]);
                }
        }
    }
};
struct EpiRes {
    static constexpr bool PERM = false, KHOOK = false;
    const float* base; float* out; const float* gate;
    __device__ __forceinline__ void operator()(const f32x4 (&acc)[2][2][4][2], const Unit& u, int wr, int wc, int fr, int fq, LAS unsigned char*) const {
        const int row0 = u.pm * 256 + wr * 64 + fr, col0 = u.pn * 256 + wc * 32 + 4 * fq;
#pragma unroll
        for (int ai = 0; ai < 2; ++ai)
#pragma unroll
            for (int m = 0; m < 4; ++m) {
                const int row = row0 + ai * 128 + m * 16; const float* gp = gate + (size_t)(row >> 11) * 6144 + col0; const size_t off = (size_t)row * 1024 + col0;
#pragma unroll
                for (int bj = 0; bj < 2; ++bj)
#pragma unroll
                    for (int n = 0; n < 2; ++n) { const int c = bj * 128 + n * 16; const f32x4 gv = *(const f32x4*)(gp + c), bs = *(const f32x4*)(base + off + c);
                        *(f32x4*)(out + off + c) = bs + gv * acc[ai][bj][m][n]; }
            }
    }
};
struct EpiResHead {
    static constexpr bool PERM = false, KHOOK = true;
    const float* base; float* out; const float* gate; const float* ssq;
    __device__ __forceinline__ void prep(const Unit& u, LAS unsigned char* lx) const {
        const int t = threadIdx.x;
        if (t < 256) {
            const f32x4* p = (const f32x4*)(ssq + (size_t)(u.pm * 256 + t) * 32);
            float ri[4];
#pragma unroll
            for (int h = 0; h < 4; ++h) { const f32x4 a = p[2 * h], b = p[2 * h + 1]; const float sm = ((a[0] + a[1]) + (a[2] + a[3])) + ((b[0] + b[1]) + (b[2] + b[3])); ri[h] = 1.0f / sqrtf(sm * (1.0f / 512.0f) + EPS); }
            *(LAS f32x4*)(lx + t * 16) = (f32x4){ri[3], ri[0] / ri[1], ri[1] / ri[2], ri[2] / ri[3]};
        }
        asm volatile("s_waitcnt lgkmcnt(0)" ::: "memory");
    }
    __device__ __forceinline__ void khook(f32x4 (&acc)[2][2][4][2], int hb, int wr, int fr, LAS unsigned char* lx) const {
#pragma unroll
        for (int ai = 0; ai < 2; ++ai)
#pragma unroll
            for (int m = 0; m < 4; ++m) { const float f = ((const LAS float*)lx)[(ai * 128 + wr * 64 + m * 16 + fr) * 4 + hb];
#pragma unroll
                for (int bj = 0; bj < 2; ++bj)
#pragma unroll
                    for (int n = 0; n < 2; ++n) acc[ai][bj][m][n] = acc[ai][bj][m][n] * f; }
    }
    __device__ __forceinline__ void operator()(const f32x4 (&acc)[2][2][4][2], const Unit& u, int wr, int wc, int fr, int fq, LAS unsigned char* lx) const {
        const int row0 = u.pm * 256 + wr * 64 + fr, col0 = u.pn * 256 + wc * 32 + 4 * fq;
#pragma unroll
        for (int ai = 0; ai < 2; ++ai)
#pragma unroll
            for (int m = 0; m < 4; ++m) {
                const int row = row0 + ai * 128 + m * 16; const float* gp = gate + (size_t)(row >> 11) * 6144 + col0; const size_t off = (size_t)row * 1024 + col0;
                const float r3 = ((const LAS float*)lx)[(ai * 128 + wr * 64 + m * 16 + fr) * 4];
#pragma unroll
                for (int bj = 0; bj < 2; ++bj)
#pragma unroll
                    for (int n = 0; n < 2; ++n) { const int c = bj * 128 + n * 16; const f32x4 gv = *(const f32x4*)(gp + c), bs = *(const f32x4*)(base + off + c);
                        *(f32x4*)(out + off + c) = bs + gv * (acc[ai][bj][m][n] * r3); }
            }
    }
};
struct NormOut { bf16_t* dst; const float* gain; const float* sh; const float* sc; int bstride; };
template <bool HEAD, int NX> struct EpiResNorm {
    static constexpr bool PERM = !HEAD, KHOOK = HEAD;
    static constexpr int FQS = PERM ? 8 : 4, NS = PERM ? 4 : 16;
    const float* base; float* out; const float* gate; const float* ssq; NormOut no[2]; float* slots; unsigned* cnt; unsigned target;
    __device__ __forceinline__ void prep(const Unit& u, LAS unsigned char* lx) const {
        const int t = threadIdx.x;
        if (t < 256) {
            const f32x4* p = (const f32x4*)(ssq + (size_t)(u.pm * 256 + t) * 32);
            float ri[4];
#pragma unroll
            for (int h = 0; h < 4; ++h) { const f32x4 a = p[2 * h], b = p[2 * h + 1]; const float sm = ((a[0] + a[1]) + (a[2] + a[3])) + ((b[0] + b[1]) + (b[2] + b[3])); ri[h] = 1.0f / sqrtf(sm * (1.0f / 512.0f) + EPS); }
            *(LAS f32x4*)(lx + t * 16) = (f32x4){ri[3], ri[0] / ri[1], ri[1] / ri[2], ri[2] / ri[3]};
        }
        asm volatile("s_waitcnt lgkmcnt(0)" ::: "memory");
    }
    __device__ __forceinline__ void khook(f32x4 (&acc)[2][2][4][2], int hb, int wr, int fr, LAS unsigned char* lx) const {
        int rb = wr * 64 + fr; asm volatile("" : "+v"(rb));
#pragma unroll
        for (int ai = 0; ai < 2; ++ai)
#pragma unroll
            for (int m = 0; m < 4; ++m) { const float f = ((const LAS float*)lx)[(ai * 128 + rb + m * 16) * 4 + hb];
#pragma unroll
                for (int bj = 0; bj < 2; ++bj)
#pragma unroll
                    for (int n = 0; n < 2; ++n) acc[ai][bj][m][n] = acc[ai][bj][m][n] * f; }
    }
    __device__ __forceinline__ void operator()(f32x4 (&acc)[2][2][4][2], const Unit& u, int wr, int wc, int fr, int fq, LAS unsigned char* lx) const {
        LAS float* P = (LAS float*)(lx + 4096);
        LAS float* Sr = (LAS float*)(lx + 9216);
        const int row0 = u.pm * 256 + wr * 64 + fr, col0 = u.pn * 256 + wc * 32 + FQS * fq, wid = wr * 4 + wc, b = (u.pm * 256) >> 11;
        const int lane = (int)__builtin_amdgcn_mbcnt_hi(~0u, __builtin_amdgcn_mbcnt_lo(~0u, 0u));
        const float* gp = gate + (size_t)b * 6144 + col0;
        int rb = wr * 64 + fr; asm volatile("" : "+v"(rb));
#pragma unroll
        for (int ai = 0; ai < 2; ++ai)
#pragma unroll
            for (int m = 0; m < 4; ++m) {
                const int row = row0 + ai * 128 + m * 16; const size_t off = (size_t)row * 1024 + col0;
                const float r3 = HEAD ? ((const LAS float*)lx)[(ai * 128 + rb + m * 16) * 4] : 1.0f;
                float ss = 0.f;
#pragma unroll
                for (int bj = 0; bj < 2; ++bj)
#pragma unroll
                    for (int n = 0; n < 2; ++n) { const int c = bj * 128 + n * NS; const f32x4 gv = *(const f32x4*)(gp + c), bs = *(const f32x4*)(base + off + c);
                        const f32x4 v = bs + gv * (HEAD ? acc[ai][bj][m][n] * r3 : acc[ai][bj][m][n]); acc[ai][bj][m][n] = v; *(f32x4*)(out + off + c) = v;
                        ss += (v[0] * v[0] + v[1] * v[1]) + (v[2] * v[2] + v[3] * v[3]); }
                ss += __shfl_xor(ss, 16); ss += __shfl_xor(ss, 32);
                if (fq == 0) P[(ai * 128 + rb + m * 16) * 4 + wc] = ss;
            }
        asm volatile("s_waitcnt lgkmcnt(0)" ::: "memory"); __builtin_amdgcn_s_barrier(); asm volatile("" ::: "memory");
        const int rl = wid * 32 + (lane & 31);
        if (lane < 32) { const f32x4 p = *(const LAS f32x4*)(P + rl * 4); const float sm = (p[0] + p[1]) + (p[2] + p[3]);
            __hip_atomic_store(slots + (size_t)(u.pm * 256 + rl) * 4 + u.pn, sm, __ATOMIC_RELAXED, __HIP_MEMORY_SCOPE_AGENT); }
        asm volatile("s_waitcnt vmcnt(0)" ::: "memory");
        if (lane == 0) __hip_atomic_fetch_add(cnt + 16 * u.pm, 1u, __ATOMIC_RELAXED, __HIP_MEMORY_SCOPE_AGENT);
        if (wid == 0) {
            unsigned sp = 0;
            while ((unsigned)__builtin_amdgcn_readfirstlane(__hip_atomic_load(cnt + 16 * u.pm, __ATOMIC_RELAXED, __HIP_MEMORY_SCOPE_AGENT)) < target) { __builtin_amdgcn_s_sleep(2); if (++sp > (1u << 16)) break; }
            __builtin_amdgcn_fence(__ATOMIC_ACQUIRE, "agent");
            asm volatile("s_waitcnt vmcnt(0)" ::: "memory");
        }
        asm volatile("s_waitcnt vmcnt(0) lgkmcnt(0)" ::: "memory"); __builtin_amdgcn_s_barrier(); asm volatile("" ::: "memory");
        if (lane < 32) { const float* sl = slots + (size_t)(u.pm * 256 + rl) * 4; float t = 0.f;
#pragma unroll
            for (int k = 0; k < 4; ++k) t += __hip_atomic_load(sl + k, __ATOMIC_RELAXED, __HIP_MEMORY_SCOPE_AGENT);
            Sr[rl] = 1.0f / sqrtf(t * (1.0f / DM) + EPS); }
        asm volatile("s_waitcnt vmcnt(0) lgkmcnt(0)" ::: "memory"); __builtin_amdgcn_s_barrier(); asm volatile("" ::: "memory");
#pragma unroll
        for (int ai = 0; ai < 2; ++ai)
#pragma unroll
            for (int m = 0; m < 4; ++m) {
                const int rloc = ai * 128 + rb + m * 16; const float ri = Sr[rloc]; const size_t off = (size_t)(u.pm * 256 + rloc) * 1024 + col0;
#pragma unroll
                for (int bj = 0; bj < 2; ++bj)
#pragma unroll
                    for (int n = 0; n < 2; ++n) { const int c = col0 + bj * 128 + n * NS; const f32x4 vr = acc[ai][bj][m][n] * ri;
#pragma unroll
                        for (int x = 0; x < NX; ++x) { const f32x4 g4 = *(const f32x4*)(no[x].gain + c), s4 = *(const f32x4*)(no[x].sc + (size_t)b * no[x].bstride + c), h4 = *(const f32x4*)(no[x].sh + (size_t)b * no[x].bstride + c);
                            const f32x4 h = vr * g4 * (s4 + 1.0f) + h4; u32x2 w; w.x = cvt_pk_bf16(h[0], h[1]); w.y = cvt_pk_bf16(h[2], h[3]); *(u32x2*)(no[x].dst + off + bj * 128 + n * NS) = w; } }
            }
    }
};
struct EpiResFinal {
    static constexpr bool PERM = true, KHOOK = false;
    const float* base; float* out; const float* gate; const float* gain; float* slots; unsigned* cnt; unsigned target;
    __device__ __forceinline__ void operator()(f32x4 (&acc)[2][2][4][2], const Unit& u, int wr, int wc, int fr, int fq, LAS unsigned char* lx) const {
        LAS float* P = (LAS float*)lx;
        LAS float* Sr = (LAS float*)(lx + 4096);
        const int row0 = u.pm * 256 + wr * 64 + fr, col0 = u.pn * 256 + wc * 32 + 8 * fq, wid = wr * 4 + wc;
        const int lane = (int)__builtin_amdgcn_mbcnt_hi(~0u, __builtin_amdgcn_mbcnt_lo(~0u, 0u));
#pragma unroll
        for (int ai = 0; ai < 2; ++ai)
#pragma unroll
            for (int m = 0; m < 4; ++m) {
                const int row = row0 + ai * 128 + m * 16; const float* gp = gate + (size_t)(row >> 11) * 6144 + col0; const size_t off = (size_t)row * 1024 + col0;
                float ss = 0.f;
#pragma unroll
                for (int bj = 0; bj < 2; ++bj)
#pragma unroll
                    for (int n = 0; n < 2; ++n) { const int c = bj * 128 + n * 4; const f32x4 gv = *(const f32x4*)(gp + c), bs = *(const f32x4*)(base + off + c);
                        const f32x4 v = bs + gv * acc[ai][bj][m][n]; acc[ai][bj][m][n] = v; ss += (v[0] * v[0] + v[1] * v[1]) + (v[2] * v[2] + v[3] * v[3]); }
                ss += __shfl_xor(ss, 16); ss += __shfl_xor(ss, 32);
                if (fq == 0) P[(ai * 128 + wr * 64 + m * 16 + fr) * 4 + wc] = ss;
            }
        asm volatile("s_waitcnt lgkmcnt(0)" ::: "memory"); __builtin_amdgcn_s_barrier(); asm volatile("" ::: "memory");
        const int rl = wid * 32 + (lane & 31);
        if (lane < 32) { const f32x4 p = *(const LAS f32x4*)(P + rl * 4); const float sm = (p[0] + p[1]) + (p[2] + p[3]);
            __hip_atomic_store(slots + (size_t)(u.pm * 256 + rl) * 4 + u.pn, sm, __ATOMIC_RELAXED, __HIP_MEMORY_SCOPE_AGENT); }
        asm volatile("s_waitcnt vmcnt(0)" ::: "memory");
        if (lane == 0) __hip_atomic_fetch_add(cnt + 16 * u.pm, 1u, __ATOMIC_RELAXED, __HIP_MEMORY_SCOPE_AGENT);
        if (wid == 0) {
            unsigned sp = 0;
            while ((unsigned)__builtin_amdgcn_readfirstlane(__hip_atomic_load(cnt + 16 * u.pm, __ATOMIC_RELAXED, __HIP_MEMORY_SCOPE_AGENT)) < target) { __builtin_amdgcn_s_sleep(2); if (++sp > (1u << 16)) break; }
            __builtin_amdgcn_fence(__ATOMIC_ACQUIRE, "agent");
            asm volatile("s_waitcnt vmcnt(0)" ::: "memory");
        }
        asm volatile("s_waitcnt vmcnt(0) lgkmcnt(0)" ::: "memory"); __builtin_amdgcn_s_barrier(); asm volatile("" ::: "memory");
        if (lane < 32) { const float* sl = slots + (size_t)(u.pm * 256 + rl) * 4; float t = 0.f;
#pragma unroll
            for (int k = 0; k < 4; ++k) t += __hip_atomic_load(sl + k, __ATOMIC_RELAXED, __HIP_MEMORY_SCOPE_AGENT);
            Sr[rl] = 1.0f / sqrtf(t * (1.0f / DM) + EPS); }
        asm volatile("s_waitcnt vmcnt(0) lgkmcnt(0)" ::: "memory"); __builtin_amdgcn_s_barrier(); asm volatile("" ::: "memory");
#pragma unroll
        for (int ai = 0; ai < 2; ++ai)
#pragma unroll
            for (int m = 0; m < 4; ++m) {
                const int rloc = ai * 128 + wr * 64 + m * 16 + fr; const float ri = Sr[rloc]; const size_t off = (size_t)(u.pm * 256 + rloc) * 1024 + col0;
#pragma unroll
                for (int bj = 0; bj < 2; ++bj)
#pragma unroll
                    for (int n = 0; n < 2; ++n) { const int c = bj * 128 + n * 4; __builtin_nontemporal_store(acc[ai][bj][m][n] * ri * *(const f32x4*)(gain + col0 + c), (f32x4*)(out + off + c)); }
            }
    }
};
struct EpiRope {
    static constexpr bool PERM = true, KHOOK = false;
    bf16_t* dstR; bf16_t* dstV; int nrope; const float* tab; float scale;
    bf16_t* dstQ; int nq0; float scaleQ;
    __device__ __forceinline__ void operator()(const f32x4 (&acc)[2][2][4][2], const Unit& u, int wr, int wc, int fr, int fq, LAS unsigned char*) const {
        const int row0 = u.pm * 256 + wr * 64 + fr, cw = wc * 32 + 8 * fq;
        if (u.pn < nrope || u.pn >= nq0) {
            const int p = cw >> 6, dd = cw & 63; const bool isq = u.pn >= nq0; const float scale = isq ? scaleQ : this->scale;
            bf16_t* dst = (isq ? dstQ + (u.pn - nq0) * 256 : dstR + u.pn * 256) + p * 128 + dd;
#pragma unroll
            for (int ai = 0; ai < 2; ++ai)
#pragma unroll
                for (int m = 0; m < 4; ++m) {
                    const int row = row0 + ai * 128 + m * 16, pos = row & 2047;
                    const f32x4* tp = (const f32x4*)(tab + ((size_t)pos * 64 + dd) * 2);
                    const f32x4 t0 = tp[0], t1 = tp[1], t2 = tp[2], t3 = tp[3];
                    const f32x4 cs0 = {t0[0], t0[2], t1[0], t1[2]}, sn0 = {t0[1], t0[3], t1[1], t1[3]}, cs1 = {t2[0], t2[2], t3[0], t3[2]}, sn1 = {t2[1], t2[3], t3[1], t3[3]};
                    const f32x4 x10 = acc[ai][0][m][0], x11 = acc[ai][0][m][1], x20 = acc[ai][1][m][0], x21 = acc[ai][1][m][1];
                    const f32x4 o10 = (x10 * cs0 - x20 * sn0) * scale, o11 = (x11 * cs1 - x21 * sn1) * scale;
                    const f32x4 o20 = (x20 * cs0 + x10 * sn0) * scale, o21 = (x21 * cs1 + x11 * sn1) * scale;
                    bf16_t* rp = dst + (size_t)row * 1024;
                    *(u32x4*)rp = pack8(o10, o11); *(u32x4*)(rp + 64) = pack8(o20, o21);
                }
        } else {
            bf16_t* dst = dstV + (u.pn - nrope) * 256 + cw;
#pragma unroll
            for (int ai = 0; ai < 2; ++ai)
#pragma unroll
                for (int m = 0; m < 4; ++m) {
                    bf16_t* rp = dst + (size_t)(row0 + ai * 128 + m * 16) * 1024;
#pragma unroll
                    for (int bj = 0; bj < 2; ++bj) *(u32x4*)(rp + bj * 128) = pack8(acc[ai][bj][m][0], acc[ai][bj][m][1]);
                }
        }
    }
};
__device__ __forceinline__ float dpp_shr1(float v) { return __builtin_bit_cast(float, __builtin_amdgcn_update_dpp(0, __builtin_bit_cast(int, v), 0x111, 0xf, 0xf, true)); }
__device__ __forceinline__ float dpp_shr2(float v) { return __builtin_bit_cast(float, __builtin_amdgcn_update_dpp(0, __builtin_bit_cast(int, v), 0x112, 0xf, 0xf, true)); }
__device__ __forceinline__ float dpp_ror1(float v) { return __builtin_bit_cast(float, __builtin_amdgcn_update_dpp(0, __builtin_bit_cast(int, v), 0x121, 0xf, 0xf, false)); }
__device__ __forceinline__ float dpp_shr1_old(float old, float v) { return __builtin_bit_cast(float, __builtin_amdgcn_update_dpp(__builtin_bit_cast(int, old), __builtin_bit_cast(int, v), 0x111, 0xf, 0xf, false)); }
__device__ __forceinline__ float dpp_shr2_old(float old, float v) { return __builtin_bit_cast(float, __builtin_amdgcn_update_dpp(__builtin_bit_cast(int, old), __builtin_bit_cast(int, v), 0x112, 0xf, 0xf, false)); }
__device__ __forceinline__ float dpp_ror2(float v) { return __builtin_bit_cast(float, __builtin_amdgcn_update_dpp(0, __builtin_bit_cast(int, v), 0x122, 0xf, 0xf, false)); }
struct EpiFfn {
    static constexpr bool PERM = true, KHOOK = false;
    bf16_t* U; const float* wconv; const float* bconv;
    __device__ __forceinline__ void operator()(const f32x4 (&acc)[2][2][4][2], const Unit& u, int wr, int wc, int fr, int fq, LAS unsigned char* lx) const {
        const int cw = wc * 32 + 8 * fq, j0 = u.pn * 128 + cw;
        f32x4 w0[2], w1[2], w2[2], bc[2];
#pragma unroll
        for (int n = 0; n < 2; ++n) { w0[n] = *(const f32x4*)(wconv + j0 + 4 * n); w1[n] = *(const f32x4*)(wconv + DFF + j0 + 4 * n); w2[n] = *(const f32x4*)(wconv + 2 * DFF + j0 + 4 * n); bc[n] = *(const f32x4*)(bconv + j0 + 4 * n); }
        LAS float* hx = (LAS float*)lx;
        if (fr >= 14) {
#pragma unroll
            for (int ai = 0; ai < 2; ++ai) { LAS float* p = hx + ((((2 * ai + wr) * 4 + wc) * 2 + (fr - 14)) * 4 + fq) * 8;
                *(LAS f32x4*)p = acc[ai][0][3][0]; *(LAS f32x4*)(p + 4) = acc[ai][0][3][1]; }
        }
        asm volatile("s_waitcnt lgkmcnt(0)" ::: "memory"); __builtin_amdgcn_s_barrier(); asm volatile("" ::: "memory");
        const int rr = fr >= 14 ? fr - 14 : 0;
#pragma unroll
        for (int ai = 0; ai < 2; ++ai) {
            const int qc = 2 * ai + wr;
            f32x4 pv[2] = {(f32x4){0.f, 0.f, 0.f, 0.f}, (f32x4){0.f, 0.f, 0.f, 0.f}};
            if (qc >= 1) { const LAS float* p = hx + (((((qc - 1) * 4 + wc) * 2 + rr) * 4 + fq) * 8); pv[0] = *(const LAS f32x4*)p; pv[1] = *(const LAS f32x4*)(p + 4); }
#pragma unroll
            for (int m = 0; m < 4; ++m) {
                const int trow = ai * 128 + wr * 64 + m * 16 + fr, grow = u.pm * 254 - 2 + trow, pos = grow & 2047;
                f32x4 res[2];
#pragma unroll
                for (int n = 0; n < 2; ++n) {
                    const f32x4 cur = acc[ai][0][m][n], gg = acc[ai][1][m][n];
                    f32x4 cv;
#pragma unroll
                    for (int j = 0; j < 4; ++j) {
                        float a1 = dpp_shr1_old(dpp_ror1(pv[n][j]), cur[j]), a2 = dpp_shr2_old(dpp_ror2(pv[n][j]), cur[j]);
                        a1 = pos < 1 ? 0.f : a1; a2 = pos < 2 ? 0.f : a2;
                        cv[j] = w0[n][j] * a2 + w1[n][j] * a1 + w2[n][j] * cur[j] + bc[n][j];
                    }
                    const f32x2 ga = gelu_pk((f32x2){cv[0], cv[1]}), gb = gelu_pk((f32x2){cv[2], cv[3]});
                    res[n] = (f32x4){ga.x * gg[0], ga.y * gg[1], gb.x * gg[2], gb.y * gg[3]};
                    pv[n] = cur;
                }
                if (trow >= 2 && grow < TOK) *(u32x4*)(U + (size_t)grow * DFF + j0) = pack8(res[0], res[1]);
            }
        }
    }
};

__device__ __forceinline__ int rowmap(int kind, int n) {
    if (kind == 0) return n;
    if (kind == 1) { const int half = n >= DFF ? 1 : 0, j = n - half * DFF; return (j >> 7) * 256 + half * 128 + (j & 127); }
    const int h = n >> 8, p = (n >> 7) & 1, d = n & 127; return h * 256 + (d >> 6) * 128 + p * 64 + (d & 63);
}
__device__ __forceinline__ void transpose_item(const float* W, int ldw, int col0, int ncols, int K, bf16_t* WT, int kind, int row_off, LAS float* scr, int item, int lane) {
    const int nblk = ncols / 32, kb = item / nblk, nb = item % nblk, k0 = 64 * kb, n0 = 32 * nb;
    f32x4 v[8];
#pragma unroll
    for (int i = 0; i < 8; ++i) v[i] = *(const f32x4*)(W + (size_t)(k0 + 8 * i + (lane >> 3)) * ldw + col0 + n0 + 4 * (lane & 7));
#pragma unroll
    for (int i = 0; i < 8; ++i) { LAS float* d = scr + (8 * i + (lane >> 3)) * 33 + 4 * (lane & 7); d[0] = v[i][0]; d[1] = v[i][1]; d[2] = v[i][2]; d[3] = v[i][3]; }
    asm volatile("s_waitcnt lgkmcnt(0)" ::: "memory");
    const int c = lane & 7;
#pragma unroll
    for (int j = 0; j < 4; ++j) { const int n = (lane >> 3) + 8 * j; const LAS float* s = scr + (8 * c) * 33 + n;
        u32x4 o; o.x = cvt_pk_bf16(s[0 * 33], s[1 * 33]); o.y = cvt_pk_bf16(s[2 * 33], s[3 * 33]); o.z = cvt_pk_bf16(s[4 * 33], s[5 * 33]); o.w = cvt_pk_bf16(s[6 * 33], s[7 * 33]);
        *(u32x4*)(WT + (size_t)(row_off + rowmap(kind, n0 + n)) * K + k0 + 8 * c) = o; }
    asm volatile("s_waitcnt lgkmcnt(0)" ::: "memory");
}
__device__ __forceinline__ void mods_item(const float* c, const float* W, int N, int strip, int kc, LAS float* scr, LAS float* red, int lane) {
    const int k0 = kc * 128, n0 = strip * 64;
#pragma unroll
    for (int i = 0; i < 16; ++i) { const int idx = lane + 64 * i, b = idx >> 7, kk = idx & 127; scr[kk * 8 + b] = silu_f(c[b * 1024 + k0 + kk]); }
    asm volatile("s_waitcnt lgkmcnt(0)" ::: "memory");
    float a0 = 0.f, a1 = 0.f, a2 = 0.f, a3 = 0.f, a4 = 0.f, a5 = 0.f, a6 = 0.f, a7 = 0.f;
#pragma unroll 32
    for (int kk = 0; kk < 128; ++kk) {
        const float wv = __builtin_nontemporal_load(W + (size_t)(k0 + kk) * N + n0 + lane);
        const f32x4 s0 = *(const LAS f32x4*)(scr + kk * 8), s1 = *(const LAS f32x4*)(scr + kk * 8 + 4);
        a0 += s0[0] * wv; a1 += s0[1] * wv; a2 += s0[2] * wv; a3 += s0[3] * wv; a4 += s1[0] * wv; a5 += s1[1] * wv; a6 += s1[2] * wv; a7 += s1[3] * wv;
    }
    red[0 * 64 + lane] = a0; red[1 * 64 + lane] = a1; red[2 * 64 + lane] = a2; red[3 * 64 + lane] = a3;
    red[4 * 64 + lane] = a4; red[5 * 64 + lane] = a5; red[6 * 64 + lane] = a6; red[7 * 64 + lane] = a7;
}
__device__ __forceinline__ void sincos_acc(float ang, float& s, float& c) {
    const double x = (double)ang;
    const double k = __builtin_rint(x * 0.6366197723675814);
    double y = __builtin_fma(-k, 1.5707963267948966, x); y = __builtin_fma(-k, 6.123233995736766e-17, y);
    const int q = ((int)k) & 3;
    const double y2 = y * y;
    const double sp = y * (1.0 + y2 * (-1.0 / 6.0 + y2 * (1.0 / 120.0 + y2 * (-1.0 / 5040.0 + y2 * (1.0 / 362880.0 + y2 * (-1.0 / 39916800.0 + y2 * (1.0 / 6227020800.0)))))));
    const double cp = 1.0 + y2 * (-0.5 + y2 * (1.0 / 24.0 + y2 * (-1.0 / 720.0 + y2 * (1.0 / 40320.0 + y2 * (-1.0 / 3628800.0 + y2 * (1.0 / 479001600.0))))));
    const double ss = (q == 0) ? sp : (q == 1) ? cp : (q == 2) ? -sp : -cp;
    const double cc = (q == 0) ? cp : (q == 1) ? -sp : (q == 2) ? -cp : sp;
    s = (float)ss; c = (float)cc;
}

struct Args { const float* in[20]; float* out; unsigned char* ws; int ph_lo, ph_hi; };

template <int PART> __device__ __forceinline__ void p0_prologue(const Args& a, LAS unsigned char* lds, int wave, int lane, int G) {
    LAS float* scr = (LAS float*)(lds + wave * 16384);
    const int gw = blockIdx.x * 8 + wave, NGW = G * 8;
    unsigned char* ws = a.ws;
    if (PART == 0) {
    for (int strip = blockIdx.x; strip < 224; strip += G) {
        LAS float* red = (LAS float*)(lds + wave * 16384 + 8192);
        const float* W; const float* bias; float* out; int N, st;
        if (strip < 96) { W = a.in[3]; bias = a.in[4]; out = (float*)(ws + WS_MOD0); N = 6144; st = strip; }
        else if (strip < 192) { W = a.in[3] + (size_t)1024 * 6144; bias = a.in[4] + 6144; out = (float*)(ws + WS_MOD1); N = 6144; st = strip - 96; }
        else { W = a.in[12]; bias = a.in[13]; out = (float*)(ws + WS_KVMOD); N = 2048; st = strip - 192; }
        mods_item(a.in[1], W, N, st, wave, scr, red, lane);
        __syncthreads();
        { float sum = bias[st * 64 + lane];
#pragma unroll
          for (int kc = 0; kc < 8; ++kc) sum += ((const LAS float*)(lds + kc * 16384 + 8192))[wave * 64 + lane];
          out[(size_t)wave * N + st * 64 + lane] = sum; }
        __syncthreads();
    }
    }
    if (PART == 1) {
    {
        constexpr int T_RIN = (1024 / 128) * (6144 / 64), T_ROUT = (2048 / 128) * (1024 / 64), T_FIN = (1024 / 128) * (NFF / 64), T_FDN = (DFF / 128) * (1024 / 64), T_SQ = (1024 / 128) * (1024 / 64);
        constexpr int NTILES = T_RIN + T_ROUT + 2 * T_FIN + 2 * T_FDN + 4 * T_SQ;
        struct TrJob { const float* W; int ldw, col0, ncols, K; bf16_t* WT; int kind, row_off, item; };
        auto decode = [&](int it) -> TrJob {
            int r = it;
            if (r < T_RIN) return TrJob{a.in[5], 6144, 0, 6144, 1024, (bf16_t*)(ws + WS_WRIN), 0, 0, r}; r -= T_RIN;
            if (r < T_ROUT) return TrJob{a.in[6], 1024, 0, 1024, 2048, (bf16_t*)(ws + WS_WROUT), 0, 0, r}; r -= T_ROUT;
            if (r < T_FIN) return TrJob{a.in[7], NFF, 0, NFF, 1024, (bf16_t*)(ws + WS_WFIN0), 1, 0, r}; r -= T_FIN;
            if (r < T_FIN) return TrJob{a.in[7] + (size_t)1024 * NFF, NFF, 0, NFF, 1024, (bf16_t*)(ws + WS_WFIN1), 1, 0, r}; r -= T_FIN;
            if (r < T_FDN) return TrJob{a.in[10], 1024, 0, 1024, DFF, (bf16_t*)(ws + WS_WFDN0), 0, 0, r}; r -= T_FDN;
            if (r < T_FDN) return TrJob{a.in[10] + (size_t)DFF * 1024, 1024, 0, 1024, DFF, (bf16_t*)(ws + WS_WFDN1), 0, 0, r}; r -= T_FDN;
            if (r < T_SQ) return TrJob{a.in[14], 2048, 0, 1024, 1024, (bf16_t*)(ws + WS_WKV), 2, 0, r}; r -= T_SQ;
            if (r < T_SQ) return TrJob{a.in[14], 2048, 1024, 1024, 1024, (bf16_t*)(ws + WS_WKV), 0, 1024, r}; r -= T_SQ;
            if (r < T_SQ) return TrJob{a.in[15], 1024, 0, 1024, 1024, (bf16_t*)(ws + WS_WQ), 2, 0, r}; r -= T_SQ;
            return TrJob{a.in[18], 1024, 0, 1024, 1024, (bf16_t*)(ws + WS_WO), 0, 0, r};
        };
        const int tid = threadIdx.x, c4 = tid & 15, rp = tid >> 4;
        f32x4 v[4];
        int it = blockIdx.x;
        TrJob cur = decode(it < NTILES ? it : 0);
#define TR_LOAD(j_) do { const int nblk_ = (j_).ncols / 64, k0_ = 128 * ((j_).item / nblk_), n0_ = 64 * ((j_).item % nblk_); \
        _Pragma("unroll") for (int i = 0; i < 2; ++i) { const float* p_ = (j_).W + (size_t)(k0_ + 2 * (32 * i + rp)) * (j_).ldw + (j_).col0 + n0_ + 4 * c4; v[2 * i] = __builtin_nontemporal_load((const f32x4*)p_); v[2 * i + 1] = __builtin_nontemporal_load((const f32x4*)(p_ + (j_).ldw)); } } while (0)
        if (it < NTILES) TR_LOAD(cur);
        int buf = 0;
        for (; it < NTILES; it += G) {
            LAS unsigned* tile = (LAS unsigned*)(lds + buf * 16896);
#pragma unroll
            for (int i = 0; i < 2; ++i) { LAS unsigned* d = tile + (32 * i + rp) * 65 + 4 * c4;
                d[0] = cvt_pk_bf16(v[2 * i][0], v[2 * i + 1][0]); d[1] = cvt_pk_bf16(v[2 * i][1], v[2 * i + 1][1]); d[2] = cvt_pk_bf16(v[2 * i][2], v[2 * i + 1][2]); d[3] = cvt_pk_bf16(v[2 * i][3], v[2 * i + 1][3]); }
            __syncthreads();
            const TrJob job = cur;
            if (it + G < NTILES) { cur = decode(it + G); TR_LOAD(cur); }
            { const int nblk = job.ncols / 64, k0 = 128 * (job.item / nblk), n0 = 64 * (job.item % nblk);
#pragma unroll
              for (int p = 0; p < 2; ++p) { const int n = 32 * p + rp; const LAS unsigned* sp = tile + (4 * c4) * 65 + n;
                  u32x4 o; o.x = sp[0]; o.y = sp[65]; o.z = sp[130]; o.w = sp[195];
                  __builtin_nontemporal_store(o, (u32x4*)(job.WT + (size_t)(job.row_off + rowmap(job.kind, n0 + n)) * job.K + k0 + 8 * c4)); } }
            buf ^= 1;
        }
#undef TR_LOAD
        __syncthreads();
    }
    const int gt = blockIdx.x * 512 + threadIdx.x, NGT = G * 512;
    f32x2* tabR = (f32x2*)(ws + WS_TABR); f32x2* tabD = (f32x2*)(ws + WS_TABD);
    for (int i = gt; i < 2048 * 128; i += NGT) { const int pos = i >> 7, f = i & 127; const float fr = exp2f(-13.287712379549449f * ((float)f / 127.0f)); float s, c; sincos_acc((float)pos * fr, s, c); tabR[i] = (f32x2){c, s}; }
    for (int i = gt; i < 2048 * 64; i += NGT) { const int pos = i >> 6, f = i & 63; const float fr = exp2f(-13.287712379549449f * ((float)f / 64.0f)); float s, c; sincos_acc((float)pos * fr, s, c); tabD[i] = (f32x2){c, s}; }
    }
    if (PART == 0 && gw == 0) {
        const float* lv = a.in[16];
        float d0 = lv[lane] * lv[128 + lane] + lv[64 + lane] * lv[128 + 64 + lane];
        float d1 = lv[256 + lane] * lv[384 + lane] + lv[256 + 64 + lane] * lv[384 + 64 + lane];
        d0 = wave_sum(d0); d1 = wave_sum(d1);
        const float lam_init = 0.8f - 0.6f * expf(-0.3f);
        if (lane == 0) { float* lp = (float*)(ws + WS_LAM); lp[0] = expf(d0) - expf(d1) + lam_init; lp[1] = 1.0f - lam_init; }
    }
}

struct NM { const float* gain; const float* sh; const float* sc; int bstride; bf16_t* dst; };
constexpr int RW = 4;
template <bool TWO>
__device__ __forceinline__ void normmod_phase(const float* src, const NM A, const NM Bq, int gw, int NGW, int lane) {
    for (int row = gw; row < TOK; row += RW * NGW) {
        f32x4 v[RW][4]; float rinv[RW];
#pragma unroll
        for (int r = 0; r < RW; ++r) { const int rw = row + r * NGW < TOK ? row + r * NGW : row; const f32x4* xr = (const f32x4*)(src + (size_t)rw * DM) + lane;
#pragma unroll
            for (int j = 0; j < 4; ++j) v[r][j] = xr[64 * j]; }
#pragma unroll
        for (int r = 0; r < RW; ++r) { float ss = 0.f;
#pragma unroll
            for (int j = 0; j < 4; ++j) ss += (v[r][j][0] * v[r][j][0] + v[r][j][1] * v[r][j][1]) + (v[r][j][2] * v[r][j][2] + v[r][j][3] * v[r][j][3]);
            rinv[r] = 1.0f / sqrtf(wave_sum(ss) * (1.0f / DM) + EPS); }
#pragma unroll
        for (int r = 0; r < RW; ++r) {
            const int rw = row + r * NGW; if (rw >= TOK) break;
            const int b = rw >> 11;
#pragma unroll
            for (int j = 0; j < 4; ++j) {
                const int k0 = 256 * j + 4 * lane;
                { const f32x4 g = *(const f32x4*)(A.gain + k0), sc = *(const f32x4*)(A.sc + (size_t)b * A.bstride + k0), sh = *(const f32x4*)(A.sh + (size_t)b * A.bstride + k0);
                  const f32x4 o = v[r][j] * rinv[r] * g * (sc + 1.0f) + sh; u32x2 w; w.x = cvt_pk_bf16(o[0], o[1]); w.y = cvt_pk_bf16(o[2], o[3]); *(u32x2*)(A.dst + (size_t)rw * DM + k0) = w; }
                if (TWO) { const f32x4 g = *(const f32x4*)(Bq.gain + k0), sc = *(const f32x4*)(Bq.sc + (size_t)b * Bq.bstride + k0), sh = *(const f32x4*)(Bq.sh + (size_t)b * Bq.bstride + k0);
                  const f32x4 o = v[r][j] * rinv[r] * g * (sc + 1.0f) + sh; u32x2 w; w.x = cvt_pk_bf16(o[0], o[1]); w.y = cvt_pk_bf16(o[2], o[3]); *(u32x2*)(Bq.dst + (size_t)rw * DM + k0) = w; }
            }
        }
    }
}
__device__ __forceinline__ void gate_phase(const bf16_t* O, const bf16_t* Gt, bf16_t* Y, int gw, int NGW, int lane) {
    for (int idx0 = gw; idx0 < TOK * 4; idx0 += RW * NGW) {
        u32x4 ov[RW], gv[RW];
#pragma unroll
        for (int r = 0; r < RW; ++r) { const int ix = idx0 + r * NGW < TOK * 4 ? idx0 + r * NGW : idx0; const size_t off = (size_t)ix * 512 + 8 * lane; ov[r] = *(const u32x4*)(O + off); gv[r] = *(const u32x4*)(Gt + off); }
#pragma unroll
        for (int r = 0; r < RW; ++r) {
            const int ix = idx0 + r * NGW; if (ix >= TOK * 4) break;
            float o[8], g[8];
            o[0] = bf_lo(ov[r].x); o[1] = bf_hi(ov[r].x); o[2] = bf_lo(ov[r].y); o[3] = bf_hi(ov[r].y); o[4] = bf_lo(ov[r].z); o[5] = bf_hi(ov[r].z); o[6] = bf_lo(ov[r].w); o[7] = bf_hi(ov[r].w);
            g[0] = bf_lo(gv[r].x); g[1] = bf_hi(gv[r].x); g[2] = bf_lo(gv[r].y); g[3] = bf_hi(gv[r].y); g[4] = bf_lo(gv[r].z); g[5] = bf_hi(gv[r].z); g[6] = bf_lo(gv[r].w); g[7] = bf_hi(gv[r].w);
            float ss = 0.f;
#pragma unroll
            for (int i = 0; i < 8; ++i) ss += o[i] * o[i];
            const float rinv = 1.0f / sqrtf(wave_sum(ss) * (1.0f / 512.0f) + EPS);
            float y[8];
#pragma unroll
            for (int i = 0; i < 8; ++i) y[i] = silu_f(g[i]) * o[i] * rinv;
            u32x4 w; w.x = cvt_pk_bf16(y[0], y[1]); w.y = cvt_pk_bf16(y[2], y[3]); w.z = cvt_pk_bf16(y[4], y[5]); w.w = cvt_pk_bf16(y[6], y[7]);
            *(u32x4*)(Y + (size_t)ix * 512 + 8 * lane) = w;
        }
    }
}
__device__ __forceinline__ void combine_phase(const bf16_t* O0, const bf16_t* O1, bf16_t* Od, const float* gain, const float* lamp, int gw, int NGW, int lane) {
    const float lam = lamp[0], oml = lamp[1];
    const f32x4 gn = *(const f32x4*)(gain + 4 * lane);
    for (int idx0 = gw; idx0 < TOK * 4; idx0 += RW * NGW) {
        u32x2 av[RW], bv[RW];
#pragma unroll
        for (int r = 0; r < RW; ++r) { const int ix = idx0 + r * NGW < TOK * 4 ? idx0 + r * NGW : idx0; const size_t off = (size_t)ix * 256 + 4 * lane; av[r] = *(const u32x2*)(O0 + off); bv[r] = *(const u32x2*)(O1 + off); }
#pragma unroll
        for (int r = 0; r < RW; ++r) {
            const int ix = idx0 + r * NGW; if (ix >= TOK * 4) break;
            const u32x2 a = av[r], b = bv[r];
            f32x4 o = {bf_lo(a.x) - lam * bf_lo(b.x), bf_hi(a.x) - lam * bf_hi(b.x), bf_lo(a.y) - lam * bf_lo(b.y), bf_hi(a.y) - lam * bf_hi(b.y)};
            const float ss = (o[0] * o[0] + o[1] * o[1]) + (o[2] * o[2] + o[3] * o[3]);
            const float rinv = 1.0f / sqrtf(wave_sum(ss) * (1.0f / 256.0f) + EPS);
            o = o * (rinv * oml) * gn;
            u32x2 w; w.x = cvt_pk_bf16(o[0], o[1]); w.y = cvt_pk_bf16(o[2], o[3]); *(u32x2*)(Od + (size_t)ix * 256 + 4 * lane) = w;
        }
    }
}
__device__ __forceinline__ void final_norm_phase(float* X, const float* gain, int gw, int NGW, int lane) {
    for (int row = gw; row < TOK; row += RW * NGW) {
        f32x4 v[RW][4]; float rinv[RW];
#pragma unroll
        for (int r = 0; r < RW; ++r) { const int rw = row + r * NGW < TOK ? row + r * NGW : row; const f32x4* xr = (const f32x4*)(X + (size_t)rw * DM) + lane;
#pragma unroll
            for (int j = 0; j < 4; ++j) v[r][j] = xr[64 * j]; }
#pragma unroll
        for (int r = 0; r < RW; ++r) { float ss = 0.f;
#pragma unroll
            for (int j = 0; j < 4; ++j) ss += (v[r][j][0] * v[r][j][0] + v[r][j][1] * v[r][j][1]) + (v[r][j][2] * v[r][j][2] + v[r][j][3] * v[r][j][3]);
            rinv[r] = 1.0f / sqrtf(wave_sum(ss) * (1.0f / DM) + EPS); }
#pragma unroll
        for (int r = 0; r < RW; ++r) {
            const int rw = row + r * NGW; if (rw >= TOK) break;
            f32x4* xw = (f32x4*)(X + (size_t)rw * DM) + lane;
#pragma unroll
            for (int j = 0; j < 4; ++j) __builtin_nontemporal_store(v[r][j] * rinv[r] * *(const f32x4*)(gain + 256 * j + 4 * lane), xw + 64 * j);
        }
    }
}

__device__ __forceinline__ void retention_phase(LAS unsigned char* lds, const bf16_t* Q, const bf16_t* K, bf16_t* V, const bf16_t* Gt, float* ssqb, int G) {
    const int tid = threadIdx.x, lane = tid & 63, w = __builtin_amdgcn_readfirstlane(tid >> 6), li = lane & 15, fq = lane >> 4, q4 = li >> 2, p4 = li & 3;
    constexpr int KS = 528, VS = 144, SS = 528;
    LAS unsigned char* Ks = lds; LAS unsigned char* Vs = lds + 128 * KS; LAS unsigned char* StT = Vs + 128 * VS;
    const int bx = blockIdx.x; const int vcu = (G % 8 == 0) ? (bx % 8) * (G / 8) + bx / 8 : bx;
    for (int item = vcu; item < 256; item += G) {
        const int bh = item >> 3, sl = item & 7, b = bh >> 2, h = bh & 3;
        const float gam = 1.0f - exp2f(-5.0f - (float)h);
        float g128 = gam;
#pragma unroll
        for (int i = 0; i < 7; ++i) g128 *= g128;
        const float g127 = g128 / gam;
        const bf16_t* Qb = Q + (size_t)b * SEQ * 1024 + h * 256;
        const bf16_t* Kb = K + (size_t)b * SEQ * 1024 + h * 256;
        const bf16_t* Vb = V + (size_t)b * SEQ * 2048 + h * 512 + sl * 64;
        bf16_t* Ob = V + (size_t)b * SEQ * 2048 + h * 512 + sl * 64;
        const bf16_t* Gb = Gt + (size_t)b * SEQ * 2048 + h * 512 + sl * 64;
        __syncthreads();
        for (int i = tid; i < 64 * SS / 16; i += 512) *(LAS u32x4*)(StT + i * 16) = (u32x4){0u, 0u, 0u, 0u};
        f32x4 St[2][4];
#pragma unroll
        for (int mt = 0; mt < 2; ++mt)
#pragma unroll
            for (int nt = 0; nt < 4; ++nt) St[mt][nt] = (f32x4){0.f, 0.f, 0.f, 0.f};
        u32x4 kreg[8], vreg[2]; bf16x8 Qf[8];
        const unsigned voK = (unsigned)((tid >> 5) * 1024 + (tid & 31) * 8) * 2u, voV = (unsigned)((tid >> 3) * 2048 + (tid & 7) * 8) * 2u, voQ = (unsigned)(li * 1024 + 8 * fq) * 2u;
#define RET_LOAD_KV(t0_) do { \
        _Pragma("unroll") for (int i = 0; i < 8; ++i) kreg[i] = *(const u32x4*)((const char*)Kb + (size_t)((t0_) + 16 * i) * 2048 + voK); \
        _Pragma("unroll") for (int i = 0; i < 2; ++i) vreg[i] = *(const u32x4*)((const char*)Vb + (size_t)((t0_) + 64 * i) * 4096 + voV); } while (0)
#define RET_LOAD_Q(t0_) do { _Pragma("unroll") for (int ks = 0; ks < 8; ++ks) Qf[ks] = *(const bf16x8*)((const char*)Qb + (size_t)((t0_) + 16 * w) * 2048 + ks * 64 + voQ); } while (0)
#define RET_WRITE_KV() do { \
        _Pragma("unroll") for (int i = 0; i < 8; ++i) { const int id = tid + 512 * i, r = id >> 5, pc = id & 31; *(LAS u32x4*)(Ks + r * KS + pc * 16) = kreg[i]; } \
        _Pragma("unroll") for (int i = 0; i < 2; ++i) { const int id = tid + 512 * i, r = id >> 3, pc = id & 7; *(LAS u32x4*)(Vs + r * VS + pc * 16) = vreg[i]; } } while (0)
        RET_LOAD_KV(0); RET_LOAD_Q(0);
        RET_WRITE_KV();
        __syncthreads();
#pragma nounroll
        for (int n = 0; n < 16; ++n) {
            const int t0 = n * 128;
            if (n + 1 < 16) RET_LOAD_KV(t0 + 128);
            u32x2 greg[4];
#pragma unroll
            for (int nt = 0; nt < 4; ++nt) greg[nt] = *(const u32x2*)(Gb + (size_t)(t0 + 16 * w + li) * 2048 + 16 * nt + 4 * fq);
            f32x4 accS[8];
#pragma unroll
            for (int kt = 0; kt < 8; ++kt) {
                accS[kt] = (f32x4){0.f, 0.f, 0.f, 0.f};
                if (kt <= w) {
#pragma unroll
                    for (int ks = 0; ks < 8; ++ks) accS[kt] = MFMA16(lds_b128(Ks + (16 * kt + li) * KS + (32 * ks + 8 * fq) * 2), Qf[ks], accS[kt]);
                    __builtin_amdgcn_sched_barrier(0);
                    if (kt == w) {
#pragma unroll
                        for (int r = 0; r < 4; ++r) if (4 * fq + r > li) accS[kt][r] = 0.f;
                    }
                }
            }
            bf16x8 P[4];
#pragma unroll
            for (int s = 0; s < 4; ++s) P[s] = pack_frag(accS[2 * s], accS[2 * s + 1]);
            f32x4 o1[4], o2[4];
#pragma unroll
            for (int nt = 0; nt < 4; ++nt) { o1[nt] = (f32x4){0.f, 0.f, 0.f, 0.f}; o2[nt] = (f32x4){0.f, 0.f, 0.f, 0.f}; }
#pragma unroll
            for (int s = 0; s < 4; ++s) {
                if (2 * s <= w) {
#pragma unroll
                    for (int nt = 0; nt < 4; ++nt) {
                        const bf16x8 av = cat4(lds_tr(Vs + (32 * s + 4 * fq + q4) * VS + (16 * nt + 4 * p4) * 2), lds_tr(Vs + (32 * s + 16 + 4 * fq + q4) * VS + (16 * nt + 4 * p4) * 2));
                        o1[nt] = MFMA16(av, P[s], o1[nt]);
                    }
                }
            }
#pragma unroll
            for (int ks = 0; ks < 8; ++ks)
#pragma unroll
                for (int nt = 0; nt < 4; ++nt) { o2[nt] = MFMA16(lds_b128(StT + (16 * nt + li) * SS + (32 * ks + 8 * fq) * 2), Qf[ks], o2[nt]); if (nt == 3 && (ks & 1)) __builtin_amdgcn_sched_barrier(0); }
            {
                bf16_t* op = Ob + (size_t)(t0 + 16 * w + li) * 2048 + 4 * fq;
                float sq = 0.f;
#pragma unroll
                for (int nt = 0; nt < 4; ++nt) { const f32x4 o = o1[nt] + o2[nt] * gam;
                    sq += (o[0] * o[0] + o[1] * o[1]) + (o[2] * o[2] + o[3] * o[3]);
                    const float y0 = silu_f(bf_lo(greg[nt].x)) * o[0], y1 = silu_f(bf_hi(greg[nt].x)) * o[1], y2 = silu_f(bf_lo(greg[nt].y)) * o[2], y3 = silu_f(bf_hi(greg[nt].y)) * o[3];
                    u32x2 wv; wv.x = cvt_pk_bf16(y0, y1); wv.y = cvt_pk_bf16(y2, y3); *(u32x2*)(op + 16 * nt) = wv; }
                sq += __shfl_xor(sq, 16); sq += __shfl_xor(sq, 32);
                if (fq == 0) ssqb[((size_t)(b * SEQ + t0 + 16 * w + li) * 4 + h) * 8 + sl] = sq;
            }
            if (n + 1 < 16) RET_LOAD_Q(t0 + 128);
            f32x4 tmp[2][4];
#pragma unroll
            for (int mt = 0; mt < 2; ++mt)
#pragma unroll
                for (int nt = 0; nt < 4; ++nt) tmp[mt][nt] = (f32x4){0.f, 0.f, 0.f, 0.f};
#pragma unroll
            for (int s = 0; s < 4; ++s) {
                bf16x8 bv[4];
#pragma unroll
                for (int nt = 0; nt < 4; ++nt) bv[nt] = cat4(lds_tr(Vs + (32 * s + 8 * fq + q4) * VS + (16 * nt + 4 * p4) * 2), lds_tr(Vs + (32 * s + 8 * fq + 4 + q4) * VS + (16 * nt + 4 * p4) * 2));
#pragma unroll
                for (int mt = 0; mt < 2; ++mt) {
                    const bf16x8 ak = cat4(lds_tr(Ks + (32 * s + 8 * fq + q4) * KS + (32 * w + 16 * mt + 4 * p4) * 2), lds_tr(Ks + (32 * s + 8 * fq + 4 + q4) * KS + (32 * w + 16 * mt + 4 * p4) * 2));
#pragma unroll
                    for (int nt = 0; nt < 4; ++nt) tmp[mt][nt] = MFMA16(ak, bv[nt], tmp[mt][nt]);
                }
            }
#pragma unroll
            for (int mt = 0; mt < 2; ++mt)
#pragma unroll
                for (int nt = 0; nt < 4; ++nt) St[mt][nt] = St[mt][nt] * g128 + tmp[mt][nt] * g127;
            if (n + 1 < 16) {
                __syncthreads();
#pragma unroll
                for (int mt = 0; mt < 2; ++mt)
#pragma unroll
                    for (int nt = 0; nt < 4; ++nt) {
                        u32x2 wv; wv.x = cvt_pk_bf16(St[mt][nt][0], St[mt][nt][1]); wv.y = cvt_pk_bf16(St[mt][nt][2], St[mt][nt][3]);
                        *(LAS u32x2*)(StT + (16 * nt + li) * SS + (32 * w + 16 * mt + 4 * fq) * 2) = wv;
                    }
                RET_WRITE_KV();
                __syncthreads();
            }
        }
    }
#undef RET_WRITE_KV
#undef RET_LOAD_KV
#undef RET_LOAD_Q
    __syncthreads();
}

__device__ __forceinline__ void attn_phase(LAS unsigned char* lds, const bf16_t* Qd, const bf16_t* Kd, const bf16_t* Vd, bf16_t* O0, bf16_t* O1, int G) {
    const int tid = threadIdx.x, lane = tid & 63, w = __builtin_amdgcn_readfirstlane(tid >> 6), li = lane & 15, fq = lane >> 4, q4 = li >> 2, p4 = li & 3;
    constexpr int KS = 272, VS = 544, SLOT = 32768;
    const float NEG = -__builtin_inff();
    const unsigned ldsb = (unsigned)(size_t)lds;
    int soff[4]; bool isv[4];
#pragma unroll
    for (int i = 0; i < 4; ++i) {
        const int q = (w * 4 + i) * 64 + lane;
        if (q < 544) { const int row = q / 17, pc = q % 17; soff[i] = row * 1024 + (pc < 16 ? pc : 15) * 8; isv[i] = false; }
        else if (q < 1632) { const int q2 = q - 544, row = q2 / 34, pc = q2 % 34; soff[i] = row * 1024 + (pc < 32 ? pc : 31) * 8; isv[i] = true; }
        else { soff[i] = 0; isv[i] = false; }
    }
    for (int idx = blockIdx.x; idx < 512; idx += G) {
        const int r = idx >> 8, c = idx & 255, xc = c & 7, l = c >> 3, qbi = l & 7;
        const int bh = 4 * xc + 2 * r + (l >> 4), p = (l >> 3) & 1, b = bh >> 2, h = bh & 3;
        const int qb = r ? 7 - qbi : qbi;
        const int q0 = qb * 256, nkt = 8 * (qb + 1);
        const int r0 = q0 + 16 * w, r1 = q0 + 16 * (15 - w);
        const bf16_t* Kp = Kd + (size_t)b * SEQ * 1024 + h * 256 + p * 128;
        const bf16_t* Vp = Vd + (size_t)b * SEQ * 1024 + h * 256;
        const bf16_t* src[4];
#pragma unroll
        for (int i = 0; i < 4; ++i) src[i] = (isv[i] ? Vp : Kp) + soff[i];
        bf16x8 Qf[2][4];
#pragma unroll
        for (int u = 0; u < 2; ++u)
#pragma unroll
            for (int ks = 0; ks < 4; ++ks) Qf[u][ks] = *(const bf16x8*)(Qd + (size_t)(b * SEQ + (u ? r1 : r0) + li) * 1024 + h * 256 + p * 128 + 32 * ks + 8 * fq);
#define ATT_DMA(tile_, slot_) do { const size_t ko_ = (size_t)(tile_) * (32 * 1024); const unsigned lb_ = ldsb + (unsigned)(slot_) * SLOT + (unsigned)(w * 4) * 1024u; _Pragma("unroll") for (int i = 0; i < 4; ++i) \
        glds16_asm(src[i] + ko_, __builtin_amdgcn_readfirstlane(lb_ + i * 1024)); } while (0)
#pragma unroll
        for (int u = 0; u < 2; ++u)
#pragma unroll
            for (int ks = 0; ks < 4; ++ks) asm volatile("" : "+v"(Qf[u][ks]));
        asm volatile("s_waitcnt lgkmcnt(0)\n\ts_barrier" ::: "memory");
        ATT_DMA(0, 0); ATT_DMA(1, 1); ATT_DMA(2, 2);
        float mrun[2] = {NEG, NEG}, lrun[2] = {0.f, 0.f};
        f32x4 O[2][16];
#pragma unroll
        for (int u = 0; u < 2; ++u)
#pragma unroll
            for (int nt = 0; nt < 16; ++nt) O[u][nt] = (f32x4){0.f, 0.f, 0.f, 0.f};
#define ATT_BODY(A0) do { \
                const LAS unsigned char* Kt = lds + (kt & 3) * SLOT; const LAS unsigned char* Vt = Kt + 32 * KS; \
                f32x4 sv[2][2]; \
                _Pragma("unroll") for (int u = 0; u < 2; ++u) _Pragma("unroll") for (int kk = 0; kk < 2; ++kk) sv[u][kk] = (f32x4){0.f, 0.f, 0.f, 0.f}; \
                __builtin_amdgcn_s_setprio(1); \
                _Pragma("unroll") for (int kk = 0; kk < 2; ++kk) _Pragma("unroll") for (int ks = 0; ks < 4; ++ks) { \
                    const bf16x8 a = lds_b128(Kt + (16 * kk + li) * KS + (32 * ks + 8 * fq) * 2); \
                    if (A0) sv[0][kk] = MFMA16(a, Qf[0][ks], sv[0][kk]); sv[1][kk] = MFMA16(a, Qf[1][ks], sv[1][kk]); } \
                __builtin_amdgcn_s_setprio(0); \
                _Pragma("unroll") for (int u = (A0) ? 0 : 1; u < 2; ++u) { const int rb = u ? r1 : r0; \
                    if (k0 + 31 > rb) { _Pragma("unroll") for (int kk = 0; kk < 2; ++kk) _Pragma("unroll") for (int rg = 0; rg < 4; ++rg) if (k0 + 16 * kk + 4 * fq + rg > rb + li) sv[u][kk][rg] = NEG; } } \
                float alpha[2] = {1.0f, 1.0f}; \
                _Pragma("unroll") for (int u = (A0) ? 0 : 1; u < 2; ++u) { \
                    float mx = fmaxf(fmaxf(fmaxf(sv[u][0][0], sv[u][0][1]), fmaxf(sv[u][0][2], sv[u][0][3])), fmaxf(fmaxf(sv[u][1][0], sv[u][1][1]), fmaxf(sv[u][1][2], sv[u][1][3]))); \
                    mx = fmaxf(mx, __shfl_xor(mx, 16)); mx = fmaxf(mx, __shfl_xor(mx, 32)); \
                    const float mn = fmaxf(mrun[u], mx); alpha[u] = __builtin_amdgcn_exp2f(mrun[u] - mn); mrun[u] = mn; \
                    float ls = 0.f; \
                    _Pragma("unroll") for (int kk = 0; kk < 2; ++kk) _Pragma("unroll") for (int rg = 0; rg < 4; ++rg) { sv[u][kk][rg] = __builtin_amdgcn_exp2f(sv[u][kk][rg] - mn); ls += sv[u][kk][rg]; } \
                    lrun[u] = lrun[u] * alpha[u] + ls; } \
                if (__any((alpha[0] != 1.0f) || (alpha[1] != 1.0f))) { \
                    _Pragma("unroll") for (int u = (A0) ? 0 : 1; u < 2; ++u) _Pragma("unroll") for (int nt = 0; nt < 16; ++nt) O[u][nt] = O[u][nt] * alpha[u]; } \
                const bf16x8 P0 = pack_frag(sv[0][0], sv[0][1]), P1 = pack_frag(sv[1][0], sv[1][1]); \
                __builtin_amdgcn_sched_barrier(0); \
                __builtin_amdgcn_s_setprio(1); \
                _Pragma("unroll") for (int nt = 0; nt < 16; ++nt) { \
                    const bf16x8 av = cat4(lds_tr(Vt + (4 * fq + q4) * VS + (16 * nt + 4 * p4) * 2), lds_tr(Vt + (16 + 4 * fq + q4) * VS + (16 * nt + 4 * p4) * 2)); \
                    if (A0) O[0][nt] = MFMA16(av, P0, O[0][nt]); O[1][nt] = MFMA16(av, P1, O[1][nt]); \
                    if ((nt & 3) == 3) __builtin_amdgcn_sched_barrier(0); } \
                __builtin_amdgcn_s_setprio(0); } while (0)
#define ATT_STEP() do { asm volatile("s_waitcnt vmcnt(8) lgkmcnt(0)\n\ts_barrier" ::: "memory"); \
                const int tn_ = kt + 3 < nkt ? kt + 3 : nkt - 1; ATT_DMA(tn_, (kt + 3) & 3); } while (0)
        const int ktA = (r0 + 15) / 32 + 1;
        int kt = 0;
#pragma nounroll
        for (; kt < ktA; ++kt) { const int k0 = 32 * kt; ATT_STEP(); ATT_BODY(1); }
#pragma nounroll
        for (; kt < nkt; ++kt) { const int k0 = 32 * kt; ATT_STEP(); if (k0 <= r1 + 15) ATT_BODY(0); }
#undef ATT_BODY
#undef ATT_STEP
#undef ATT_DMA
#pragma unroll
        for (int u = 0; u < 2; ++u) {
            float l = lrun[u]; l += __shfl_xor(l, 16); l += __shfl_xor(l, 32);
            const float inv = 1.0f / l;
            bf16_t* op = (p ? O1 : O0) + (size_t)(b * SEQ + (u ? r1 : r0) + li) * 1024 + h * 256 + 4 * fq;
#pragma unroll
            for (int nt = 0; nt < 16; ++nt) { const f32x4 o = O[u][nt] * inv; u32x2 wv; wv.x = cvt_pk_bf16(o[0], o[1]); wv.y = cvt_pk_bf16(o[2], o[3]); *(u32x2*)(op + 16 * nt) = wv; }
        }
    }
    asm volatile("s_waitcnt vmcnt(0) lgkmcnt(0)\n\ts_barrier" ::: "memory");
}

#define XB_TMO      128
#define XB_XCNT(j)  (256  + 64 * (j))
#define XB_XSUB(j)  (1280 + 64 * (j))
#define XB_XGEN(j)  (2304 + 64 * (j))
#define XB_TOP      3328
#define XB_TOPGEN   3392
#define XCD_BAR_WORDS 3456
#define XB_SPIN_CAP (1u << 18)
__device__ __forceinline__ unsigned xb_ld(unsigned* p)              { return __hip_atomic_load(p, __ATOMIC_RELAXED, __HIP_MEMORY_SCOPE_AGENT); }
__device__ __forceinline__ unsigned xb_add(unsigned* p, unsigned v) { return __hip_atomic_fetch_add(p, v, __ATOMIC_RELAXED, __HIP_MEMORY_SCOPE_AGENT); }
__device__ __forceinline__ unsigned xb_xcc_id() { return (unsigned)__builtin_amdgcn_s_getreg((3 << 11) | 20) & 0xFu; }
#define XB_SPIN(cond, bar) do { unsigned _sp = 0; while (cond) { __builtin_amdgcn_s_sleep(1); \
    if ((++_sp & 255u) == 0u) { if (xb_ld(&(bar)[XB_TMO])) break; if (_sp > XB_SPIN_CAP) { atomicAdd(&(bar)[XB_TMO], 1u); break; } } } } while (0)
struct XcdBarrier { unsigned* bar; unsigned x; volatile LAS unsigned* st; };
__device__ __forceinline__ XcdBarrier xcd_barrier_post(unsigned* bar, volatile LAS unsigned* st) {
    XcdBarrier b; b.bar = bar; b.x = xb_xcc_id(); b.st = st;
    if (threadIdx.x == 0) (void)xb_add(&bar[XB_XCNT(b.x)], 1u);
    return b;
}
__device__ __forceinline__ void xcd_barrier_complete(unsigned* bar, unsigned x, unsigned& nloc, unsigned& nx) {
    const unsigned G = gridDim.x * gridDim.y * gridDim.z;
    unsigned sum, cnt, mine, sp = 0u;
    for (;;) {
        sum = 0u; cnt = 0u; mine = 0u;
#pragma unroll
        for (unsigned j = 0; j < 16; ++j) { const unsigned c = xb_ld(&bar[XB_XCNT(j)]); sum += c; cnt += (c > 0u) ? 1u : 0u; mine = (j == x) ? c : mine; }
        if (sum == G) break;
        __builtin_amdgcn_s_sleep(1);
        if ((++sp & 255u) == 0u) { if (xb_ld(&bar[XB_TMO])) break; if (sp > XB_SPIN_CAP) { atomicAdd(&bar[XB_TMO], 1u); break; } }
    }
    nloc = mine > 0u ? mine : 1u; nx = cnt > 0u ? cnt : 1u;
}
__device__ __forceinline__ void xcd_barrier(const XcdBarrier& b) {
    asm volatile("s_waitcnt vmcnt(0)" ::: "memory");
    __syncthreads();
    if (threadIdx.x == 0) {
        unsigned* bar = b.bar;
        __builtin_amdgcn_s_waitcnt(0);
        unsigned nloc = b.st[0], nx = b.st[1];
        if (nloc == 0u) { xcd_barrier_complete(bar, b.x, nloc, nx); b.st[0] = nloc; b.st[1] = nx; }
        const unsigned old = xb_add(&bar[XB_XSUB(b.x)], 1u);
        const unsigned gen = old / nloc;
        if (old + 1u == (gen + 1u) * nloc) {
            __builtin_amdgcn_fence(__ATOMIC_RELEASE, "agent");
            asm volatile("s_waitcnt vmcnt(0)" ::: "memory");
            const unsigned og = xb_add(&bar[XB_TOP], 1u);
            const unsigned tg = og / nx;
            if (og + 1u == (tg + 1u) * nx) xb_add(&bar[XB_TOPGEN], 1u);
            else XB_SPIN(xb_ld(&bar[XB_TOPGEN]) == tg, bar);
            __builtin_amdgcn_fence(__ATOMIC_ACQUIRE, "agent");
            xb_add(&bar[XB_XGEN(b.x)], 1u);
            asm volatile("s_waitcnt vmcnt(0)" ::: "memory");
        } else {
            XB_SPIN(xb_ld(&bar[XB_XGEN(b.x)]) == gen, bar);
            __builtin_amdgcn_fence(__ATOMIC_ACQUIRE, "agent");
            asm volatile("s_waitcnt vmcnt(0)" ::: "memory");
        }
    }
    __syncthreads();
}

__global__ void __launch_bounds__(512, 2) yoco_fwd(Args args) {
    extern __shared__ __attribute__((aligned(16))) unsigned char lds_raw[];
    LAS unsigned char* lds = (LAS unsigned char*)lds_raw;
    LAS unsigned char* ldsx = lds + LDS_XOFF;
    cg::grid_group grid = cg::this_grid();
    const int tid = threadIdx.x, lane = tid & 63, wave = __builtin_amdgcn_readfirstlane(tid >> 6);
    const int G = gridDim.x, gw = blockIdx.x * 8 + wave, NGW = G * 8;
    unsigned char* ws = args.ws;
    const int lo = args.ph_lo, hi = args.ph_hi;
    volatile LAS unsigned* xst = (volatile LAS unsigned*)(lds + LDS_XOFF + 8192);
    if (tid < 2) xst[tid] = 0u;
    if (blockIdx.x == 0 && tid < 64) __hip_atomic_store((unsigned*)(ws + WS_XCNT) + 16 * tid, 0u, __ATOMIC_RELAXED, __HIP_MEMORY_SCOPE_AGENT);
    if (blockIdx.x == 0) { for (int i = tid; i < XCD_BAR_WORDS; i += 512) __hip_atomic_store((unsigned*)(ws + WS_BAR) + i, 0u, __ATOMIC_RELAXED, __HIP_MEMORY_SCOPE_AGENT); }
    asm volatile("s_waitcnt vmcnt(0)" ::: "memory");
    __syncthreads();
#define IN(k) (lo <= (k) && (k) < hi)
#define SEAM(k) do { if (IN(k) && hi > (k) + 1 && (k) != 16) xcd_barrier(xbar); } while (0)
    grid.sync();
    asm volatile("" ::: "memory");
    const XcdBarrier xbar = xcd_barrier_post((unsigned*)(ws + WS_BAR), xst);
    float* X = args.out;
    const float* mod0 = (const float*)(ws + WS_MOD0); const float* mod1 = (const float*)(ws + WS_MOD1); const float* kvmod = (const float*)(ws + WS_KVMOD);
    bf16_t* H = (bf16_t*)(ws + WS_H);
    bf16_t* U = (bf16_t*)(ws + WS_U);
    const float* tabR = (const float*)(ws + WS_TABR); const float* tabD = (const float*)(ws + WS_TABD);
    pg8::StaticOrder S;

#define PH(k, ...) do { if (IN(k)) { __VA_ARGS__ if (MK_DUP == (k)) { __VA_ARGS__ } } SEAM(k); if (MK_DUPSYNC) SEAM(k); } while (0)
    PH(0, { p0_prologue<0>(args, lds, wave, lane, G); });
    PH(1, { p0_prologue<1>(args, lds, wave, lane, G); NM a{args.in[2], mod0, mod0 + 1024, 6144, (bf16_t*)args.out}; normmod_phase<false>(args.in[0], a, a, gw, NGW, lane); });
    PH(2, {
        pg8::Gemm g{(const bf16_t*)args.out, (const bf16_t*)(ws + WS_WRIN), TOK, 6144, 1024, 256}; S.init(TOK, 6144, G, (int)blockIdx.x);
        EpiRetIn E{(bf16_t*)(ws + WS_Q), (bf16_t*)(ws + WS_K), (bf16_t*)(ws + WS_V), (bf16_t*)(ws + WS_G), tabR};
        pg8::gemm_phase<EpiRetIn>(lds, ldsx, g, S, E); });
    PH(3, { retention_phase(lds, (const bf16_t*)(ws + WS_Q), (const bf16_t*)(ws + WS_K), (bf16_t*)(ws + WS_V), (const bf16_t*)(ws + WS_G), (float*)(ws + WS_SSQ), G); });
    PH(5, {
        pg8::Gemm g{(const bf16_t*)(ws + WS_V), (const bf16_t*)(ws + WS_WROUT), TOK, 1024, 2048, 256}; S.init(TOK, 1024, G, (int)blockIdx.x);
        EpiResNorm<true, 1> E{args.in[0], X, mod0 + 2048, (const float*)(ws + WS_SSQ), {{H, args.in[2] + 1024, mod0 + 3072, mod0 + 4096, 6144}, {H, args.in[2] + 1024, mod0 + 3072, mod0 + 4096, 6144}}, (float*)(ws + WS_XSLOT), (unsigned*)(ws + WS_XCNT), 32u};
        pg8::gemm_phase<EpiResNorm<true, 1>>(lds, ldsx, g, S, E); });
    PH(7, {
        pg8::Gemm g{H - 2 * 1024, (const bf16_t*)(ws + WS_WFIN0), 65 * 256, NFF, 1024, 254}; S.init(65 * 256, NFF, G, (int)blockIdx.x);
        EpiFfn E{U, args.in[8], args.in[9]};
        pg8::gemm_phase<EpiFfn>(lds, ldsx, g, S, E); });
    PH(8, {
        pg8::Gemm g{U, (const bf16_t*)(ws + WS_WFDN0), TOK, 1024, DFF, 256}; S.init(TOK, 1024, G, (int)blockIdx.x);
        EpiResNorm<false, 2> E{X, X, mod0 + 5120, nullptr, {{H, args.in[11], kvmod, kvmod + 1024, 2048}, {(bf16_t*)(ws + WS_H3), args.in[2] + 2048, mod1, mod1 + 1024, 6144}}, (float*)(ws + WS_XSLOT), (unsigned*)(ws + WS_XCNT), 64u};
        pg8::gemm_phase<EpiResNorm<false, 2>>(lds, ldsx, g, S, E); });
    PH(10, {
        pg8::Gemm g{H, (const bf16_t*)(ws + WS_WKV), TOK, 3072, 1024, 256, (const bf16_t*)(ws + WS_H3), 8}; S.init(TOK, 3072, G, (int)blockIdx.x);
        EpiRope E{(bf16_t*)(ws + WS_KSH), (bf16_t*)(ws + WS_VSH), 4, tabD, 1.0f, (bf16_t*)(ws + WS_QD), 8, 0.08838834764831845f * 1.4426950408889634f};
        pg8::gemm_phase<EpiRope>(lds, ldsx, g, S, E); });
    PH(11, { attn_phase(lds, (const bf16_t*)(ws + WS_QD), (const bf16_t*)(ws + WS_KSH), (const bf16_t*)(ws + WS_VSH), (bf16_t*)(ws + WS_O0), (bf16_t*)(ws + WS_O1), G); });
    PH(12, { combine_phase((const bf16_t*)(ws + WS_O0), (const bf16_t*)(ws + WS_O1), (bf16_t*)(ws + WS_OD), args.in[17], (const float*)(ws + WS_LAM), gw, NGW, lane); });
    PH(13, {
        pg8::Gemm g{(const bf16_t*)(ws + WS_OD), (const bf16_t*)(ws + WS_WO), TOK, 1024, 1024, 256}; S.init(TOK, 1024, G, (int)blockIdx.x);
        EpiResNorm<false, 1> E{X, X, mod1 + 2048, nullptr, {{H, args.in[2] + 3072, mod1 + 3072, mod1 + 4096, 6144}, {H, args.in[2] + 3072, mod1 + 3072, mod1 + 4096, 6144}}, (float*)(ws + WS_XSLOT), (unsigned*)(ws + WS_XCNT), 96u};
        pg8::gemm_phase<EpiResNorm<false, 1>>(lds, ldsx, g, S, E); });
    PH(15, {
        pg8::Gemm g{H - 2 * 1024, (const bf16_t*)(ws + WS_WFIN1), 65 * 256, NFF, 1024, 254}; S.init(65 * 256, NFF, G, (int)blockIdx.x);
        EpiFfn E{U, args.in[8] + 3 * DFF, args.in[9] + DFF};
        pg8::gemm_phase<EpiFfn>(lds, ldsx, g, S, E); });
    PH(16, {
        pg8::Gemm g{U, (const bf16_t*)(ws + WS_WFDN1), TOK, 1024, DFF, 256}; S.init(TOK, 1024, G, (int)blockIdx.x);
        EpiResFinal E{X, X, mod1 + 5120, args.in[19], (float*)(ws + WS_XSLOT), (unsigned*)(ws + WS_XCNT), 128u};
        pg8::gemm_phase<EpiResFinal>(lds, ldsx, g, S, E); });
#undef PH
#undef IN
#undef SEAM
}

extern "C" void kernel_launch(void* const* d_in, const int* in_sizes, int n_in, void* d_out, int out_size, void* d_ws, size_t ws_size, hipStream_t stream) {
    static int grid = 0;
    if (grid == 0) {
        if (n_in != 20 || out_size != TOK * DM || ws_size < WS_END) { fprintf(stderr, "kernel_launch: unexpected shapes (n_in %d, out %d, ws %zu)\n", n_in, out_size, ws_size); grid = -1; return; }
        int dev = 0, cus = 0, per_cu = 0;
        if (hipGetDevice(&dev) != hipSuccess || hipDeviceGetAttribute(&cus, hipDeviceAttributeMultiprocessorCount, dev) != hipSuccess) { grid = -1; return; }
        if (hipFuncSetAttribute((const void*)yoco_fwd, hipFuncAttributeMaxDynamicSharedMemorySize, LDS_BYTES) != hipSuccess) { fprintf(stderr, "kernel_launch: hipFuncSetAttribute failed\n"); grid = -1; return; }
        if (hipOccupancyMaxActiveBlocksPerMultiprocessor(&per_cu, (const void*)yoco_fwd, 512, LDS_BYTES) != hipSuccess || per_cu < 1) { fprintf(stderr, "kernel_launch: occupancy query failed (%d)\n", per_cu); (void)hipGetLastError(); grid = -1; return; }
        if (cus != 256) { fprintf(stderr, "kernel_launch: built for a 256-CU device (one 256x256 unit per workgroup in the fused final-norm GEMM), found %d CUs\n", cus); grid = -1; return; }
        grid = cus;
    }
    if (grid < 0) return;
    Args a{};
    for (int i = 0; i < 20; ++i) a.in[i] = (const float*)d_in[i];
    a.out = (float*)d_out; a.ws = (unsigned char*)d_ws;
#if MK_PER_PHASE
    for (int ph = 0; ph < NPHASE; ++ph) {
        a.ph_lo = ph; a.ph_hi = ph + 1; void* kargs[] = {&a};
        hipError_t e = hipLaunchCooperativeKernel((const void*)yoco_fwd, dim3(grid), dim3(512), kargs, LDS_BYTES, stream);
        if (e != hipSuccess) { fprintf(stderr, "cooperative launch failed: %s\n", hipGetErrorString(e)); break; }
    }
#else
    a.ph_lo = 0; a.ph_hi = NPHASE; void* kargs[] = {&a};
    hipError_t e = hipLaunchCooperativeKernel((const void*)yoco_fwd, dim3(grid), dim3(512), kargs, LDS_BYTES, stream);
    if (e != hipSuccess) fprintf(stderr, "cooperative launch failed: %s (grid %d)\n", hipGetErrorString(e), grid);
#endif
}
```

```cpp
#include <hip/hip_runtime.h>
#include <hip/hip_cooperative_groups.h>
#include <cstdio>
#include <cstdint>
namespace cg = cooperative_groups;

#define LAS __attribute__((address_space(3)))
typedef unsigned short bf16_t;
typedef short bf16x8 __attribute__((ext_vector_type(8)));
typedef short s16x4 __attribute__((ext_vector_type(4)));
typedef float f32x4 __attribute__((ext_vector_type(4)));
typedef float f32x2 __attribute__((ext_vector_type(2)));
typedef unsigned u32x4 __attribute__((ext_vector_type(4)));
typedef unsigned u32x2 __attribute__((ext_vector_type(2)));

#ifndef MK_DUP
#define MK_DUP -1
#endif
#ifndef MK_DUPSYNC
#define MK_DUPSYNC 0
#endif
#ifndef MK_PER_PHASE
#define MK_PER_PHASE 0
#endif

constexpr int NB = 8, SEQ = 2048, DM = 1024, TOK = NB * SEQ;
constexpr int DFF = 2816, NFF = 2 * DFF;
constexpr float EPS = 1e-6f;
constexpr int NPHASE = 18;

constexpr size_t MiB = 1u << 20;
constexpr size_t WS_MOD0 = 0, WS_MOD1 = 196608, WS_KVMOD = 393216, WS_LAM = 458752, CTL_ZERO_BYTES = 1 * MiB;
constexpr size_t WS_BAR = 524288, BAR_ZERO_BYTES = 16384;
constexpr size_t WS_TABR = 1 * MiB, WS_TABD = 3 * MiB;
constexpr size_t WS_WRIN = 4 * MiB, WS_WROUT = 16 * MiB, WS_WFIN0 = 20 * MiB, WS_WFIN1 = 31 * MiB, WS_WFDN0 = 42 * MiB, WS_WFDN1 = 42 * MiB + 5632 * 1024,
                 WS_WKV = 53 * MiB, WS_WQ = 57 * MiB, WS_WO = 59 * MiB;
constexpr size_t WS_A0 = 61 * MiB;
constexpr size_t WS_Q = WS_A0, WS_K = 93 * MiB, WS_V = 125 * MiB, WS_G = 189 * MiB;
constexpr size_t WS_H = WS_A0 + 8192;
constexpr size_t WS_U = 126 * MiB;
constexpr size_t WS_H3 = 94 * MiB, WS_KSH = 126 * MiB, WS_VSH = 158 * MiB, WS_QD = 190 * MiB, WS_O0 = 222 * MiB, WS_O1 = WS_H, WS_OD = 94 * MiB;
constexpr size_t WS_SSQ = 253 * MiB;
constexpr size_t WS_XSLOT = 255 * MiB;
constexpr size_t WS_XCNT = 700000;
constexpr size_t WS_END = 256 * MiB;

constexpr int LDS_BYTES = 147456;
constexpr int LDS_XOFF = 131072;

__device__ __forceinline__ unsigned cvt_pk_bf16(float lo, float hi) { unsigned r; asm volatile("v_cvt_pk_bf16_f32 %0, %1, %2" : "=v"(r) : "v"(lo), "v"(hi)); return r; }
__device__ __forceinline__ float bf_lo(unsigned u) { return __uint_as_float(u << 16); }
__device__ __forceinline__ float bf_hi(unsigned u) { return __uint_as_float(u & 0xffff0000u); }
__device__ __forceinline__ float wave_sum(float v) {
#pragma unroll
    for (int o = 1; o < 64; o <<= 1) v += __shfl_xor(v, o);
    return v;
}
__device__ __forceinline__ float silu_f(float x) { return x / (1.0f + __expf(-x)); }
__device__ __forceinline__ f32x2 gelu_pk(f32x2 v) {
    const f32x2 av = __builtin_elementwise_abs(v), d = av * 0.2316418882f + 1.0f;
    f32x2 t; t.x = __builtin_amdgcn_rcpf(d.x); t.y = __builtin_amdgcn_rcpf(d.y);
    f32x2 q = t * 0.5307027145f + (-0.7265760135f); q = q * t + 0.7107068705f; q = q * t + (-0.142248368f); q = q * t + 0.127414796f; q = q * t;
    const f32x2 s = (v * v) * (-0.72134752044f);
    f32x2 e; e.x = __builtin_amdgcn_exp2f(s.x); e.y = __builtin_amdgcn_exp2f(s.y);
    const f32x2 m = v * (q * e), r = v - m;
    f32x2 o; o.x = v.x < 0.f ? m.x : r.x; o.y = v.y < 0.f ? m.y : r.y; return o;
}
__device__ __forceinline__ u32x4 pack8(const f32x4 a, const f32x4 b) { u32x4 w; w.x = cvt_pk_bf16(a[0], a[1]); w.y = cvt_pk_bf16(a[2], a[3]); w.z = cvt_pk_bf16(b[0], b[1]); w.w = cvt_pk_bf16(b[2], b[3]); return w; }
__device__ __forceinline__ bf16x8 lds_b128(const LAS unsigned char* p) { return *(const LAS bf16x8*)p; }
__device__ __forceinline__ s16x4 lds_tr(const LAS unsigned char* p) { return __builtin_amdgcn_ds_read_tr16_b64_v4i16((LAS s16x4*)p); }
__device__ __forceinline__ void glds16_asm(const void* gsrc, unsigned lds_dst) { unsigned keep;
    asm volatile("s_mov_b32 %0, m0\n\ts_mov_b32 m0, %2\n\ts_nop 0\n\tglobal_load_lds_dwordx4 %1, off\n\ts_mov_b32 m0, %0" : "=&s"(keep) : "v"(gsrc), "s"(lds_dst) : "memory"); }
template <int OFF> __device__ __forceinline__ s16x4 lds_tr_asm(unsigned addr) { s16x4 d; asm volatile("ds_read_b64_tr_b16 %0, %1 offset:%2" : "=v"(d) : "v"(addr), "n"(OFF)); return d; }
#define LGKM_WAIT8(n, r) asm volatile("s_waitcnt lgkmcnt(" #n ")" : "+v"(r[0]), "+v"(r[1]), "+v"(r[2]), "+v"(r[3]), "+v"(r[4]), "+v"(r[5]), "+v"(r[6]), "+v"(r[7]))
__device__ __forceinline__ bf16x8 cat4(s16x4 a, s16x4 b) { return __builtin_shufflevector(a, b, 0, 1, 2, 3, 4, 5, 6, 7); }
__device__ __forceinline__ bf16x8 pack_frag(const f32x4 a, const f32x4 b) { u32x4 w = pack8(a, b); return __builtin_bit_cast(bf16x8, w); }
#define MFMA16(a, b, c) __builtin_amdgcn_mfma_f32_16x16x32_bf16((a), (b), (c), 0, 0, 0)

namespace pg8 {
constexpr int BM = 256, BK = 64, HALF = 128, HTB = HALF * BK * 2, STAGE_BYTES = 8 * HTB, NXCD = 8, WGM = 4;
__host__ __device__ __forceinline__ int lds_byte(int r, int c) { const int st = (r >> 4) * 2 + (c >> 5), rr = r & 15, cc = c & 31, ob = rr * 64 + cc * 2; return st * 1024 + (ob ^ (((ob >> 9) & 1) << 5)); }
__host__ __device__ __forceinline__ void stage_rc(int b, int& R, int& C) { const int st = b / 1024, sb = b % 1024, swz = sb ^ (((sb >> 9) & 1) << 5); R = (st >> 1) * 16 + swz / 64; C = (st & 1) * 32 + (swz % 64) / 2; }
__host__ __device__ __forceinline__ int perm32(int rho) { const int n = rho >> 4, i = rho & 15; return 8 * (i >> 2) + 4 * n + (i & 3); }

struct Unit { int pm, pn; };
struct Gemm { const bf16_t* A; const bf16_t* Bt; int M, N, K; int a_rows; const bf16_t* A2 = nullptr; int pn2 = 0x7fffffff; };

struct StaticOrder {
    int nM, nN, nwg, G, c;
    __host__ __device__ void init(int M, int N, int G_, int c_) { nM = M / BM; nN = N / BM; nwg = nM * nN; G = G_; c = c_; }
    __host__ __device__ bool next(int i, Unit& u) const {
        const long L = (long)i * G + c; if (L >= nwg) return false;
        int wgid = (int)L; { const int q = nwg / NXCD, r = nwg % NXCD, xcd = wgid % NXCD, off = wgid / NXCD; wgid = (xcd < r ? xcd * (q + 1) : r * (q + 1) + (xcd - r) * q) + off; }
        const int nig = WGM * nN, gid = wgid / nig, fm = gid * WGM, gsz = (nM - fm) < WGM ? (nM - fm) : WGM;
        u.pm = fm + ((wgid % nig) % gsz); u.pn = (wgid % nig) / gsz; return true;
    }
};

template <class Epi>
__device__ __forceinline__ void gemm_phase(LAS unsigned char* lds, LAS unsigned char* ldsx, const Gemm g, const StaticOrder& S, const Epi& E) {
    const int tid = threadIdx.x, wid = __builtin_amdgcn_readfirstlane(tid >> 6), lane = tid & 63, wr = wid >> 2, wc = wid & 3, fr = lane & 15, fq = lane >> 4;
    const int K = g.K, nt = K / BK;
    unsigned voffA[2], voffB[2];
#pragma unroll
    for (int i = 0; i < 2; ++i) { int R, C; stage_rc(tid * 16 + i * 8192, R, C); const int Rb = Epi::PERM ? ((R & ~31) + perm32(R & 31)) : R;
        voffA[i] = (unsigned)(R * K + C) * 2u; voffB[i] = (unsigned)(Rb * K + C) * 2u; }
    const size_t kstep = (size_t)(BK * 2);
    const size_t hstep = (size_t)HALF * K * 2;
    const size_t tstepB = 2 * hstep;
    const size_t tstepA = (size_t)g.a_rows * K * 2;
    const unsigned ldsw = (unsigned)wid * 1024u;
    const int aoff = lds_byte(wr * 64 + fr, fq * 8), boff = lds_byte(wc * 32 + fr, fq * 8);
#define PG8_SA(b, h) (((b) * 2 + (h)) * HTB)
#define PG8_SB(b, h) ((4 + (b) * 2 + (h)) * HTB)
#define PG8_STAGE(bufoff, gbase, voff) do { _Pragma("unroll") for (int _i = 0; _i < 2; ++_i) \
        __builtin_amdgcn_global_load_lds((const unsigned*)((const char*)(gbase) + (voff)[_i]), (LAS unsigned*)(lds + (bufoff) + ldsw + _i * 8192), 16, 0, 0); } while (0)
#define PG8_LDA(dst, b, h) do { _Pragma("unroll") for (int m = 0; m < 4; ++m) _Pragma("unroll") for (int k = 0; k < 2; ++k) dst[m][k] = *(const LAS bf16x8*)(lds + PG8_SA(b, h) + aoff + m * 2048 + k * 1024); } while (0)
#define PG8_LDB(dst, b, h) do { _Pragma("unroll") for (int n = 0; n < 2; ++n) _Pragma("unroll") for (int k = 0; k < 2; ++k) dst[n][k] = *(const LAS bf16x8*)(lds + PG8_SB(b, h) + boff + n * 2048 + k * 1024); } while (0)
#define PG8_MMA(ai, bj, At, Bt) do { __builtin_amdgcn_s_setprio(1); _Pragma("unroll") for (int m = 0; m < 4; ++m) _Pragma("unroll") for (int n = 0; n < 2; ++n) _Pragma("unroll") for (int k = 0; k < 2; ++k) \
        acc[ai][bj][m][n] = __builtin_amdgcn_mfma_f32_16x16x32_bf16(Bt[n][k], At[m][k], acc[ai][bj][m][n], 0, 0, 0); __builtin_amdgcn_s_setprio(0); } while (0)
#define PG8_WAIT_V(n) asm volatile("s_waitcnt vmcnt(" #n ")" ::: "memory")
#define PG8_WAIT_L(n) asm volatile("s_waitcnt lgkmcnt(" #n ")" ::: "memory")
#define PG8_BAR __builtin_amdgcn_s_barrier()
#define PG8_SCHED __builtin_amdgcn_sched_barrier(0)
    Unit cur, nxt; int ui = 0;
    if (!S.next(0, cur)) return;
    if constexpr (Epi::KHOOK) E.prep(cur, ldsx);
    f32x4 acc[2][2][4][2];
#pragma unroll
    for (int a = 0; a < 2; ++a)
#pragma unroll
        for (int b = 0; b < 2; ++b)
#pragma unroll
            for (int m = 0; m < 4; ++m)
#pragma unroll
                for (int n = 0; n < 2; ++n) acc[a][b][m][n] = (f32x4){0.f, 0.f, 0.f, 0.f};
    bf16x8 At[4][2], B0[2][2], B1[2][2];
    const char* cA = (const char*)(cur.pn >= g.pn2 ? g.A2 : g.A) + (size_t)cur.pm * tstepA; const char* cB = (const char*)g.Bt + (size_t)cur.pn * tstepB;
    PG8_STAGE(PG8_SB(0, 0), cB, voffB); PG8_STAGE(PG8_SB(0, 1), cB + hstep, voffB); PG8_STAGE(PG8_SA(0, 0), cA, voffA); PG8_STAGE(PG8_SA(0, 1), cA + hstep, voffA);
    if (wr == 1) PG8_BAR;
    PG8_WAIT_V(2); PG8_BAR;
    PG8_STAGE(PG8_SB(1, 0), cB + kstep, voffB); PG8_STAGE(PG8_SA(1, 0), cA + kstep, voffA); PG8_STAGE(PG8_SB(1, 1), cB + hstep + kstep, voffB);
    PG8_WAIT_V(6); PG8_BAR;
    for (;;) {
        const bool has_next = S.next(ui + 1, nxt);
        const char* nA = has_next ? (const char*)(nxt.pn >= g.pn2 ? g.A2 : g.A) + (size_t)nxt.pm * tstepA : cA; const char* nB = has_next ? (const char*)g.Bt + (size_t)nxt.pn * tstepB : cB;
        for (int t = 0; t < nt; t += 2) {
            const bool last = (t == nt - 2);
            if constexpr (Epi::KHOOK) { if (t != 0 && (t & 7) == 0) E.khook(acc, t >> 3, wr, fr, ldsx); }
            const char* a1 = cA + (size_t)(t + 1) * kstep;
            const char* a2 = last ? nA : cA + (size_t)(t + 2) * kstep; const char* b2 = last ? nB : cB + (size_t)(t + 2) * kstep;
            const char* a3 = a2 + kstep; const char* b3 = b2 + kstep;
            PG8_LDB(B0, 0, 0); PG8_LDB(B1, 0, 1); PG8_SCHED; PG8_LDA(At, 0, 0); PG8_STAGE(PG8_SA(1, 1), a1 + hstep, voffA);
            PG8_WAIT_V(8); PG8_WAIT_L(0); PG8_BAR; PG8_MMA(0, 0, At, B0); PG8_MMA(0, 1, At, B1); PG8_BAR; PG8_SCHED;
            PG8_LDA(At, 0, 1); PG8_STAGE(PG8_SB(0, 0), b2, voffB); PG8_STAGE(PG8_SB(0, 1), b2 + hstep, voffB); PG8_STAGE(PG8_SA(0, 0), a2, voffA);
            PG8_WAIT_V(8); PG8_WAIT_L(0); PG8_BAR; PG8_MMA(1, 0, At, B0); PG8_MMA(1, 1, At, B1); PG8_BAR; PG8_SCHED;
            PG8_LDB(B0, 1, 0); PG8_LDB(B1, 1, 1); PG8_SCHED; PG8_LDA(At, 1, 0); PG8_STAGE(PG8_SA(0, 1), a2 + hstep, voffA);
            PG8_WAIT_V(8); PG8_WAIT_L(0); PG8_BAR; PG8_MMA(0, 0, At, B0); PG8_MMA(0, 1, At, B1); PG8_BAR; PG8_SCHED;
            PG8_LDA(At, 1, 1); PG8_STAGE(PG8_SB(1, 0), b3, voffB); PG8_STAGE(PG8_SB(1, 1), b3 + hstep, voffB); PG8_STAGE(PG8_SA(1, 0), a3, voffA);
            PG8_WAIT_V(8); PG8_WAIT_L(0); PG8_BAR; PG8_MMA(1, 0, At, B0); PG8_MMA(1, 1, At, B1); PG8_BAR; PG8_SCHED;
        }
        if (wr == 0) PG8_BAR;
        E(acc, cur, wr, wc, fr, fq, ldsx);
        if (!has_next) break;
#pragma unroll
        for (int a = 0; a < 2; ++a)
#pragma unroll
            for (int b = 0; b < 2; ++b)
#pragma unroll
                for (int m = 0; m < 4; ++m)
#pragma unroll
                    for (int n = 0; n < 2; ++n) acc[a][b][m][n] = (f32x4){0.f, 0.f, 0.f, 0.f};
        cur = nxt; cA = nA; cB = nB; ++ui;
        if (wr == 1) PG8_BAR;
    }
    PG8_WAIT_V(0);
    PG8_BAR;
#undef PG8_SA
#undef PG8_SB
#undef PG8_STAGE
#undef PG8_LDA
#undef PG8_LDB
#undef PG8_MMA
#undef PG8_WAIT_V
#undef PG8_WAIT_L
#undef PG8_BAR
#undef PG8_SCHED
}
}
using pg8::Unit;

struct EpiRetIn {
    static constexpr bool PERM = true, KHOOK = false;
    bf16_t *Q, *Kk, *V, *G; const float* tab;
    __device__ __forceinline__ void operator()(const f32x4 (&acc)[2][2][4][2], const Unit& u, int wr, int wc, int fr, int fq, LAS unsigned char*) const {
        const int row0 = u.pm * 256 + wr * 64 + fr, cw = wc * 32 + 8 * fq;
        if (u.pn < 8) {
            const int head = u.pn & 3; const bool isk = u.pn >= 4;
            bf16_t* dst = (isk ? Kk : Q) + head * 256 + cw;
            const float lg = log2f(1.0f - exp2f(-5.0f - (float)head));
#pragma unroll
            for (int ai = 0; ai < 2; ++ai)
#pragma unroll
                for (int m = 0; m < 4; ++m) {
                    const int row = row0 + ai * 128 + m * 16, pos = row & 2047, ci = pos & 127;
                    const float sc = isk ? exp2f(-lg * (float)ci) * 0.0625f : exp2f(lg * (float)ci);
                    const f32x4* tp = (const f32x4*)(tab + ((size_t)pos * 128 + cw) * 2);
                    const f32x4 t0 = tp[0], t1 = tp[1], t2 = tp[2], t3 = tp[3];
                    const f32x4 cs0 = {t0[0], t0[2], t1[0], t1[2]}, sn0 = {t0[1], t0[3], t1[1], t1[3]}, cs1 = {t2[0], t2[2], t3[0], t3[2]}, sn1 = {t2[1], t2[3], t3[1], t3[3]};
                    const f32x4 x10 = acc[ai][0][m][0], x11 = acc[ai][0][m][1], x20 = acc[ai][1][m][0], x21 = acc[ai][1][m][1];
                    const f32x4 o10 = (x10 * cs0 - x20 * sn0) * sc, o11 = (x11 * cs1 - x21 * sn1) * sc;
                    const f32x4 o20 = (x20 * cs0 + x10 * sn0) * sc, o21 = (x21 * cs1 + x11 * sn1) * sc;
                    bf16_t* rp = dst + (size_t)row * 1024;
                    *(u32x4*)rp = pack8(o10, o11); *(u32x4*)(rp + 128) = pack8(o20, o21);
                }
        } else {
            bf16_t* dst = (u.pn < 16 ? V + (u.pn - 8) * 256 : G + (u.pn - 16) * 256) + cw;
#pragma unroll
            for (int ai = 0; ai < 2; ++ai)
#pragma unroll
                for (int m = 0; m < 4; ++m) {
                    bf16_t* rp = dst + (size_t)(row0 + ai * 128 + m * 16) * 2048;
#pragma unroll
                    for (int bj = 0; bj < 2; ++bj) *(u32x4*)(rp + bj * 128) = pack8(acc[ai][bj][m][0], acc[ai][bj][m][1]);
                }
        }
    }
};
struct EpiRes {
    static constexpr bool PERM = false, KHOOK = false;
    const float* base; float* out; const float* gate;
    __device__ __forceinline__ void operator()(const f32x4 (&acc)[2][2][4][2], const Unit& u, int wr, int wc, int fr, int fq, LAS unsigned char*) const {
        const int row0 = u.pm * 256 + wr * 64 + fr, col0 = u.pn * 256 + wc * 32 + 4 * fq;
#pragma unroll
        for (int ai = 0; ai < 2; ++ai)
#pragma unroll
            for (int m = 0; m < 4; ++m) {
                const int row = row0 + ai * 128 + m * 16; const float* gp = gate + (size_t)(row >> 11) * 6144 + col0; const size_t off = (size_t)row * 1024 + col0;
#pragma unroll
                for (int bj = 0; bj < 2; ++bj)
#pragma unroll
                    for (int n = 0; n < 2; ++n) { const int c = bj * 128 + n * 16; const f32x4 gv = *(const f32x4*)(gp + c), bs = *(const f32x4*)(base + off + c);
                        *(f32x4*)(out + off + c) = bs + gv * acc[ai][bj][m][n]; }
            }
    }
};
struct EpiResHead {
    static constexpr bool PERM = false, KHOOK = true;
    const float* base; float* out; const float* gate; const float* ssq;
    __device__ __forceinline__ void prep(const Unit& u, LAS unsigned char* lx) const {
        const int t = threadIdx.x;
        if (t < 256) {
            const f32x4* p = (const f32x4*)(ssq + (size_t)(u.pm * 256 + t) * 32);
            float ri[4];
#pragma unroll
            for (int h = 0; h < 4; ++h) { const f32x4 a = p[2 * h], b = p[2 * h + 1]; const float sm = ((a[0] + a[1]) + (a[2] + a[3])) + ((b[0] + b[1]) + (b[2] + b[3])); ri[h] = 1.0f / sqrtf(sm * (1.0f / 512.0f) + EPS); }
            *(LAS f32x4*)(lx + t * 16) = (f32x4){ri[3], ri[0] / ri[1], ri[1] / ri[2], ri[2] / ri[3]};
        }
        asm volatile("s_waitcnt lgkmcnt(0)" ::: "memory");
    }
    __device__ __forceinline__ void khook(f32x4 (&acc)[2][2][4][2], int hb, int wr, int fr, LAS unsigned char* lx) const {
#pragma unroll
        for (int ai = 0; ai < 2; ++ai)
#pragma unroll
            for (int m = 0; m < 4; ++m) { const float f = ((const LAS float*)lx)[(ai * 128 + wr * 64 + m * 16 + fr) * 4 + hb];
#pragma unroll
                for (int bj = 0; bj < 2; ++bj)
#pragma unroll
                    for (int n = 0; n < 2; ++n) acc[ai][bj][m][n] = acc[ai][bj][m][n] * f; }
    }
    __device__ __forceinline__ void operator()(const f32x4 (&acc)[2][2][4][2], const Unit& u, int wr, int wc, int fr, int fq, LAS unsigned char* lx) const {
        const int row0 = u.pm * 256 + wr * 64 + fr, col0 = u.pn * 256 + wc * 32 + 4 * fq;
#pragma unroll
        for (int ai = 0; ai < 2; ++ai)
#pragma unroll
            for (int m = 0; m < 4; ++m) {
                const int row = row0 + ai * 128 + m * 16; const float* gp = gate + (size_t)(row >> 11) * 6144 + col0; const size_t off = (size_t)row * 1024 + col0;
                const float r3 = ((const LAS float*)lx)[(ai * 128 + wr * 64 + m * 16 + fr) * 4];
#pragma unroll
                for (int bj = 0; bj < 2; ++bj)
#pragma unroll
                    for (int n = 0; n < 2; ++n) { const int c = bj * 128 + n * 16; const f32x4 gv = *(const f32x4*)(gp + c), bs = *(const f32x4*)(base + off + c);
                        *(f32x4*)(out + off + c) = bs + gv * (acc[ai][bj][m][n] * r3); }
            }
    }
};
struct NormOut { bf16_t* dst; const float* gain; const float* sh; const float* sc; int bstride; };
template <bool HEAD, int NX> struct EpiResNorm {
    static constexpr bool PERM = !HEAD, KHOOK = HEAD;
    static constexpr int FQS = PERM ? 8 : 4, NS = PERM ? 4 : 16;
    const float* base; float* out; const float* gate; const float* ssq; NormOut no[2]; float* slots; unsigned* cnt; unsigned target;
    __device__ __forceinline__ void prep(const Unit& u, LAS unsigned char* lx) const {
        const int t = threadIdx.x;
        if (t < 256) {
            const f32x4* p = (const f32x4*)(ssq + (size_t)(u.pm * 256 + t) * 32);
            float ri[4];
#pragma unroll
            for (int h = 0; h < 4; ++h) { const f32x4 a = p[2 * h], b = p[2 * h + 1]; const float sm = ((a[0] + a[1]) + (a[2] + a[3])) + ((b[0] + b[1]) + (b[2] + b[3])); ri[h] = 1.0f / sqrtf(sm * (1.0f / 512.0f) + EPS); }
            *(LAS f32x4*)(lx + t * 16) = (f32x4){ri[3], ri[0] / ri[1], ri[1] / ri[2], ri[2] / ri[3]};
        }
        asm volatile("s_waitcnt lgkmcnt(0)" ::: "memory");
    }
    __device__ __forceinline__ void khook(f32x4 (&acc)[2][2][4][2], int hb, int wr, int fr, LAS unsigned char* lx) const {
        int rb = wr * 64 + fr; asm volatile("" : "+v"(rb));
#pragma unroll
        for (int ai = 0; ai < 2; ++ai)
#pragma unroll
            for (int m = 0; m < 4; ++m) { const float f = ((const LAS float*)lx)[(ai * 128 + rb + m * 16) * 4 + hb];
#pragma unroll
                for (int bj = 0; bj < 2; ++bj)
#pragma unroll
                    for (int n = 0; n < 2; ++n) acc[ai][bj][m][n] = acc[ai][bj][m][n] * f; }
    }
    __device__ __forceinline__ void operator()(f32x4 (&acc)[2][2][4][2], const Unit& u, int wr, int wc, int fr, int fq, LAS unsigned char* lx) const {
        LAS float* P = (LAS float*)(lx + 4096);
        LAS float* Sr = (LAS float*)(lx + 9216);
        const int row0 = u.pm * 256 + wr * 64 + fr, col0 = u.pn * 256 + wc * 32 + FQS * fq, wid = wr * 4 + wc, b = (u.pm * 256) >> 11;
        const int lane = (int)__builtin_amdgcn_mbcnt_hi(~0u, __builtin_amdgcn_mbcnt_lo(~0u, 0u));
        const float* gp = gate + (size_t)b * 6144 + col0;
        int rb = wr * 64 + fr; asm volatile("" : "+v"(rb));
#pragma unroll
        for (int ai = 0; ai < 2; ++ai)
#pragma unroll
            for (int m = 0; m < 4; ++m) {
                const int row = row0 + ai * 128 + m * 16; const size_t off = (size_t)row * 1024 + col0;
                const float r3 = HEAD ? ((const LAS float*)lx)[(ai * 128 + rb + m * 16) * 4] : 1.0f;
                float ss = 0.f;
#pragma unroll
                for (int bj = 0; bj < 2; ++bj)
#pragma unroll
                    for (int n = 0; n < 2; ++n) { const int c = bj * 128 + n * NS; const f32x4 gv = *(const f32x4*)(gp + c), bs = *(const f32x4*)(base + off + c);
                        const f32x4 v = bs + gv * (HEAD ? acc[ai][bj][m][n] * r3 : acc[ai][bj][m][n]); acc[ai][bj][m][n] = v; *(f32x4*)(out + off + c) = v;
                        ss += (v[0] * v[0] + v[1] * v[1]) + (v[2] * v[2] + v[3] * v[3]); }
                ss += __shfl_xor(ss, 16); ss += __shfl_xor(ss, 32);
                if (fq == 0) P[(ai * 128 + rb + m * 16) * 4 + wc] = ss;
            }
        asm volatile("s_waitcnt lgkmcnt(0)" ::: "memory"); __builtin_amdgcn_s_barrier(); asm volatile("" ::: "memory");
        const int rl = wid * 32 + (lane & 31);
        if (lane < 32) { const f32x4 p = *(const LAS f32x4*)(P + rl * 4); const float sm = (p[0] + p[1]) + (p[2] + p[3]);
            __hip_atomic_store(slots + (size_t)(u.pm * 256 + rl) * 4 + u.pn, sm, __ATOMIC_RELAXED, __HIP_MEMORY_SCOPE_AGENT); }
        asm volatile("s_waitcnt vmcnt(0)" ::: "memory");
        if (lane == 0) __hip_atomic_fetch_add(cnt + 16 * u.pm, 1u, __ATOMIC_RELAXED, __HIP_MEMORY_SCOPE_AGENT);
        if (wid == 0) {
            unsigned sp = 0;
            while ((unsigned)__builtin_amdgcn_readfirstlane(__hip_atomic_load(cnt + 16 * u.pm, __ATOMIC_RELAXED, __HIP_MEMORY_SCOPE_AGENT)) < target) { __builtin_amdgcn_s_sleep(2); if (++sp > (1u << 16)) break; }
            __builtin_amdgcn_fence(__ATOMIC_ACQUIRE, "agent");
            asm volatile("s_waitcnt vmcnt(0)" ::: "memory");
        }
        asm volatile("s_waitcnt vmcnt(0) lgkmcnt(0)" ::: "memory"); __builtin_amdgcn_s_barrier(); asm volatile("" ::: "memory");
        if (lane < 32) { const float* sl = slots + (size_t)(u.pm * 256 + rl) * 4; float t = 0.f;
#pragma unroll
            for (int k = 0; k < 4; ++k) t += __hip_atomic_load(sl + k, __ATOMIC_RELAXED, __HIP_MEMORY_SCOPE_AGENT);
            Sr[rl] = 1.0f / sqrtf(t * (1.0f / DM) + EPS); }
        asm volatile("s_waitcnt vmcnt(0) lgkmcnt(0)" ::: "memory"); __builtin_amdgcn_s_barrier(); asm volatile("" ::: "memory");
#pragma unroll
        for (int ai = 0; ai < 2; ++ai)
#pragma unroll
            for (int m = 0; m < 4; ++m) {
                const int rloc = ai * 128 + rb + m * 16; const float ri = Sr[rloc]; const size_t off = (size_t)(u.pm * 256 + rloc) * 1024 + col0;
#pragma unroll
                for (int bj = 0; bj < 2; ++bj)
#pragma unroll
                    for (int n = 0; n < 2; ++n) { const int c = col0 + bj * 128 + n * NS; const f32x4 vr = acc[ai][bj][m][n] * ri;
#pragma unroll
                        for (int x = 0; x < NX; ++x) { const f32x4 g4 = *(const f32x4*)(no[x].gain + c), s4 = *(const f32x4*)(no[x].sc + (size_t)b * no[x].bstride + c), h4 = *(const f32x4*)(no[x].sh + (size_t)b * no[x].bstride + c);
                            const f32x4 h = vr * g4 * (s4 + 1.0f) + h4; u32x2 w; w.x = cvt_pk_bf16(h[0], h[1]); w.y = cvt_pk_bf16(h[2], h[3]); *(u32x2*)(no[x].dst + off + bj * 128 + n * NS) = w; } }
            }
    }
};
struct EpiResFinal {
    static constexpr bool PERM = true, KHOOK = false;
    const float* base; float* out; const float* gate; const float* gain; float* slots; unsigned* cnt; unsigned target;
    __device__ __forceinline__ void operator()(f32x4 (&acc)[2][2][4][2], const Unit& u, int wr, int wc, int fr, int fq, LAS unsigned char* lx) const {
        LAS float* P = (LAS float*)lx;
        LAS float* Sr = (LAS float*)(lx + 4096);
        const int row0 = u.pm * 256 + wr * 64 + fr, col0 = u.pn * 256 + wc * 32 + 8 * fq, wid = wr * 4 + wc;
        const int lane = (int)__builtin_amdgcn_mbcnt_hi(~0u, __builtin_amdgcn_mbcnt_lo(~0u, 0u));
#pragma unroll
        for (int ai = 0; ai < 2; ++ai)
#pragma unroll
            for (int m = 0; m < 4; ++m) {
                const int row = row0 + ai * 128 + m * 16; const float* gp = gate + (size_t)(row >> 11) * 6144 + col0; const size_t off = (size_t)row * 1024 + col0;
                float ss = 0.f;
#pragma unroll
                for (int bj = 0; bj < 2; ++bj)
#pragma unroll
                    for (int n = 0; n < 2; ++n) { const int c = bj * 128 + n * 4; const f32x4 gv = *(const f32x4*)(gp + c), bs = *(const f32x4*)(base + off + c);
                        const f32x4 v = bs + gv * acc[ai][bj][m][n]; acc[ai][bj][m][n] = v; ss += (v[0] * v[0] + v[1] * v[1]) + (v[2] * v[2] + v[3] * v[3]); }
                ss += __shfl_xor(ss, 16); ss += __shfl_xor(ss, 32);
                if (fq == 0) P[(ai * 128 + wr * 64 + m * 16 + fr) * 4 + wc] = ss;
            }
        asm volatile("s_waitcnt lgkmcnt(0)" ::: "memory"); __builtin_amdgcn_s_barrier(); asm volatile("" ::: "memory");
        const int rl = wid * 32 + (lane & 31);
        if (lane < 32) { const f32x4 p = *(const LAS f32x4*)(P + rl * 4); const float sm = (p[0] + p[1]) + (p[2] + p[3]);
            __hip_atomic_store(slots + (size_t)(u.pm * 256 + rl) * 4 + u.pn, sm, __ATOMIC_RELAXED, __HIP_MEMORY_SCOPE_AGENT); }
        asm volatile("s_waitcnt vmcnt(0)" ::: "memory");
        if (lane == 0) __hip_atomic_fetch_add(cnt + 16 * u.pm, 1u, __ATOMIC_RELAXED, __HIP_MEMORY_SCOPE_AGENT);
        if (wid == 0) {
            unsigned sp = 0;
            while ((unsigned)__builtin_amdgcn_readfirstlane(__hip_atomic_load(cnt + 16 * u.pm, __ATOMIC_RELAXED, __HIP_MEMORY_SCOPE_AGENT)) < target) { __builtin_amdgcn_s_sleep(2); if (++sp > (1u << 16)) break; }
            __builtin_amdgcn_fence(__ATOMIC_ACQUIRE, "agent");
            asm volatile("s_waitcnt vmcnt(0)" ::: "memory");
        }
        asm volatile("s_waitcnt vmcnt(0) lgkmcnt(0)" ::: "memory"); __builtin_amdgcn_s_barrier(); asm volatile("" ::: "memory");
        if (lane < 32) { const float* sl = slots + (size_t)(u.pm * 256 + rl) * 4; float t = 0.f;
#pragma unroll
            for (int k = 0; k < 4; ++k) t += __hip_atomic_load(sl + k, __ATOMIC_RELAXED, __HIP_MEMORY_SCOPE_AGENT);
            Sr[rl] = 1.0f / sqrtf(t * (1.0f / DM) + EPS); }
        asm volatile("s_waitcnt vmcnt(0) lgkmcnt(0)" ::: "memory"); __builtin_amdgcn_s_barrier(); asm volatile("" ::: "memory");
#pragma unroll
        for (int ai = 0; ai < 2; ++ai)
#pragma unroll
            for (int m = 0; m < 4; ++m) {
                const int rloc = ai * 128 + wr * 64 + m * 16 + fr; const float ri = Sr[rloc]; const size_t off = (size_t)(u.pm * 256 + rloc) * 1024 + col0;
#pragma unroll
                for (int bj = 0; bj < 2; ++bj)
#pragma unroll
                    for (int n = 0; n < 2; ++n) { const int c = bj * 128 + n * 4; __builtin_nontemporal_store(acc[ai][bj][m][n] * ri * *(const f32x4*)(gain + col0 + c), (f32x4*)(out + off + c)); }
            }
    }
};
struct EpiRope {
    static constexpr bool PERM = true, KHOOK = false;
    bf16_t* dstR; bf16_t* dstV; int nrope; const float* tab; float scale;
    bf16_t* dstQ; int nq0; float scaleQ;
    __device__ __forceinline__ void operator()(const f32x4 (&acc)[2][2][4][2], const Unit& u, int wr, int wc, int fr, int fq, LAS unsigned char*) const {
        const int row0 = u.pm * 256 + wr * 64 + fr, cw = wc * 32 + 8 * fq;
        if (u.pn < nrope || u.pn >= nq0) {
            const int p = cw >> 6, dd = cw & 63; const bool isq = u.pn >= nq0; const float scale = isq ? scaleQ : this->scale;
            bf16_t* dst = (isq ? dstQ + (u.pn - nq0) * 256 : dstR + u.pn * 256) + p * 128 + dd;
#pragma unroll
            for (int ai = 0; ai < 2; ++ai)
#pragma unroll
                for (int m = 0; m < 4; ++m) {
                    const int row = row0 + ai * 128 + m * 16, pos = row & 2047;
                    const f32x4* tp = (const f32x4*)(tab + ((size_t)pos * 64 + dd) * 2);
                    const f32x4 t0 = tp[0], t1 = tp[1], t2 = tp[2], t3 = tp[3];
                    const f32x4 cs0 = {t0[0], t0[2], t1[0], t1[2]}, sn0 = {t0[1], t0[3], t1[1], t1[3]}, cs1 = {t2[0], t2[2], t3[0], t3[2]}, sn1 = {t2[1], t2[3], t3[1], t3[3]};
                    const f32x4 x10 = acc[ai][0][m][0], x11 = acc[ai][0][m][1], x20 = acc[ai][1][m][0], x21 = acc[ai][1][m][1];
                    const f32x4 o10 = (x10 * cs0 - x20 * sn0) * scale, o11 = (x11 * cs1 - x21 * sn1) * scale;
                    const f32x4 o20 = (x20 * cs0 + x10 * sn0) * scale, o21 = (x21 * cs1 + x11 * sn1) * scale;
                    bf16_t* rp = dst + (size_t)row * 1024;
                    *(u32x4*)rp = pack8(o10, o11); *(u32x4*)(rp + 64) = pack8(o20, o21);
                }
        } else {
            bf16_t* dst = dstV + (u.pn - nrope) * 256 + cw;
#pragma unroll
            for (int ai = 0; ai < 2; ++ai)
#pragma unroll
                for (int m = 0; m < 4; ++m) {
                    bf16_t* rp = dst + (size_t)(row0 + ai * 128 + m * 16) * 1024;
#pragma unroll
                    for (int bj = 0; bj < 2; ++bj) *(u32x4*)(rp + bj * 128) = pack8(acc[ai][bj][m][0], acc[ai][bj][m][1]);
                }
        }
    }
};
__device__ __forceinline__ float dpp_shr1(float v) { return __builtin_bit_cast(float, __builtin_amdgcn_update_dpp(0, __builtin_bit_cast(int, v), 0x111, 0xf, 0xf, true)); }
__device__ __forceinline__ float dpp_shr2(float v) { return __builtin_bit_cast(float, __builtin_amdgcn_update_dpp(0, __builtin_bit_cast(int, v), 0x112, 0xf, 0xf, true)); }
__device__ __forceinline__ float dpp_ror1(float v) { return __builtin_bit_cast(float, __builtin_amdgcn_update_dpp(0, __builtin_bit_cast(int, v), 0x121, 0xf, 0xf, false)); }
__device__ __forceinline__ float dpp_shr1_old(float old, float v) { return __builtin_bit_cast(float, __builtin_amdgcn_update_dpp(__builtin_bit_cast(int, old), __builtin_bit_cast(int, v), 0x111, 0xf, 0xf, false)); }
__device__ __forceinline__ float dpp_shr2_old(float old, float v) { return __builtin_bit_cast(float, __builtin_amdgcn_update_dpp(__builtin_bit_cast(int, old), __builtin_bit_cast(int, v), 0x112, 0xf, 0xf, false)); }
__device__ __forceinline__ float dpp_ror2(float v) { return __builtin_bit_cast(float, __builtin_amdgcn_update_dpp(0, __builtin_bit_cast(int, v), 0x122, 0xf, 0xf, false)); }
struct EpiFfn {
    static constexpr bool PERM = true, KHOOK = false;
    bf16_t* U; const float* wconv; const float* bconv;
    __device__ __forceinline__ void operator()(const f32x4 (&acc)[2][2][4][2], const Unit& u, int wr, int wc, int fr, int fq, LAS unsigned char* lx) const {
        const int cw = wc * 32 + 8 * fq, j0 = u.pn * 128 + cw;
        f32x4 w0[2], w1[2], w2[2], bc[2];
#pragma unroll
        for (int n = 0; n < 2; ++n) { w0[n] = *(const f32x4*)(wconv + j0 + 4 * n); w1[n] = *(const f32x4*)(wconv + DFF + j0 + 4 * n); w2[n] = *(const f32x4*)(wconv + 2 * DFF + j0 + 4 * n); bc[n] = *(const f32x4*)(bconv + j0 + 4 * n); }
        LAS float* hx = (LAS float*)lx;
        if (fr >= 14) {
#pragma unroll
            for (int ai = 0; ai < 2; ++ai) { LAS float* p = hx + ((((2 * ai + wr) * 4 + wc) * 2 + (fr - 14)) * 4 + fq) * 8;
                *(LAS f32x4*)p = acc[ai][0][3][0]; *(LAS f32x4*)(p + 4) = acc[ai][0][3][1]; }
        }
        asm volatile("s_waitcnt lgkmcnt(0)" ::: "memory"); __builtin_amdgcn_s_barrier(); asm volatile("" ::: "memory");
        const int rr = fr >= 14 ? fr - 14 : 0;
#pragma unroll
        for (int ai = 0; ai < 2; ++ai) {
            const int qc = 2 * ai + wr;
            f32x4 pv[2] = {(f32x4){0.f, 0.f, 0.f, 0.f}, (f32x4){0.f, 0.f, 0.f, 0.f}};
            if (qc >= 1) { const LAS float* p = hx + (((((qc - 1) * 4 + wc) * 2 + rr) * 4 + fq) * 8); pv[0] = *(const LAS f32x4*)p; pv[1] = *(const LAS f32x4*)(p + 4); }
#pragma unroll
            for (int m = 0; m < 4; ++m) {
                const int trow = ai * 128 + wr * 64 + m * 16 + fr, grow = u.pm * 254 - 2 + trow, pos = grow & 2047;
                f32x4 res[2];
#pragma unroll
                for (int n = 0; n < 2; ++n) {
                    const f32x4 cur = acc[ai][0][m][n], gg = acc[ai][1][m][n];
                    f32x4 cv;
#pragma unroll
                    for (int j = 0; j < 4; ++j) {
                        float a1 = dpp_shr1_old(dpp_ror1(pv[n][j]), cur[j]), a2 = dpp_shr2_old(dpp_ror2(pv[n][j]), cur[j]);
                        a1 = pos < 1 ? 0.f : a1; a2 = pos < 2 ? 0.f : a2;
                        cv[j] = w0[n][j] * a2 + w1[n][j] * a1 + w2[n][j] * cur[j] + bc[n][j];
                    }
                    const f32x2 ga = gelu_pk((f32x2){cv[0], cv[1]}), gb = gelu_pk((f32x2){cv[2], cv[3]});
                    res[n] = (f32x4){ga.x * gg[0], ga.y * gg[1], gb.x * gg[2], gb.y * gg[3]};
                    pv[n] = cur;
                }
                if (trow >= 2 && grow < TOK) *(u32x4*)(U + (size_t)grow * DFF + j0) = pack8(res[0], res[1]);
            }
        }
    }
};

__device__ __forceinline__ int rowmap(int kind, int n) {
    if (kind == 0) return n;
    if (kind == 1) { const int half = n >= DFF ? 1 : 0, j = n - half * DFF; return (j >> 7) * 256 + half * 128 + (j & 127); }
    const int h = n >> 8, p = (n >> 7) & 1, d = n & 127; return h * 256 + (d >> 6) * 128 + p * 64 + (d & 63);
}
__device__ __forceinline__ void transpose_item(const float* W, int ldw, int col0, int ncols, int K, bf16_t* WT, int kind, int row_off, LAS float* scr, int item, int lane) {
    const int nblk = ncols / 32, kb = item / nblk, nb = item % nblk, k0 = 64 * kb, n0 = 32 * nb;
    f32x4 v[8];
#pragma unroll
    for (int i = 0; i < 8; ++i) v[i] = *(const f32x4*)(W + (size_t)(k0 + 8 * i + (lane >> 3)) * ldw + col0 + n0 + 4 * (lane & 7));
#pragma unroll
    for (int i = 0; i < 8; ++i) { LAS float* d = scr + (8 * i + (lane >> 3)) * 33 + 4 * (lane & 7); d[0] = v[i][0]; d[1] = v[i][1]; d[2] = v[i][2]; d[3] = v[i][3]; }
    asm volatile("s_waitcnt lgkmcnt(0)" ::: "memory");
    const int c = lane & 7;
#pragma unroll
    for (int j = 0; j < 4; ++j) { const int n = (lane >> 3) + 8 * j; const LAS float* s = scr + (8 * c) * 33 + n;
        u32x4 o; o.x = cvt_pk_bf16(s[0 * 33], s[1 * 33]); o.y = cvt_pk_bf16(s[2 * 33], s[3 * 33]); o.z = cvt_pk_bf16(s[4 * 33], s[5 * 33]); o.w = cvt_pk_bf16(s[6 * 33], s[7 * 33]);
        *(u32x4*)(WT + (size_t)(row_off + rowmap(kind, n0 + n)) * K + k0 + 8 * c) = o; }
    asm volatile("s_waitcnt lgkmcnt(0)" ::: "memory");
}
__device__ __forceinline__ void mods_item(const float* c, const float* W, int N, int strip, int kc, LAS float* scr, LAS float* red, int lane) {
    const int k0 = kc * 128, n0 = strip * 64;
#pragma unroll
    for (int i = 0; i < 16; ++i) { const int idx = lane + 64 * i, b = idx >> 7, kk = idx & 127; scr[kk * 8 + b] = silu_f(c[b * 1024 + k0 + kk]); }
    asm volatile("s_waitcnt lgkmcnt(0)" ::: "memory");
    float a0 = 0.f, a1 = 0.f, a2 = 0.f, a3 = 0.f, a4 = 0.f, a5 = 0.f, a6 = 0.f, a7 = 0.f;
#pragma unroll 32
    for (int kk = 0; kk < 128; ++kk) {
        const float wv = __builtin_nontemporal_load(W + (size_t)(k0 + kk) * N + n0 + lane);
        const f32x4 s0 = *(const LAS f32x4*)(scr + kk * 8), s1 = *(const LAS f32x4*)(scr + kk * 8 + 4);
        a0 += s0[0] * wv; a1 += s0[1] * wv; a2 += s0[2] * wv; a3 += s0[3] * wv; a4 += s1[0] * wv; a5 += s1[1] * wv; a6 += s1[2] * wv; a7 += s1[3] * wv;
    }
    red[0 * 64 + lane] = a0; red[1 * 64 + lane] = a1; red[2 * 64 + lane] = a2; red[3 * 64 + lane] = a3;
    red[4 * 64 + lane] = a4; red[5 * 64 + lane] = a5; red[6 * 64 + lane] = a6; red[7 * 64 + lane] = a7;
}
__device__ __forceinline__ void sincos_acc(float ang, float& s, float& c) {
    const double x = (double)ang;
    const double k = __builtin_rint(x * 0.6366197723675814);
    double y = __builtin_fma(-k, 1.5707963267948966, x); y = __builtin_fma(-k, 6.123233995736766e-17, y);
    const int q = ((int)k) & 3;
    const double y2 = y * y;
    const double sp = y * (1.0 + y2 * (-1.0 / 6.0 + y2 * (1.0 / 120.0 + y2 * (-1.0 / 5040.0 + y2 * (1.0 / 362880.0 + y2 * (-1.0 / 39916800.0 + y2 * (1.0 / 6227020800.0)))))));
    const double cp = 1.0 + y2 * (-0.5 + y2 * (1.0 / 24.0 + y2 * (-1.0 / 720.0 + y2 * (1.0 / 40320.0 + y2 * (-1.0 / 3628800.0 + y2 * (1.0 / 479001600.0))))));
    const double ss = (q == 0) ? sp : (q == 1) ? cp : (q == 2) ? -sp : -cp;
    const double cc = (q == 0) ? cp : (q == 1) ? -sp : (q == 2) ? -cp : sp;
    s = (float)ss; c = (float)cc;
}

struct Args { const float* in[20]; float* out; unsigned char* ws; int ph_lo, ph_hi; };

template <int PART> __device__ __forceinline__ void p0_prologue(const Args& a, LAS unsigned char* lds, int wave, int lane, int G) {
    LAS float* scr = (LAS float*)(lds + wave * 16384);
    const int gw = blockIdx.x * 8 + wave, NGW = G * 8;
    unsigned char* ws = a.ws;
    if (PART == 0) {
    for (int strip = blockIdx.x; strip < 224; strip += G) {
        LAS float* red = (LAS float*)(lds + wave * 16384 + 8192);
        const float* W; const float* bias; float* out; int N, st;
        if (strip < 96) { W = a.in[3]; bias = a.in[4]; out = (float*)(ws + WS_MOD0); N = 6144; st = strip; }
        else if (strip < 192) { W = a.in[3] + (size_t)1024 * 6144; bias = a.in[4] + 6144; out = (float*)(ws + WS_MOD1); N = 6144; st = strip - 96; }
        else { W = a.in[12]; bias = a.in[13]; out = (float*)(ws + WS_KVMOD); N = 2048; st = strip - 192; }
        mods_item(a.in[1], W, N, st, wave, scr, red, lane);
        __syncthreads();
        { float sum = bias[st * 64 + lane];
#pragma unroll
          for (int kc = 0; kc < 8; ++kc) sum += ((const LAS float*)(lds + kc * 16384 + 8192))[wave * 64 + lane];
          out[(size_t)wave * N + st * 64 + lane] = sum; }
        __syncthreads();
    }
    }
    if (PART == 1) {
    {
        constexpr int T_RIN = (1024 / 128) * (6144 / 64), T_ROUT = (2048 / 128) * (1024 / 64), T_FIN = (1024 / 128) * (NFF / 64), T_FDN = (DFF / 128) * (1024 / 64), T_SQ = (1024 / 128) * (1024 / 64);
        constexpr int NTILES = T_RIN + T_ROUT + 2 * T_FIN + 2 * T_FDN + 4 * T_SQ;
        struct TrJob { const float* W; int ldw, col0, ncols, K; bf16_t* WT; int kind, row_off, item; };
        auto decode = [&](int it) -> TrJob {
            int r = it;
            if (r < T_RIN) return TrJob{a.in[5], 6144, 0, 6144, 1024, (bf16_t*)(ws + WS_WRIN), 0, 0, r}; r -= T_RIN;
            if (r < T_ROUT) return TrJob{a.in[6], 1024, 0, 1024, 2048, (bf16_t*)(ws + WS_WROUT), 0, 0, r}; r -= T_ROUT;
            if (r < T_FIN) return TrJob{a.in[7], NFF, 0, NFF, 1024, (bf16_t*)(ws + WS_WFIN0), 1, 0, r}; r -= T_FIN;
            if (r < T_FIN) return TrJob{a.in[7] + (size_t)1024 * NFF, NFF, 0, NFF, 1024, (bf16_t*)(ws + WS_WFIN1), 1, 0, r}; r -= T_FIN;
            if (r < T_FDN) return TrJob{a.in[10], 1024, 0, 1024, DFF, (bf16_t*)(ws + WS_WFDN0), 0, 0, r}; r -= T_FDN;
            if (r < T_FDN) return TrJob{a.in[10] + (size_t)DFF * 1024, 1024, 0, 1024, DFF, (bf16_t*)(ws + WS_WFDN1), 0, 0, r}; r -= T_FDN;
            if (r < T_SQ) return TrJob{a.in[14], 2048, 0, 1024, 1024, (bf16_t*)(ws + WS_WKV), 2, 0, r}; r -= T_SQ;
            if (r < T_SQ) return TrJob{a.in[14], 2048, 1024, 1024, 1024, (bf16_t*)(ws + WS_WKV), 0, 1024, r}; r -= T_SQ;
            if (r < T_SQ) return TrJob{a.in[15], 1024, 0, 1024, 1024, (bf16_t*)(ws + WS_WQ), 2, 0, r}; r -= T_SQ;
            return TrJob{a.in[18], 1024, 0, 1024, 1024, (bf16_t*)(ws + WS_WO), 0, 0, r};
        };
        const int tid = threadIdx.x, c4 = tid & 15, rp = tid >> 4;
        f32x4 v[4];
        int it = blockIdx.x;
        TrJob cur = decode(it < NTILES ? it : 0);
#define TR_LOAD(j_) do { const int nblk_ = (j_).ncols / 64, k0_ = 128 * ((j_).item / nblk_), n0_ = 64 * ((j_).item % nblk_); \
        _Pragma("unroll") for (int i = 0; i < 2; ++i) { const float* p_ = (j_).W + (size_t)(k0_ + 2 * (32 * i + rp)) * (j_).ldw + (j_).col0 + n0_ + 4 * c4; v[2 * i] = __builtin_nontemporal_load((const f32x4*)p_); v[2 * i + 1] = __builtin_nontemporal_load((const f32x4*)(p_ + (j_).ldw)); } } while (0)
        if (it < NTILES) TR_LOAD(cur);
        int buf = 0;
        for (; it < NTILES; it += G) {
            LAS unsigned* tile = (LAS unsigned*)(lds + buf * 16896);
#pragma unroll
            for (int i = 0; i < 2; ++i) { LAS unsigned* d = tile + (32 * i + rp) * 65 + 4 * c4;
                d[0] = cvt_pk_bf16(v[2 * i][0], v[2 * i + 1][0]); d[1] = cvt_pk_bf16(v[2 * i][1], v[2 * i + 1][1]); d[2] = cvt_pk_bf16(v[2 * i][2], v[2 * i + 1][2]); d[3] = cvt_pk_bf16(v[2 * i][3], v[2 * i + 1][3]); }
            __syncthreads();
            const TrJob job = cur;
            if (it + G < NTILES) { cur = decode(it + G); TR_LOAD(cur); }
            { const int nblk = job.ncols / 64, k0 = 128 * (job.item / nblk), n0 = 64 * (job.item % nblk);
#pragma unroll
              for (int p = 0; p < 2; ++p) { const int n = 32 * p + rp; const LAS unsigned* sp = tile + (4 * c4) * 65 + n;
                  u32x4 o; o.x = sp[0]; o.y = sp[65]; o.z = sp[130]; o.w = sp[195];
                  __builtin_nontemporal_store(o, (u32x4*)(job.WT + (size_t)(job.row_off + rowmap(job.kind, n0 + n)) * job.K + k0 + 8 * c4)); } }
            buf ^= 1;
        }
#undef TR_LOAD
        __syncthreads();
    }
    const int gt = blockIdx.x * 512 + threadIdx.x, NGT = G * 512;
    f32x2* tabR = (f32x2*)(ws + WS_TABR); f32x2* tabD = (f32x2*)(ws + WS_TABD);
    for (int i = gt; i < 2048 * 128; i += NGT) { const int pos = i >> 7, f = i & 127; const float fr = exp2f(-13.287712379549449f * ((float)f / 127.0f)); float s, c; sincos_acc((float)pos * fr, s, c); tabR[i] = (f32x2){c, s}; }
    for (int i = gt; i < 2048 * 64; i += NGT) { const int pos = i >> 6, f = i & 63; const float fr = exp2f(-13.287712379549449f * ((float)f / 64.0f)); float s, c; sincos_acc((float)pos * fr, s, c); tabD[i] = (f32x2){c, s}; }
    }
    if (PART == 0 && gw == 0) {
        const float* lv = a.in[16];
        float d0 = lv[lane] * lv[128 + lane] + lv[64 + lane] * lv[128 + 64 + lane];
        float d1 = lv[256 + lane] * lv[384 + lane] + lv[256 + 64 + lane] * lv[384 + 64 + lane];
        d0 = wave_sum(d0); d1 = wave_sum(d1);
        const float lam_init = 0.8f - 0.6f * expf(-0.3f);
        if (lane == 0) { float* lp = (float*)(ws + WS_LAM); lp[0] = expf(d0) - expf(d1) + lam_init; lp[1] = 1.0f - lam_init; }
    }
}

struct NM { const float* gain; const float* sh; const float* sc; int bstride; bf16_t* dst; };
constexpr int RW = 4;
template <bool TWO>
__device__ __forceinline__ void normmod_phase(const float* src, const NM A, const NM Bq, int gw, int NGW, int lane) {
    for (int row = gw; row < TOK; row += RW * NGW) {
        f32x4 v[RW][4]; float rinv[RW];
#pragma unroll
        for (int r = 0; r < RW; ++r) { const int rw = row + r * NGW < TOK ? row + r * NGW : row; const f32x4* xr = (const f32x4*)(src + (size_t)rw * DM) + lane;
#pragma unroll
            for (int j = 0; j < 4; ++j) v[r][j] = xr[64 * j]; }
#pragma unroll
        for (int r = 0; r < RW; ++r) { float ss = 0.f;
#pragma unroll
            for (int j = 0; j < 4; ++j) ss += (v[r][j][0] * v[r][j][0] + v[r][j][1] * v[r][j][1]) + (v[r][j][2] * v[r][j][2] + v[r][j][3] * v[r][j][3]);
            rinv[r] = 1.0f / sqrtf(wave_sum(ss) * (1.0f / DM) + EPS); }
#pragma unroll
        for (int r = 0; r < RW; ++r) {
            const int rw = row + r * NGW; if (rw >= TOK) break;
            const int b = rw >> 11;
#pragma unroll
            for (int j = 0; j < 4; ++j) {
                const int k0 = 256 * j + 4 * lane;
                { const f32x4 g = *(const f32x4*)(A.gain + k0), sc = *(const f32x4*)(A.sc + (size_t)b * A.bstride + k0), sh = *(const f32x4*)(A.sh + (size_t)b * A.bstride + k0);
                  const f32x4 o = v[r][j] * rinv[r] * g * (sc + 1.0f) + sh; u32x2 w; w.x = cvt_pk_bf16(o[0], o[1]); w.y = cvt_pk_bf16(o[2], o[3]); *(u32x2*)(A.dst + (size_t)rw * DM + k0) = w; }
                if (TWO) { const f32x4 g = *(const f32x4*)(Bq.gain + k0), sc = *(const f32x4*)(Bq.sc + (size_t)b * Bq.bstride + k0), sh = *(const f32x4*)(Bq.sh + (size_t)b * Bq.bstride + k0);
                  const f32x4 o = v[r][j] * rinv[r] * g * (sc + 1.0f) + sh; u32x2 w; w.x = cvt_pk_bf16(o[0], o[1]); w.y = cvt_pk_bf16(o[2], o[3]); *(u32x2*)(Bq.dst + (size_t)rw * DM + k0) = w; }
            }
        }
    }
}
__device__ __forceinline__ void gate_phase(const bf16_t* O, const bf16_t* Gt, bf16_t* Y, int gw, int NGW, int lane) {
    for (int idx0 = gw; idx0 < TOK * 4; idx0 += RW * NGW) {
        u32x4 ov[RW], gv[RW];
#pragma unroll
        for (int r = 0; r < RW; ++r) { const int ix = idx0 + r * NGW < TOK * 4 ? idx0 + r * NGW : idx0; const size_t off = (size_t)ix * 512 + 8 * lane; ov[r] = *(const u32x4*)(O + off); gv[r] = *(const u32x4*)(Gt + off); }
#pragma unroll
        for (int r = 0; r < RW; ++r) {
            const int ix = idx0 + r * NGW; if (ix >= TOK * 4) break;
            float o[8], g[8];
            o[0] = bf_lo(ov[r].x); o[1] = bf_hi(ov[r].x); o[2] = bf_lo(ov[r].y); o[3] = bf_hi(ov[r].y); o[4] = bf_lo(ov[r].z); o[5] = bf_hi(ov[r].z); o[6] = bf_lo(ov[r].w); o[7] = bf_hi(ov[r].w);
            g[0] = bf_lo(gv[r].x); g[1] = bf_hi(gv[r].x); g[2] = bf_lo(gv[r].y); g[3] = bf_hi(gv[r].y); g[4] = bf_lo(gv[r].z); g[5] = bf_hi(gv[r].z); g[6] = bf_lo(gv[r].w); g[7] = bf_hi(gv[r].w);
            float ss = 0.f;
#pragma unroll
            for (int i = 0; i < 8; ++i) ss += o[i] * o[i];
            const float rinv = 1.0f / sqrtf(wave_sum(ss) * (1.0f / 512.0f) + EPS);
            float y[8];
#pragma unroll
            for (int i = 0; i < 8; ++i) y[i] = silu_f(g[i]) * o[i] * rinv;
            u32x4 w; w.x = cvt_pk_bf16(y[0], y[1]); w.y = cvt_pk_bf16(y[2], y[3]); w.z = cvt_pk_bf16(y[4], y[5]); w.w = cvt_pk_bf16(y[6], y[7]);
            *(u32x4*)(Y + (size_t)ix * 512 + 8 * lane) = w;
        }
    }
}
__device__ __forceinline__ void combine_phase(const bf16_t* O0, const bf16_t* O1, bf16_t* Od, const float* gain, const float* lamp, int gw, int NGW, int lane) {
    const float lam = lamp[0], oml = lamp[1];
    const f32x4 gn = *(const f32x4*)(gain + 4 * lane);
    for (int idx0 = gw; idx0 < TOK * 4; idx0 += RW * NGW) {
        u32x2 av[RW], bv[RW];
#pragma unroll
        for (int r = 0; r < RW; ++r) { const int ix = idx0 + r * NGW < TOK * 4 ? idx0 + r * NGW : idx0; const size_t off = (size_t)ix * 256 + 4 * lane; av[r] = *(const u32x2*)(O0 + off); bv[r] = *(const u32x2*)(O1 + off); }
#pragma unroll
        for (int r = 0; r < RW; ++r) {
            const int ix = idx0 + r * NGW; if (ix >= TOK * 4) break;
            const u32x2 a = av[r], b = bv[r];
            f32x4 o = {bf_lo(a.x) - lam * bf_lo(b.x), bf_hi(a.x) - lam * bf_hi(b.x), bf_lo(a.y) - lam * bf_lo(b.y), bf_hi(a.y) - lam * bf_hi(b.y)};
            const float ss = (o[0] * o[0] + o[1] * o[1]) + (o[2] * o[2] + o[3] * o[3]);
            const float rinv = 1.0f / sqrtf(wave_sum(ss) * (1.0f / 256.0f) + EPS);
            o = o * (rinv * oml) * gn;
            u32x2 w; w.x = cvt_pk_bf16(o[0], o[1]); w.y = cvt_pk_bf16(o[2], o[3]); *(u32x2*)(Od + (size_t)ix * 256 + 4 * lane) = w;
        }
    }
}
__device__ __forceinline__ void final_norm_phase(float* X, const float* gain, int gw, int NGW, int lane) {
    for (int row = gw; row < TOK; row += RW * NGW) {
        f32x4 v[RW][4]; float rinv[RW];
#pragma unroll
        for (int r = 0; r < RW; ++r) { const int rw = row + r * NGW < TOK ? row + r * NGW : row; const f32x4* xr = (const f32x4*)(X + (size_t)rw * DM) + lane;
#pragma unroll
            for (int j = 0; j < 4; ++j) v[r][j] = xr[64 * j]; }
#pragma unroll
        for (int r = 0; r < RW; ++r) { float ss = 0.f;
#pragma unroll
            for (int j = 0; j < 4; ++j) ss += (v[r][j][0] * v[r][j][0] + v[r][j][1] * v[r][j][1]) + (v[r][j][2] * v[r][j][2] + v[r][j][3] * v[r][j][3]);
            rinv[r] = 1.0f / sqrtf(wave_sum(ss) * (1.0f / DM) + EPS); }
#pragma unroll
        for (int r = 0; r < RW; ++r) {
            const int rw = row + r * NGW; if (rw >= TOK) break;
            f32x4* xw = (f32x4*)(X + (size_t)rw * DM) + lane;
#pragma unroll
            for (int j = 0; j < 4; ++j) __builtin_nontemporal_store(v[r][j] * rinv[r] * *(const f32x4*)(gain + 256 * j + 4 * lane), xw + 64 * j);
        }
    }
}

__device__ __forceinline__ void retention_phase(LAS unsigned char* lds, const bf16_t* Q, const bf16_t* K, bf16_t* V, const bf16_t* Gt, float* ssqb, int G) {
    const int tid = threadIdx.x, lane = tid & 63, w = __builtin_amdgcn_readfirstlane(tid >> 6), li = lane & 15, fq = lane >> 4, q4 = li >> 2, p4 = li & 3;
    constexpr int KS = 528, VS = 144, SS = 528;
    LAS unsigned char* Ks = lds; LAS unsigned char* Vs = lds + 128 * KS; LAS unsigned char* StT = Vs + 128 * VS;
    const int bx = blockIdx.x; const int vcu = (G % 8 == 0) ? (bx % 8) * (G / 8) + bx / 8 : bx;
    for (int item = vcu; item < 256; item += G) {
        const int bh = item >> 3, sl = item & 7, b = bh >> 2, h = bh & 3;
        const float gam = 1.0f - exp2f(-5.0f - (float)h);
        float g128 = gam;
#pragma unroll
        for (int i = 0; i < 7; ++i) g128 *= g128;
        const float g127 = g128 / gam;
        const bf16_t* Qb = Q + (size_t)b * SEQ * 1024 + h * 256;
        const bf16_t* Kb = K + (size_t)b * SEQ * 1024 + h * 256;
        const bf16_t* Vb = V + (size_t)b * SEQ * 2048 + h * 512 + sl * 64;
        bf16_t* Ob = V + (size_t)b * SEQ * 2048 + h * 512 + sl * 64;
        const bf16_t* Gb = Gt + (size_t)b * SEQ * 2048 + h * 512 + sl * 64;
        __syncthreads();
        for (int i = tid; i < 64 * SS / 16; i += 512) *(LAS u32x4*)(StT + i * 16) = (u32x4){0u, 0u, 0u, 0u};
        f32x4 St[2][4];
#pragma unroll
        for (int mt = 0; mt < 2; ++mt)
#pragma unroll
            for (int nt = 0; nt < 4; ++nt) St[mt][nt] = (f32x4){0.f, 0.f, 0.f, 0.f};
        u32x4 kreg[8], vreg[2]; bf16x8 Qf[8];
        const unsigned voK = (unsigned)((tid >> 5) * 1024 + (tid & 31) * 8) * 2u, voV = (unsigned)((tid >> 3) * 2048 + (tid & 7) * 8) * 2u, voQ = (unsigned)(li * 1024 + 8 * fq) * 2u;
#define RET_LOAD_KV(t0_) do { \
        _Pragma("unroll") for (int i = 0; i < 8; ++i) kreg[i] = *(const u32x4*)((const char*)Kb + (size_t)((t0_) + 16 * i) * 2048 + voK); \
        _Pragma("unroll") for (int i = 0; i < 2; ++i) vreg[i] = *(const u32x4*)((const char*)Vb + (size_t)((t0_) + 64 * i) * 4096 + voV); } while (0)
#define RET_LOAD_Q(t0_) do { _Pragma("unroll") for (int ks = 0; ks < 8; ++ks) Qf[ks] = *(const bf16x8*)((const char*)Qb + (size_t)((t0_) + 16 * w) * 2048 + ks * 64 + voQ); } while (0)
#define RET_WRITE_KV() do { \
        _Pragma("unroll") for (int i = 0; i < 8; ++i) { const int id = tid + 512 * i, r = id >> 5, pc = id & 31; *(LAS u32x4*)(Ks + r * KS + pc * 16) = kreg[i]; } \
        _Pragma("unroll") for (int i = 0; i < 2; ++i) { const int id = tid + 512 * i, r = id >> 3, pc = id & 7; *(LAS u32x4*)(Vs + r * VS + pc * 16) = vreg[i]; } } while (0)
        RET_LOAD_KV(0); RET_LOAD_Q(0);
        RET_WRITE_KV();
        __syncthreads();
#pragma nounroll
        for (int n = 0; n < 16; ++n) {
            const int t0 = n * 128;
            if (n + 1 < 16) RET_LOAD_KV(t0 + 128);
            u32x2 greg[4];
#pragma unroll
            for (int nt = 0; nt < 4; ++nt) greg[nt] = *(const u32x2*)(Gb + (size_t)(t0 + 16 * w + li) * 2048 + 16 * nt + 4 * fq);
            f32x4 accS[8];
#pragma unroll
            for (int kt = 0; kt < 8; ++kt) {
                accS[kt] = (f32x4){0.f, 0.f, 0.f, 0.f};
                if (kt <= w) {
#pragma unroll
                    for (int ks = 0; ks < 8; ++ks) accS[kt] = MFMA16(lds_b128(Ks + (16 * kt + li) * KS + (32 * ks + 8 * fq) * 2), Qf[ks], accS[kt]);
                    __builtin_amdgcn_sched_barrier(0);
                    if (kt == w) {
#pragma unroll
                        for (int r = 0; r < 4; ++r) if (4 * fq + r > li) accS[kt][r] = 0.f;
                    }
                }
            }
            bf16x8 P[4];
#pragma unroll
            for (int s = 0; s < 4; ++s) P[s] = pack_frag(accS[2 * s], accS[2 * s + 1]);
            f32x4 o1[4], o2[4];
#pragma unroll
            for (int nt = 0; nt < 4; ++nt) { o1[nt] = (f32x4){0.f, 0.f, 0.f, 0.f}; o2[nt] = (f32x4){0.f, 0.f, 0.f, 0.f}; }
#pragma unroll
            for (int s = 0; s < 4; ++s) {
                if (2 * s <= w) {
#pragma unroll
                    for (int nt = 0; nt < 4; ++nt) {
                        const bf16x8 av = cat4(lds_tr(Vs + (32 * s + 4 * fq + q4) * VS + (16 * nt + 4 * p4) * 2), lds_tr(Vs + (32 * s + 16 + 4 * fq + q4) * VS + (16 * nt + 4 * p4) * 2));
                        o1[nt] = MFMA16(av, P[s], o1[nt]);
                    }
                }
            }
#pragma unroll
            for (int ks = 0; ks < 8; ++ks)
#pragma unroll
                for (int nt = 0; nt < 4; ++nt) { o2[nt] = MFMA16(lds_b128(StT + (16 * nt + li) * SS + (32 * ks + 8 * fq) * 2), Qf[ks], o2[nt]); if (nt == 3 && (ks & 1)) __builtin_amdgcn_sched_barrier(0); }
            {
                bf16_t* op = Ob + (size_t)(t0 + 16 * w + li) * 2048 + 4 * fq;
                float sq = 0.f;
#pragma unroll
                for (int nt = 0; nt < 4; ++nt) { const f32x4 o = o1[nt] + o2[nt] * gam;
                    sq += (o[0] * o[0] + o[1] * o[1]) + (o[2] * o[2] + o[3] * o[3]);
                    const float y0 = silu_f(bf_lo(greg[nt].x)) * o[0], y1 = silu_f(bf_hi(greg[nt].x)) * o[1], y2 = silu_f(bf_lo(greg[nt].y)) * o[2], y3 = silu_f(bf_hi(greg[nt].y)) * o[3];
                    u32x2 wv; wv.x = cvt_pk_bf16(y0, y1); wv.y = cvt_pk_bf16(y2, y3); *(u32x2*)(op + 16 * nt) = wv; }
                sq += __shfl_xor(sq, 16); sq += __shfl_xor(sq, 32);
                if (fq == 0) ssqb[((size_t)(b * SEQ + t0 + 16 * w + li) * 4 + h) * 8 + sl] = sq;
            }
            if (n + 1 < 16) RET_LOAD_Q(t0 + 128);
            f32x4 tmp[2][4];
#pragma unroll
            for (int mt = 0; mt < 2; ++mt)
#pragma unroll
                for (int nt = 0; nt < 4; ++nt) tmp[mt][nt] = (f32x4){0.f, 0.f, 0.f, 0.f};
#pragma unroll
            for (int s = 0; s < 4; ++s) {
                bf16x8 bv[4];
#pragma unroll
                for (int nt = 0; nt < 4; ++nt) bv[nt] = cat4(lds_tr(Vs + (32 * s + 8 * fq + q4) * VS + (16 * nt + 4 * p4) * 2), lds_tr(Vs + (32 * s + 8 * fq + 4 + q4) * VS + (16 * nt + 4 * p4) * 2));
#pragma unroll
                for (int mt = 0; mt < 2; ++mt) {
                    const bf16x8 ak = cat4(lds_tr(Ks + (32 * s + 8 * fq + q4) * KS + (32 * w + 16 * mt + 4 * p4) * 2), lds_tr(Ks + (32 * s + 8 * fq + 4 + q4) * KS + (32 * w + 16 * mt + 4 * p4) * 2));
#pragma unroll
                    for (int nt = 0; nt < 4; ++nt) tmp[mt][nt] = MFMA16(ak, bv[nt], tmp[mt][nt]);
                }
            }
#pragma unroll
            for (int mt = 0; mt < 2; ++mt)
#pragma unroll
                for (int nt = 0; nt < 4; ++nt) St[mt][nt] = St[mt][nt] * g128 + tmp[mt][nt] * g127;
            if (n + 1 < 16) {
                __syncthreads();
#pragma unroll
                for (int mt = 0; mt < 2; ++mt)
#pragma unroll
                    for (int nt = 0; nt < 4; ++nt) {
                        u32x2 wv; wv.x = cvt_pk_bf16(St[mt][nt][0], St[mt][nt][1]); wv.y = cvt_pk_bf16(St[mt][nt][2], St[mt][nt][3]);
                        *(LAS u32x2*)(StT + (16 * nt + li) * SS + (32 * w + 16 * mt + 4 * fq) * 2) = wv;
                    }
                RET_WRITE_KV();
                __syncthreads();
            }
        }
    }
#undef RET_WRITE_KV
#undef RET_LOAD_KV
#undef RET_LOAD_Q
    __syncthreads();
}

__device__ __forceinline__ void attn_phase(LAS unsigned char* lds, const bf16_t* Qd, const bf16_t* Kd, const bf16_t* Vd, bf16_t* O0, bf16_t* O1, int G) {
    const int tid = threadIdx.x, lane = tid & 63, w = __builtin_amdgcn_readfirstlane(tid >> 6), li = lane & 15, fq = lane >> 4, q4 = li >> 2, p4 = li & 3;
    constexpr int KS = 272, VS = 544, SLOT = 32768;
    const float NEG = -__builtin_inff();
    const unsigned ldsb = (unsigned)(size_t)lds;
    int soff[4]; bool isv[4];
#pragma unroll
    for (int i = 0; i < 4; ++i) {
        const int q = (w * 4 + i) * 64 + lane;
        if (q < 544) { const int row = q / 17, pc = q % 17; soff[i] = row * 1024 + (pc < 16 ? pc : 15) * 8; isv[i] = false; }
        else if (q < 1632) { const int q2 = q - 544, row = q2 / 34, pc = q2 % 34; soff[i] = row * 1024 + (pc < 32 ? pc : 31) * 8; isv[i] = true; }
        else { soff[i] = 0; isv[i] = false; }
    }
    for (int idx = blockIdx.x; idx < 512; idx += G) {
        const int r = idx >> 8, c = idx & 255, xc = c & 7, l = c >> 3, qbi = l & 7;
        const int bh = 4 * xc + 2 * r + (l >> 4), p = (l >> 3) & 1, b = bh >> 2, h = bh & 3;
        const int qb = r ? 7 - qbi : qbi;
        const int q0 = qb * 256, nkt = 8 * (qb + 1);
        const int r0 = q0 + 16 * w, r1 = q0 + 16 * (15 - w);
        const bf16_t* Kp = Kd + (size_t)b * SEQ * 1024 + h * 256 + p * 128;
        const bf16_t* Vp = Vd + (size_t)b * SEQ * 1024 + h * 256;
        const bf16_t* src[4];
#pragma unroll
        for (int i = 0; i < 4; ++i) src[i] = (isv[i] ? Vp : Kp) + soff[i];
        bf16x8 Qf[2][4];
#pragma unroll
        for (int u = 0; u < 2; ++u)
#pragma unroll
            for (int ks = 0; ks < 4; ++ks) Qf[u][ks] = *(const bf16x8*)(Qd + (size_t)(b * SEQ + (u ? r1 : r0) + li) * 1024 + h * 256 + p * 128 + 32 * ks + 8 * fq);
#define ATT_DMA(tile_, slot_) do { const size_t ko_ = (size_t)(tile_) * (32 * 1024); const unsigned lb_ = ldsb + (unsigned)(slot_) * SLOT + (unsigned)(w * 4) * 1024u; _Pragma("unroll") for (int i = 0; i < 4; ++i) \
        glds16_asm(src[i] + ko_, __builtin_amdgcn_readfirstlane(lb_ + i * 1024)); } while (0)
#pragma unroll
        for (int u = 0; u < 2; ++u)
#pragma unroll
            for (int ks = 0; ks < 4; ++ks) asm volatile("" : "+v"(Qf[u][ks]));
        asm volatile("s_waitcnt lgkmcnt(0)\n\ts_barrier" ::: "memory");
        ATT_DMA(0, 0); ATT_DMA(1, 1); ATT_DMA(2, 2);
        float mrun[2] = {NEG, NEG}, lrun[2] = {0.f, 0.f};
        f32x4 O[2][16];
#pragma unroll
        for (int u = 0; u < 2; ++u)
#pragma unroll
            for (int nt = 0; nt < 16; ++nt) O[u][nt] = (f32x4){0.f, 0.f, 0.f, 0.f};
#define ATT_BODY(A0) do { \
                const LAS unsigned char* Kt = lds + (kt & 3) * SLOT; const LAS unsigned char* Vt = Kt + 32 * KS; \
                f32x4 sv[2][2]; \
                _Pragma("unroll") for (int u = 0; u < 2; ++u) _Pragma("unroll") for (int kk = 0; kk < 2; ++kk) sv[u][kk] = (f32x4){0.f, 0.f, 0.f, 0.f}; \
                __builtin_amdgcn_s_setprio(1); \
                _Pragma("unroll") for (int kk = 0; kk < 2; ++kk) _Pragma("unroll") for (int ks = 0; ks < 4; ++ks) { \
                    const bf16x8 a = lds_b128(Kt + (16 * kk + li) * KS + (32 * ks + 8 * fq) * 2); \
                    if (A0) sv[0][kk] = MFMA16(a, Qf[0][ks], sv[0][kk]); sv[1][kk] = MFMA16(a, Qf[1][ks], sv[1][kk]); } \
                __builtin_amdgcn_s_setprio(0); \
                _Pragma("unroll") for (int u = (A0) ? 0 : 1; u < 2; ++u) { const int rb = u ? r1 : r0; \
                    if (k0 + 31 > rb) { _Pragma("unroll") for (int kk = 0; kk < 2; ++kk) _Pragma("unroll") for (int rg = 0; rg < 4; ++rg) if (k0 + 16 * kk + 4 * fq + rg > rb + li) sv[u][kk][rg] = NEG; } } \
                float alpha[2] = {1.0f, 1.0f}; \
                _Pragma("unroll") for (int u = (A0) ? 0 : 1; u < 2; ++u) { \
                    float mx = fmaxf(fmaxf(fmaxf(sv[u][0][0], sv[u][0][1]), fmaxf(sv[u][0][2], sv[u][0][3])), fmaxf(fmaxf(sv[u][1][0], sv[u][1][1]), fmaxf(sv[u][1][2], sv[u][1][3]))); \
                    mx = fmaxf(mx, __shfl_xor(mx, 16)); mx = fmaxf(mx, __shfl_xor(mx, 32)); \
                    const float mn = fmaxf(mrun[u], mx); alpha[u] = __builtin_amdgcn_exp2f(mrun[u] - mn); mrun[u] = mn; \
                    float ls = 0.f; \
                    _Pragma("unroll") for (int kk = 0; kk < 2; ++kk) _Pragma("unroll") for (int rg = 0; rg < 4; ++rg) { sv[u][kk][rg] = __builtin_amdgcn_exp2f(sv[u][kk][rg] - mn); ls += sv[u][kk][rg]; } \
                    lrun[u] = lrun[u] * alpha[u] + ls; } \
                if (__any((alpha[0] != 1.0f) || (alpha[1] != 1.0f))) { \
                    _Pragma("unroll") for (int u = (A0) ? 0 : 1; u < 2; ++u) _Pragma("unroll") for (int nt = 0; nt < 16; ++nt) O[u][nt] = O[u][nt] * alpha[u]; } \
                const bf16x8 P0 = pack_frag(sv[0][0], sv[0][1]), P1 = pack_frag(sv[1][0], sv[1][1]); \
                __builtin_amdgcn_sched_barrier(0); \
                __builtin_amdgcn_s_setprio(1); \
                _Pragma("unroll") for (int nt = 0; nt < 16; ++nt) { \
                    const bf16x8 av = cat4(lds_tr(Vt + (4 * fq + q4) * VS + (16 * nt + 4 * p4) * 2), lds_tr(Vt + (16 + 4 * fq + q4) * VS + (16 * nt + 4 * p4) * 2)); \
                    if (A0) O[0][nt] = MFMA16(av, P0, O[0][nt]); O[1][nt] = MFMA16(av, P1, O[1][nt]); \
                    if ((nt & 3) == 3) __builtin_amdgcn_sched_barrier(0); } \
                __builtin_amdgcn_s_setprio(0); } while (0)
#define ATT_STEP() do { asm volatile("s_waitcnt vmcnt(8) lgkmcnt(0)\n\ts_barrier" ::: "memory"); \
                const int tn_ = kt + 3 < nkt ? kt + 3 : nkt - 1; ATT_DMA(tn_, (kt + 3) & 3); } while (0)
        const int ktA = (r0 + 15) / 32 + 1;
        int kt = 0;
#pragma nounroll
        for (; kt < ktA; ++kt) { const int k0 = 32 * kt; ATT_STEP(); ATT_BODY(1); }
#pragma nounroll
        for (; kt < nkt; ++kt) { const int k0 = 32 * kt; ATT_STEP(); if (k0 <= r1 + 15) ATT_BODY(0); }
#undef ATT_BODY
#undef ATT_STEP
#undef ATT_DMA
#pragma unroll
        for (int u = 0; u < 2; ++u) {
            float l = lrun[u]; l += __shfl_xor(l, 16); l += __shfl_xor(l, 32);
            const float inv = 1.0f / l;
            bf16_t* op = (p ? O1 : O0) + (size_t)(b * SEQ + (u ? r1 : r0) + li) * 1024 + h * 256 + 4 * fq;
#pragma unroll
            for (int nt = 0; nt < 16; ++nt) { const f32x4 o = O[u][nt] * inv; u32x2 wv; wv.x = cvt_pk_bf16(o[0], o[1]); wv.y = cvt_pk_bf16(o[2], o[3]); *(u32x2*)(op + 16 * nt) = wv; }
        }
    }
    asm volatile("s_waitcnt vmcnt(0) lgkmcnt(0)\n\ts_barrier" ::: "memory");
}

#define XB_TMO      128
#define XB_XCNT(j)  (256  + 64 * (j))
#define XB_XSUB(j)  (1280 + 64 * (j))
#define XB_XGEN(j)  (2304 + 64 * (j))
#define XB_TOP      3328
#define XB_TOPGEN   3392
#define XCD_BAR_WORDS 3456
#define XB_SPIN_CAP (1u << 18)
__device__ __forceinline__ unsigned xb_ld(unsigned* p)              { return __hip_atomic_load(p, __ATOMIC_RELAXED, __HIP_MEMORY_SCOPE_AGENT); }
__device__ __forceinline__ unsigned xb_add(unsigned* p, unsigned v) { return __hip_atomic_fetch_add(p, v, __ATOMIC_RELAXED, __HIP_MEMORY_SCOPE_AGENT); }
__device__ __forceinline__ unsigned xb_xcc_id() { return (unsigned)__builtin_amdgcn_s_getreg((3 << 11) | 20) & 0xFu; }
#define XB_SPIN(cond, bar) do { unsigned _sp = 0; while (cond) { __builtin_amdgcn_s_sleep(1); \
    if ((++_sp & 255u) == 0u) { if (xb_ld(&(bar)[XB_TMO])) break; if (_sp > XB_SPIN_CAP) { atomicAdd(&(bar)[XB_TMO], 1u); break; } } } } while (0)
struct XcdBarrier { unsigned* bar; unsigned x; volatile LAS unsigned* st; };
__device__ __forceinline__ XcdBarrier xcd_barrier_post(unsigned* bar, volatile LAS unsigned* st) {
    XcdBarrier b; b.bar = bar; b.x = xb_xcc_id(); b.st = st;
    if (threadIdx.x == 0) (void)xb_add(&bar[XB_XCNT(b.x)], 1u);
    return b;
}
__device__ __forceinline__ void xcd_barrier_complete(unsigned* bar, unsigned x, unsigned& nloc, unsigned& nx) {
    const unsigned G = gridDim.x * gridDim.y * gridDim.z;
    unsigned sum, cnt, mine, sp = 0u;
    for (;;) {
        sum = 0u; cnt = 0u; mine = 0u;
#pragma unroll
        for (unsigned j = 0; j < 16; ++j) { const unsigned c = xb_ld(&bar[XB_XCNT(j)]); sum += c; cnt += (c > 0u) ? 1u : 0u; mine = (j == x) ? c : mine; }
        if (sum == G) break;
        __builtin_amdgcn_s_sleep(1);
        if ((++sp & 255u) == 0u) { if (xb_ld(&bar[XB_TMO])) break; if (sp > XB_SPIN_CAP) { atomicAdd(&bar[XB_TMO], 1u); break; } }
    }
    nloc = mine > 0u ? mine : 1u; nx = cnt > 0u ? cnt : 1u;
}
__device__ __forceinline__ void xcd_barrier(const XcdBarrier& b) {
    asm volatile("s_waitcnt vmcnt(0)" ::: "memory");
    __syncthreads();
    if (threadIdx.x == 0) {
        unsigned* bar = b.bar;
        __builtin_amdgcn_s_waitcnt(0);
        unsigned nloc = b.st[0], nx = b.st[1];
        if (nloc == 0u) { xcd_barrier_complete(bar, b.x, nloc, nx); b.st[0] = nloc; b.st[1] = nx; }
        const unsigned old = xb_add(&bar[XB_XSUB(b.x)], 1u);
        const unsigned gen = old / nloc;
        if (old + 1u == (gen + 1u) * nloc) {
            __builtin_amdgcn_fence(__ATOMIC_RELEASE, "agent");
            asm volatile("s_waitcnt vmcnt(0)" ::: "memory");
            const unsigned og = xb_add(&bar[XB_TOP], 1u);
            const unsigned tg = og / nx;
            if (og + 1u == (tg + 1u) * nx) xb_add(&bar[XB_TOPGEN], 1u);
            else XB_SPIN(xb_ld(&bar[XB_TOPGEN]) == tg, bar);
            __builtin_amdgcn_fence(__ATOMIC_ACQUIRE, "agent");
            xb_add(&bar[XB_XGEN(b.x)], 1u);
            asm volatile("s_waitcnt vmcnt(0)" ::: "memory");
        } else {
            XB_SPIN(xb_ld(&bar[XB_XGEN(b.x)]) == gen, bar);
            __builtin_amdgcn_fence(__ATOMIC_ACQUIRE, "agent");
            asm volatile("s_waitcnt vmcnt(0)" ::: "memory");
        }
    }
    __syncthreads();
}

__global__ void __launch_bounds__(512, 2) yoco_fwd(Args args) {
    extern __shared__ __attribute__((aligned(16))) unsigned char lds_raw[];
    LAS unsigned char* lds = (LAS unsigned char*)lds_raw;
    LAS unsigned char* ldsx = lds + LDS_XOFF;
    cg::grid_group grid = cg::this_grid();
    const int tid = threadIdx.x, lane = tid & 63, wave = __builtin_amdgcn_readfirstlane(tid >> 6);
    const int G = gridDim.x, gw = blockIdx.x * 8 + wave, NGW = G * 8;
    unsigned char* ws = args.ws;
    const int lo = args.ph_lo, hi = args.ph_hi;
    volatile LAS unsigned* xst = (volatile LAS unsigned*)(lds + LDS_XOFF + 8192);
    if (tid < 2) xst[tid] = 0u;
    if (blockIdx.x == 0 && tid < 64) __hip_atomic_store((unsigned*)(ws + WS_XCNT) + 16 * tid, 0u, __ATOMIC_RELAXED, __HIP_MEMORY_SCOPE_AGENT);
    if (blockIdx.x == 0) { for (int i = tid; i < XCD_BAR_WORDS; i += 512) __hip_atomic_store((unsigned*)(ws + WS_BAR) + i, 0u, __ATOMIC_RELAXED, __HIP_MEMORY_SCOPE_AGENT); }
    asm volatile("s_waitcnt vmcnt(0)" ::: "memory");
    __syncthreads();
#define IN(k) (lo <= (k) && (k) < hi)
#define SEAM(k) do { if (IN(k) && hi > (k) + 1 && (k) != 16) xcd_barrier(xbar); } while (0)
    grid.sync();
    asm volatile("" ::: "memory");
    const XcdBarrier xbar = xcd_barrier_post((unsigned*)(ws + WS_BAR), xst);
    float* X = args.out;
    const float* mod0 = (const float*)(ws + WS_MOD0); const float* mod1 = (const float*)(ws + WS_MOD1); const float* kvmod = (const float*)(ws + WS_KVMOD);
    bf16_t* H = (bf16_t*)(ws + WS_H);
    bf16_t* U = (bf16_t*)(ws + WS_U);
    const float* tabR = (const float*)(ws + WS_TABR); const float* tabD = (const float*)(ws + WS_TABD);
    pg8::StaticOrder S;

#define PH(k, ...) do { if (IN(k)) { __VA_ARGS__ if (MK_DUP == (k)) { __VA_ARGS__ } } SEAM(k); if (MK_DUPSYNC) SEAM(k); } while (0)
    PH(0, { p0_prologue<0>(args, lds, wave, lane, G); });
    PH(1, { p0_prologue<1>(args, lds, wave, lane, G); NM a{args.in[2], mod0, mod0 + 1024, 6144, (bf16_t*)args.out}; normmod_phase<false>(args.in[0], a, a, gw, NGW, lane); });
    PH(2, {
        pg8::Gemm g{(const bf16_t*)args.out, (const bf16_t*)(ws + WS_WRIN), TOK, 6144, 1024, 256}; S.init(TOK, 6144, G, (int)blockIdx.x);
        EpiRetIn E{(bf16_t*)(ws + WS_Q), (bf16_t*)(ws + WS_K), (bf16_t*)(ws + WS_V), (bf16_t*)(ws + WS_G), tabR};
        pg8::gemm_phase<EpiRetIn>(lds, ldsx, g, S, E); });
    PH(3, { retention_phase(lds, (const bf16_t*)(ws + WS_Q), (const bf16_t*)(ws + WS_K), (bf16_t*)(ws + WS_V), (const bf16_t*)(ws + WS_G), (float*)(ws + WS_SSQ), G); });
    PH(5, {
        pg8::Gemm g{(const bf16_t*)(ws + WS_V), (const bf16_t*)(ws + WS_WROUT), TOK, 1024, 2048, 256}; S.init(TOK, 1024, G, (int)blockIdx.x);
        EpiResNorm<true, 1> E{args.in[0], X, mod0 + 2048, (const float*)(ws + WS_SSQ), {{H, args.in[2] + 1024, mod0 + 3072, mod0 + 4096, 6144}, {H, args.in[2] + 1024, mod0 + 3072, mod0 + 4096, 6144}}, (float*)(ws + WS_XSLOT), (unsigned*)(ws + WS_XCNT), 32u};
        pg8::gemm_phase<EpiResNorm<true, 1>>(lds, ldsx, g, S, E); });
    PH(7, {
        pg8::Gemm g{H - 2 * 1024, (const bf16_t*)(ws + WS_WFIN0), 65 * 256, NFF, 1024, 254}; S.init(65 * 256, NFF, G, (int)blockIdx.x);
        EpiFfn E{U, args.in[8], args.in[9]};
        pg8::gemm_phase<EpiFfn>(lds, ldsx, g, S, E); });
    PH(8, {
        pg8::Gemm g{U, (const bf16_t*)(ws + WS_WFDN0), TOK, 1024, DFF, 256}; S.init(TOK, 1024, G, (int)blockIdx.x);
        EpiResNorm<false, 2> E{X, X, mod0 + 5120, nullptr, {{H, args.in[11], kvmod, kvmod + 1024, 2048}, {(bf16_t*)(ws + WS_H3), args.in[2] + 2048, mod1, mod1 + 1024, 6144}}, (float*)(ws + WS_XSLOT), (unsigned*)(ws + WS_XCNT), 64u};
        pg8::gemm_phase<EpiResNorm<false, 2>>(lds, ldsx, g, S, E); });
    PH(10, {
        pg8::Gemm g{H, (const bf16_t*)(ws + WS_WKV), TOK, 3072, 1024, 256, (const bf16_t*)(ws + WS_H3), 8}; S.init(TOK, 3072, G, (int)blockIdx.x);
        EpiRope E{(bf16_t*)(ws + WS_KSH), (bf16_t*)(ws + WS_VSH), 4, tabD, 1.0f, (bf16_t*)(ws + WS_QD), 8, 0.08838834764831845f * 1.4426950408889634f};
        pg8::gemm_phase<EpiRope>(lds, ldsx, g, S, E); });
    PH(11, { attn_phase(lds, (const bf16_t*)(ws + WS_QD), (const bf16_t*)(ws + WS_KSH), (const bf16_t*)(ws + WS_VSH), (bf16_t*)(ws + WS_O0), (bf16_t*)(ws + WS_O1), G); });
    PH(12, { combine_phase((const bf16_t*)(ws + WS_O0), (const bf16_t*)(ws + WS_O1), (bf16_t*)(ws + WS_OD), args.in[17], (const float*)(ws + WS_LAM), gw, NGW, lane); });
    PH(13, {
        pg8::Gemm g{(const bf16_t*)(ws + WS_OD), (const bf16_t*)(ws + WS_WO), TOK, 1024, 1024, 256}; S.init(TOK, 1024, G, (int)blockIdx.x);
        EpiResNorm<false, 1> E{X, X, mod1 + 2048, nullptr, {{H, args.in[2] + 3072, mod1 + 3072, mod1 + 4096, 6144}, {H, args.in[2] + 3072, mod1 + 3072, mod1 + 4096, 6144}}, (float*)(ws + WS_XSLOT), (unsigned*)(ws + WS_XCNT), 96u};
        pg8::gemm_phase<EpiResNorm<false, 1>>(lds, ldsx, g, S, E); });
    PH(15, {
        pg8::Gemm g{H - 2 * 1024, (const bf16_t*)(ws + WS_WFIN1), 65 * 256, NFF, 1024, 254}; S.init(65 * 256, NFF, G, (int)blockIdx.x);
        EpiFfn E{U, args.in[8] + 3 * DFF, args.in[9] + DFF};
        pg8::gemm_phase<EpiFfn>(lds, ldsx, g, S, E); });
    PH(16, {
        pg8::Gemm g{U, (const bf16_t*)(ws + WS_WFDN1), TOK, 1024, DFF, 256}; S.init(TOK, 1024, G, (int)blockIdx.x);
        EpiResFinal E{X, X, mod1 + 5120, args.in[19], (float*)(ws + WS_XSLOT), (unsigned*)(ws + WS_XCNT), 128u};
        pg8::gemm_phase<EpiResFinal>(lds, ldsx, g, S, E); });
#undef PH
#undef IN
#undef SEAM
}

extern "C" void kernel_launch(void* const* d_in, const int* in_sizes, int n_in, void* d_out, int out_size, void* d_ws, size_t ws_size, hipStream_t stream) {
    static int grid = 0;
    if (grid == 0) {
        if (n_in != 20 || out_size != TOK * DM || ws_size < WS_END) { fprintf(stderr, "kernel_launch: unexpected shapes (n_in %d, out %d, ws %zu)\n", n_in, out_size, ws_size); grid = -1; return; }
        int dev = 0, cus = 0, per_cu = 0;
        if (hipGetDevice(&dev) != hipSuccess || hipDeviceGetAttribute(&cus, hipDeviceAttributeMultiprocessorCount, dev) != hipSuccess) { grid = -1; return; }
        if (hipFuncSetAttribute((const void*)yoco_fwd, hipFuncAttributeMaxDynamicSharedMemorySize, LDS_BYTES) != hipSuccess) { fprintf(stderr, "kernel_launch: hipFuncSetAttribute failed\n"); grid = -1; return; }
        if (hipOccupancyMaxActiveBlocksPerMultiprocessor(&per_cu, (const void*)yoco_fwd, 512, LDS_BYTES) != hipSuccess || per_cu < 1) { fprintf(stderr, "kernel_launch: occupancy query failed (%d)\n", per_cu); (void)hipGetLastError(); grid = -1; return; }
        if (cus != 256) { fprintf(stderr, "kernel_launch: built for a 256-CU device (one 256x256 unit per workgroup in the fused final-norm GEMM), found %d CUs\n", cus); grid = -1; return; }
        grid = cus;
    }
    if (grid < 0) return;
    Args a{};
    for (int i = 0; i < 20; ++i) a.in[i] = (const float*)d_in[i];
    a.out = (float*)d_out; a.ws = (unsigned char*)d_ws;
#if MK_PER_PHASE
    for (int ph = 0; ph < NPHASE; ++ph) {
        a.ph_lo = ph; a.ph_hi = ph + 1; void* kargs[] = {&a};
        hipError_t e = hipLaunchCooperativeKernel((const void*)yoco_fwd, dim3(grid), dim3(512), kargs, LDS_BYTES, stream);
        if (e != hipSuccess) { fprintf(stderr, "cooperative launch failed: %s\n", hipGetErrorString(e)); break; }
    }
#else
    a.ph_lo = 0; a.ph_hi = NPHASE; void* kargs[] = {&a};
    hipError_t e = hipLaunchCooperativeKernel((const void*)yoco_fwd, dim3(grid), dim3(512), kargs, LDS_BYTES, stream);
    if (e != hipSuccess) fprintf(stderr, "cooperative launch failed: %s (grid %d)\n", hipGetErrorString(e), grid);
#endif
}
```

```cpp
#include <hip/hip_runtime.h>
#include <hip/hip_cooperative_groups.h>
#include <cstdio>
#include <cstdint>
namespace cg = cooperative_groups;

#define LAS __attribute__((address_space(3)))
typedef unsigned short bf16_t;
typedef short bf16x8 __attribute__((ext_vector_type(8)));
typedef short s16x4 __attribute__((ext_vector_type(4)));
typedef float f32x4 __attribute__((ext_vector_type(4)));
typedef float f32x2 __attribute__((ext_vector_type(2)));
typedef unsigned u32x4 __attribute__((ext_vector_type(4)));
typedef unsigned u32x2 __attribute__((ext_vector_type(2)));

#ifndef MK_DUP
#define MK_DUP -1
#endif
#ifndef MK_DUPSYNC
#define MK_DUPSYNC 0
#endif
#ifndef MK_PER_PHASE
#define MK_PER_PHASE 0
#endif

constexpr int NB = 8, SEQ = 2048, DM = 1024, TOK = NB * SEQ;
constexpr int DFF = 2816, NFF = 2 * DFF;
constexpr float EPS = 1e-6f;
constexpr int NPHASE = 18;

constexpr size_t MiB = 1u << 20;
constexpr size_t WS_MOD0 = 0, WS_MOD1 = 196608, WS_KVMOD = 393216, WS_LAM = 458752, CTL_ZERO_BYTES = 1 * MiB;
constexpr size_t WS_BAR = 524288, BAR_ZERO_BYTES = 16384;
constexpr size_t WS_TABR = 1 * MiB, WS_TABD = 3 * MiB;
constexpr size_t WS_WRIN = 4 * MiB, WS_WROUT = 16 * MiB, WS_WFIN0 = 20 * MiB, WS_WFIN1 = 31 * MiB, WS_WFDN0 = 42 * MiB, WS_WFDN1 = 42 * MiB + 5632 * 1024,
                 WS_WKV = 53 * MiB, WS_WQ = 57 * MiB, WS_WO = 59 * MiB;
constexpr size_t WS_A0 = 61 * MiB;
constexpr size_t WS_Q = WS_A0, WS_K = 93 * MiB, WS_V = 125 * MiB, WS_G = 189 * MiB;
constexpr size_t WS_H = WS_A0 + 8192;
constexpr size_t WS_U = 126 * MiB;
constexpr size_t WS_H3 = 94 * MiB, WS_KSH = 126 * MiB, WS_VSH = 158 * MiB, WS_QD = 190 * MiB, WS_O0 = 222 * MiB, WS_O1 = WS_H, WS_OD = 94 * MiB;
constexpr size_t WS_SSQ = 253 * MiB;
constexpr size_t WS_XSLOT = 255 * MiB;
constexpr size_t WS_XCNT = 700000;
constexpr size_t WS_END = 256 * MiB;

constexpr int LDS_BYTES = 147456;
constexpr int LDS_XOFF = 131072;

__device__ __forceinline__ unsigned cvt_pk_bf16(float lo, float hi) { unsigned r; asm volatile("v_cvt_pk_bf16_f32 %0, %1, %2" : "=v"(r) : "v"(lo), "v"(hi)); return r; }
__device__ __forceinline__ float bf_lo(unsigned u) { return __uint_as_float(u << 16); }
__device__ __forceinline__ float bf_hi(unsigned u) { return __uint_as_float(u & 0xffff0000u); }
__device__ __forceinline__ float wave_sum(float v) {
#pragma unroll
    for (int o = 1; o < 64; o <<= 1) v += __shfl_xor(v, o);
    return v;
}
__device__ __forceinline__ float silu_f(float x) { return x / (1.0f + __expf(-x)); }
__device__ __forceinline__ f32x2 gelu_pk(f32x2 v) {
    const f32x2 av = __builtin_elementwise_abs(v), d = av * 0.2316418882f + 1.0f;
    f32x2 t; t.x = __builtin_amdgcn_rcpf(d.x); t.y = __builtin_amdgcn_rcpf(d.y);
    f32x2 q = t * 0.5307027145f + (-0.7265760135f); q = q * t + 0.7107068705f; q = q * t + (-0.142248368f); q = q * t + 0.127414796f; q = q * t;
    const f32x2 s = (v * v) * (-0.72134752044f);
    f32x2 e; e.x = __builtin_amdgcn_exp2f(s.x); e.y = __builtin_amdgcn_exp2f(s.y);
    const f32x2 m = v * (q * e), r = v - m;
    f32x2 o; o.x = v.x < 0.f ? m.x : r.x; o.y = v.y < 0.f ? m.y : r.y; return o;
}
__device__ __forceinline__ u32x4 pack8(const f32x4 a, const f32x4 b) { u32x4 w; w.x = cvt_pk_bf16(a[0], a[1]); w.y = cvt_pk_bf16(a[2], a[3]); w.z = cvt_pk_bf16(b[0], b[1]); w.w = cvt_pk_bf16(b[2], b[3]); return w; }
__device__ __forceinline__ bf16x8 lds_b128(const LAS unsigned char* p) { return *(const LAS bf16x8*)p; }
__device__ __forceinline__ s16x4 lds_tr(const LAS unsigned char* p) { return __builtin_amdgcn_ds_read_tr16_b64_v4i16((LAS s16x4*)p); }
__device__ __forceinline__ void glds16_asm(const void* gsrc, unsigned lds_dst) { unsigned keep;
    asm volatile("s_mov_b32 %0, m0\n\ts_mov_b32 m0, %2\n\ts_nop 0\n\tglobal_load_lds_dwordx4 %1, off\n\ts_mov_b32 m0, %0" : "=&s"(keep) : "v"(gsrc), "s"(lds_dst) : "memory"); }
template <int OFF> __device__ __forceinline__ s16x4 lds_tr_asm(unsigned addr) { s16x4 d; asm volatile("ds_read_b64_tr_b16 %0, %1 offset:%2" : "=v"(d) : "v"(addr), "n"(OFF)); return d; }
#define LGKM_WAIT8(n, r) asm volatile("s_waitcnt lgkmcnt(" #n ")" : "+v"(r[0]), "+v"(r[1]), "+v"(r[2]), "+v"(r[3]), "+v"(r[4]), "+v"(r[5]), "+v"(r[6]), "+v"(r[7]))
__device__ __forceinline__ bf16x8 cat4(s16x4 a, s16x4 b) { return __builtin_shufflevector(a, b, 0, 1, 2, 3, 4, 5, 6, 7); }
__device__ __forceinline__ bf16x8 pack_frag(const f32x4 a, const f32x4 b) { u32x4 w = pack8(a, b); return __builtin_bit_cast(bf16x8, w); }
#define MFMA16(a, b, c) __builtin_amdgcn_mfma_f32_16x16x32_bf16((a), (b), (c), 0, 0, 0)

namespace pg8 {
constexpr int BM = 256, BK = 64, HALF = 128, HTB = HALF * BK * 2, STAGE_BYTES = 8 * HTB, NXCD = 8, WGM = 2;
__host__ __device__ __forceinline__ int lds_byte(int r, int c) { const int st = (r >> 4) * 2 + (c >> 5), rr = r & 15, cc = c & 31, ob = rr * 64 + cc * 2; return st * 1024 + (ob ^ (((ob >> 9) & 1) << 5)); }
__host__ __device__ __forceinline__ void stage_rc(int b, int& R, int& C) { const int st = b / 1024, sb = b % 1024, swz = sb ^ (((sb >> 9) & 1) << 5); R = (st >> 1) * 16 + swz / 64; C = (st & 1) * 32 + (swz % 64) / 2; }
__host__ __device__ __forceinline__ int perm32(int rho) { const int n = rho >> 4, i = rho & 15; return 8 * (i >> 2) + 4 * n + (i & 3); }

struct Unit { int pm, pn; };
struct Gemm { const bf16_t* A; const bf16_t* Bt; int M, N, K; int a_rows; const bf16_t* A2 = nullptr; int pn2 = 0x7fffffff; };

struct StaticOrder {
    int nM, nN, nwg, G, c;
    __host__ __device__ void init(int M, int N, int G_, int c_) { nM = M / BM; nN = N / BM; nwg = nM * nN; G = G_; c = c_; }
    __host__ __device__ bool next(int i, Unit& u) const {
        const long L = (long)i * G + c; if (L >= nwg) return false;
        int wgid = (int)L; { const int q = nwg / NXCD, r = nwg % NXCD, xcd = wgid % NXCD, off = wgid / NXCD; wgid = (xcd < r ? xcd * (q + 1) : r * (q + 1) + (xcd - r) * q) + off; }
        const int nig = WGM * nN, gid = wgid / nig, fm = gid * WGM, gsz = (nM - fm) < WGM ? (nM - fm) : WGM;
        u.pm = fm + ((wgid % nig) % gsz); u.pn = (wgid % nig) / gsz; return true;
    }
};

template <class Epi>
__device__ __forceinline__ void gemm_phase(LAS unsigned char* lds, LAS unsigned char* ldsx, const Gemm g, const StaticOrder& S, const Epi& E) {
    const int tid = threadIdx.x, wid = __builtin_amdgcn_readfirstlane(tid >> 6), lane = tid & 63, wr = wid >> 2, wc = wid & 3, fr = lane & 15, fq = lane >> 4;
    const int K = g.K, nt = K / BK;
    unsigned voffA[2], voffB[2];
#pragma unroll
    for (int i = 0; i < 2; ++i) { int R, C; stage_rc(tid * 16 + i * 8192, R, C); const int Rb = Epi::PERM ? ((R & ~31) + perm32(R & 31)) : R;
        voffA[i] = (unsigned)(R * K + C) * 2u; voffB[i] = (unsigned)(Rb * K + C) * 2u; }
    const size_t kstep = (size_t)(BK * 2);
    const size_t hstep = (size_t)HALF * K * 2;
    const size_t tstepB = 2 * hstep;
    const size_t tstepA = (size_t)g.a_rows * K * 2;
    const unsigned ldsw = (unsigned)wid * 1024u;
    const int aoff = lds_byte(wr * 64 + fr, fq * 8), boff = lds_byte(wc * 32 + fr, fq * 8);
#define PG8_SA(b, h) (((b) * 2 + (h)) * HTB)
#define PG8_SB(b, h) ((4 + (b) * 2 + (h)) * HTB)
#define PG8_STAGE(bufoff, gbase, voff) do { _Pragma("unroll") for (int _i = 0; _i < 2; ++_i) \
        __builtin_amdgcn_global_load_lds((const unsigned*)((const char*)(gbase) + (voff)[_i]), (LAS unsigned*)(lds + (bufoff) + ldsw + _i * 8192), 16, 0, 0); } while (0)
#define PG8_LDA(dst, b, h) do { _Pragma("unroll") for (int m = 0; m < 4; ++m) _Pragma("unroll") for (int k = 0; k < 2; ++k) dst[m][k] = *(const LAS bf16x8*)(lds + PG8_SA(b, h) + aoff + m * 2048 + k * 1024); } while (0)
#define PG8_LDB(dst, b, h) do { _Pragma("unroll") for (int n = 0; n < 2; ++n) _Pragma("unroll") for (int k = 0; k < 2; ++k) dst[n][k] = *(const LAS bf16x8*)(lds + PG8_SB(b, h) + boff + n * 2048 + k * 1024); } while (0)
#define PG8_MMA(ai, bj, At, Bt) do { __builtin_amdgcn_s_setprio(1); _Pragma("unroll") for (int m = 0; m < 4; ++m) _Pragma("unroll") for (int n = 0; n < 2; ++n) _Pragma("unroll") for (int k = 0; k < 2; ++k) \
        acc[ai][bj][m][n] = __builtin_amdgcn_mfma_f32_16x16x32_bf16(Bt[n][k], At[m][k], acc[ai][bj][m][n], 0, 0, 0); __builtin_amdgcn_s_setprio(0); } while (0)
#define PG8_WAIT_V(n) asm volatile("s_waitcnt vmcnt(" #n ")" ::: "memory")
#define PG8_WAIT_L(n) asm volatile("s_waitcnt lgkmcnt(" #n ")" ::: "memory")
#define PG8_BAR __builtin_amdgcn_s_barrier()
#define PG8_SCHED __builtin_amdgcn_sched_barrier(0)
    Unit cur, nxt; int ui = 0;
    if (!S.next(0, cur)) return;
    if constexpr (Epi::KHOOK) E.prep(cur, ldsx);
    f32x4 acc[2][2][4][2];
#pragma unroll
    for (int a = 0; a < 2; ++a)
#pragma unroll
        for (int b = 0; b < 2; ++b)
#pragma unroll
            for (int m = 0; m < 4; ++m)
#pragma unroll
                for (int n = 0; n < 2; ++n) acc[a][b][m][n] = (f32x4){0.f, 0.f, 0.f, 0.f};
    bf16x8 At[4][2], B0[2][2], B1[2][2];
    const char* cA = (const char*)(cur.pn >= g.pn2 ? g.A2 : g.A) + (size_t)cur.pm * tstepA; const char* cB = (const char*)g.Bt + (size_t)cur.pn * tstepB;
    PG8_STAGE(PG8_SB(0, 0), cB, voffB); PG8_STAGE(PG8_SB(0, 1), cB + hstep, voffB); PG8_STAGE(PG8_SA(0, 0), cA, voffA); PG8_STAGE(PG8_SA(0, 1), cA + hstep, voffA);
    if (wr == 1) PG8_BAR;
    PG8_WAIT_V(2); PG8_BAR;
    PG8_STAGE(PG8_SB(1, 0), cB + kstep, voffB); PG8_STAGE(PG8_SA(1, 0), cA + kstep, voffA); PG8_STAGE(PG8_SB(1, 1), cB + hstep + kstep, voffB);
    PG8_WAIT_V(6); PG8_BAR;
    for (;;) {
        const bool has_next = S.next(ui + 1, nxt);
        const char* nA = has_next ? (const char*)(nxt.pn >= g.pn2 ? g.A2 : g.A) + (size_t)nxt.pm * tstepA : cA; const char* nB = has_next ? (const char*)g.Bt + (size_t)nxt.pn * tstepB : cB;
        for (int t = 0; t < nt; t += 2) {
            const bool last = (t == nt - 2);
            if constexpr (Epi::KHOOK) { if (t != 0 && (t & 7) == 0) E.khook(acc, t >> 3, wr, fr, ldsx); }
            const char* a1 = cA + (size_t)(t + 1) * kstep;
            const char* a2 = last ? nA : cA + (size_t)(t + 2) * kstep; const char* b2 = last ? nB : cB + (size_t)(t + 2) * kstep;
            const char* a3 = a2 + kstep; const char* b3 = b2 + kstep;
            PG8_LDB(B0, 0, 0); PG8_LDB(B1, 0, 1); PG8_SCHED; PG8_LDA(At, 0, 0); PG8_STAGE(PG8_SA(1, 1), a1 + hstep, voffA);
            PG8_WAIT_V(8); PG8_WAIT_L(0); PG8_BAR; PG8_MMA(0, 0, At, B0); PG8_MMA(0, 1, At, B1); PG8_BAR; PG8_SCHED;
            PG8_LDA(At, 0, 1); PG8_STAGE(PG8_SB(0, 0), b2, voffB); PG8_STAGE(PG8_SB(0, 1), b2 + hstep, voffB); PG8_STAGE(PG8_SA(0, 0), a2, voffA);
            PG8_WAIT_V(8); PG8_WAIT_L(0); PG8_BAR; PG8_MMA(1, 0, At, B0); PG8_MMA(1, 1, At, B1); PG8_BAR; PG8_SCHED;
            PG8_LDB(B0, 1, 0); PG8_LDB(B1, 1, 1); PG8_SCHED; PG8_LDA(At, 1, 0); PG8_STAGE(PG8_SA(0, 1), a2 + hstep, voffA);
            PG8_WAIT_V(8); PG8_WAIT_L(0); PG8_BAR; PG8_MMA(0, 0, At, B0); PG8_MMA(0, 1, At, B1); PG8_BAR; PG8_SCHED;
            PG8_LDA(At, 1, 1); PG8_STAGE(PG8_SB(1, 0), b3, voffB); PG8_STAGE(PG8_SB(1, 1), b3 + hstep, voffB); PG8_STAGE(PG8_SA(1, 0), a3, voffA);
            PG8_WAIT_V(8); PG8_WAIT_L(0); PG8_BAR; PG8_MMA(1, 0, At, B0); PG8_MMA(1, 1, At, B1); PG8_BAR; PG8_SCHED;
        }
        if (wr == 0) PG8_BAR;
        E(acc, cur, wr, wc, fr, fq, ldsx);
        if (!has_next) break;
#pragma unroll
        for (int a = 0; a < 2; ++a)
#pragma unroll
            for (int b = 0; b < 2; ++b)
#pragma unroll
                for (int m = 0; m < 4; ++m)
#pragma unroll
                    for (int n = 0; n < 2; ++n) acc[a][b][m][n] = (f32x4){0.f, 0.f, 0.f, 0.f};
        cur = nxt; cA = nA; cB = nB; ++ui;
        if (wr == 1) PG8_BAR;
    }
    PG8_WAIT_V(0);
    PG8_BAR;
#undef PG8_SA
#undef PG8_SB
#undef PG8_STAGE
#undef PG8_LDA
#undef PG8_LDB
#undef PG8_MMA
#undef PG8_WAIT_V
#undef PG8_WAIT_L
#undef PG8_BAR
#undef PG8_SCHED
}
}
using pg8::Unit;

struct EpiRetIn {
    static constexpr bool PERM = true, KHOOK = false;
    bf16_t *Q, *Kk, *V, *G; const float* tab;
    __device__ __forceinline__ void operator()(const f32x4 (&acc)[2][2][4][2], const Unit& u, int wr, int wc, int fr, int fq, LAS unsigned char*) const {
        const int row0 = u.pm * 256 + wr * 64 + fr, cw = wc * 32 + 8 * fq;
        if (u.pn < 8) {
            const int head = u.pn & 3; const bool isk = u.pn >= 4;
            bf16_t* dst = (isk ? Kk : Q) + head * 256 + cw;
            const float lg = log2f(1.0f - exp2f(-5.0f - (float)head));
#pragma unroll
            for (int ai = 0; ai < 2; ++ai)
#pragma unroll
                for (int m = 0; m < 4; ++m) {
                    const int row = row0 + ai * 128 + m * 16, pos = row & 2047, ci = pos & 127;
                    const float sc = isk ? exp2f(-lg * (float)ci) * 0.0625f : exp2f(lg * (float)ci);
                    const f32x4* tp = (const f32x4*)(tab + ((size_t)pos * 128 + cw) * 2);
                    const f32x4 t0 = tp[0], t1 = tp[1], t2 = tp[2], t3 = tp[3];
                    const f32x4 cs0 = {t0[0], t0[2], t1[0], t1[2]}, sn0 = {t0[1], t0[3], t1[1], t1[3]}, cs1 = {t2[0], t2[2], t3[0], t3[2]}, sn1 = {t2[1], t2[3], t3[1], t3[3]};
                    const f32x4 x10 = acc[ai][0][m][0], x11 = acc[ai][0][m][1], x20 = acc[ai][1][m][0], x21 = acc[ai][1][m][1];
                    const f32x4 o10 = (x10 * cs0 - x20 * sn0) * sc, o11 = (x11 * cs1 - x21 * sn1) * sc;
                    const f32x4 o20 = (x20 * cs0 + x10 * sn0) * sc, o21 = (x21 * cs1 + x11 * sn1) * sc;
                    bf16_t* rp = dst + (size_t)row * 1024;
                    *(u32x4*)rp = pack8(o10, o11); *(u32x4*)(rp + 128) = pack8(o20, o21);
                }
        } else {
            bf16_t* dst = (u.pn < 16 ? V + (u.pn - 8) * 256 : G + (u.pn - 16) * 256) + cw;
#pragma unroll
            for (int ai = 0; ai < 2; ++ai)
#pragma unroll
                for (int m = 0; m < 4; ++m) {
                    bf16_t* rp = dst + (size_t)(row0 + ai * 128 + m * 16) * 2048;
#pragma unroll
                    for (int bj = 0; bj < 2; ++bj) *(u32x4*)(rp + bj * 128) = pack8(acc[ai][bj][m][0], acc[ai][bj][m][1]);
                }
        }
    }
};
struct EpiRes {
    static constexpr bool PERM = false, KHOOK = false;
    const float* base; float* out; const float* gate;
    __device__ __forceinline__ void operator()(const f32x4 (&acc)[2][2][4][2], const Unit& u, int wr, int wc, int fr, int fq, LAS unsigned char*) const {
        const int row0 = u.pm * 256 + wr * 64 + fr, col0 = u.pn * 256 + wc * 32 + 4 * fq;
#pragma unroll
        for (int ai = 0; ai < 2; ++ai)
#pragma unroll
            for (int m = 0; m < 4; ++m) {
                const int row = row0 + ai * 128 + m * 16; const float* gp = gate + (size_t)(row >> 11) * 6144 + col0; const size_t off = (size_t)row * 1024 + col0;
#pragma unroll
                for (int bj = 0; bj < 2; ++bj)
#pragma unroll
                    for (int n = 0; n < 2; ++n) { const int c = bj * 128 + n * 16; const f32x4 gv = *(const f32x4*)(gp + c), bs = *(const f32x4*)(base + off + c);
                        *(f32x4*)(out + off + c) = bs + gv * acc[ai][bj][m][n]; }
            }
    }
};
struct EpiResHead {
    static constexpr bool PERM = false, KHOOK = true;
    const float* base; float* out; const float* gate; const float* ssq;
    __device__ __forceinline__ void prep(const Unit& u, LAS unsigned char* lx) const {
        const int t = threadIdx.x;
        if (t < 256) {
            const f32x4* p = (const f32x4*)(ssq + (size_t)(u.pm * 256 + t) * 32);
            float ri[4];
#pragma unroll
            for (int h = 0; h < 4; ++h) { const f32x4 a = p[2 * h], b = p[2 * h + 1]; const float sm = ((a[0] + a[1]) + (a[2] + a[3])) + ((b[0] + b[1]) + (b[2] + b[3])); ri[h] = 1.0f / sqrtf(sm * (1.0f / 512.0f) + EPS); }
            *(LAS f32x4*)(lx + t * 16) = (f32x4){ri[3], ri[0] / ri[1], ri[1] / ri[2], ri[2] / ri[3]};
        }
        asm volatile("s_waitcnt lgkmcnt(0)" ::: "memory");
    }
    __device__ __forceinline__ void khook(f32x4 (&acc)[2][2][4][2], int hb, int wr, int fr, LAS unsigned char* lx) const {
#pragma unroll
        for (int ai = 0; ai < 2; ++ai)
#pragma unroll
            for (int m = 0; m < 4; ++m) { const float f = ((const LAS float*)lx)[(ai * 128 + wr * 64 + m * 16 + fr) * 4 + hb];
#pragma unroll
                for (int bj = 0; bj < 2; ++bj)
#pragma unroll
                    for (int n = 0; n < 2; ++n) acc[ai][bj][m][n] = acc[ai][bj][m][n] * f; }
    }
    __device__ __forceinline__ void operator()(const f32x4 (&acc)[2][2][4][2], const Unit& u, int wr, int wc, int fr, int fq, LAS unsigned char* lx) const {
        const int row0 = u.pm * 256 + wr * 64 + fr, col0 = u.pn * 256 + wc * 32 + 4 * fq;
#pragma unroll
        for (int ai = 0; ai < 2; ++ai)
#pragma unroll
            for (int m = 0; m < 4; ++m) {
                const int row = row0 + ai * 128 + m * 16; const float* gp = gate + (size_t)(row >> 11) * 6144 + col0; const size_t off = (size_t)row * 1024 + col0;
                const float r3 = ((const LAS float*)lx)[(ai * 128 + wr * 64 + m * 16 + fr) * 4];
#pragma unroll
                for (int bj = 0; bj < 2; ++bj)
#pragma unroll
                    for (int n = 0; n < 2; ++n) { const int c = bj * 128 + n * 16; const f32x4 gv = *(const f32x4*)(gp + c), bs = *(const f32x4*)(base + off + c);
                        *(f32x4*)(out + off + c) = bs + gv * (acc[ai][bj][m][n] * r3); }
            }
    }
};
struct NormOut { bf16_t* dst; const float* gain; const float* sh; const float* sc; int bstride; };
template <bool HEAD, int NX> struct EpiResNorm {
    static constexpr bool PERM = !HEAD, KHOOK = HEAD;
    static constexpr int FQS = PERM ? 8 : 4, NS = PERM ? 4 : 16;
    const float* base; float* out; const float* gate; const float* ssq; NormOut no[2]; float* slots; unsigned* cnt; unsigned target;
    __device__ __forceinline__ void prep(const Unit& u, LAS unsigned char* lx) const {
        const int t = threadIdx.x;
        if (t < 256) {
            const f32x4* p = (const f32x4*)(ssq + (size_t)(u.pm * 256 + t) * 32);
            float ri[4];
#pragma unroll
            for (int h = 0; h < 4; ++h) { const f32x4 a = p[2 * h], b = p[2 * h + 1]; const float sm = ((a[0] + a[1]) + (a[2] + a[3])) + ((b[0] + b[1]) + (b[2] + b[3])); ri[h] = 1.0f / sqrtf(sm * (1.0f / 512.0f) + EPS); }
            *(LAS f32x4*)(lx + t * 16) = (f32x4){ri[3], ri[0] / ri[1], ri[1] / ri[2], ri[2] / ri[3]};
        }
        asm volatile("s_waitcnt lgkmcnt(0)" ::: "memory");
    }
    __device__ __forceinline__ void khook(f32x4 (&acc)[2][2][4][2], int hb, int wr, int fr, LAS unsigned char* lx) const {
        int rb = wr * 64 + fr; asm volatile("" : "+v"(rb));
#pragma unroll
        for (int ai = 0; ai < 2; ++ai)
#pragma unroll
            for (int m = 0; m < 4; ++m) { const float f = ((const LAS float*)lx)[(ai * 128 + rb + m * 16) * 4 + hb];
#pragma unroll
                for (int bj = 0; bj < 2; ++bj)
#pragma unroll
                    for (int n = 0; n < 2; ++n) acc[ai][bj][m][n] = acc[ai][bj][m][n] * f; }
    }
    __device__ __forceinline__ void operator()(f32x4 (&acc)[2][2][4][2], const Unit& u, int wr, int wc, int fr, int fq, LAS unsigned char* lx) const {
        LAS float* P = (LAS float*)(lx + 4096);
        LAS float* Sr = (LAS float*)(lx + 9216);
        const int row0 = u.pm * 256 + wr * 64 + fr, col0 = u.pn * 256 + wc * 32 + FQS * fq, wid = wr * 4 + wc, b = (u.pm * 256) >> 11;
        const int lane = (int)__builtin_amdgcn_mbcnt_hi(~0u, __builtin_amdgcn_mbcnt_lo(~0u, 0u));
        const float* gp = gate + (size_t)b * 6144 + col0;
        int rb = wr * 64 + fr; asm volatile("" : "+v"(rb));
#pragma unroll
        for (int ai = 0; ai < 2; ++ai)
#pragma unroll
            for (int m = 0; m < 4; ++m) {
                const int row = row0 + ai * 128 + m * 16; const size_t off = (size_t)row * 1024 + col0;
                const float r3 = HEAD ? ((const LAS float*)lx)[(ai * 128 + rb + m * 16) * 4] : 1.0f;
                float ss = 0.f;
#pragma unroll
                for (int bj = 0; bj < 2; ++bj)
#pragma unroll
                    for (int n = 0; n < 2; ++n) { const int c = bj * 128 + n * NS; const f32x4 gv = *(const f32x4*)(gp + c), bs = *(const f32x4*)(base + off + c);
                        const f32x4 v = bs + gv * (HEAD ? acc[ai][bj][m][n] * r3 : acc[ai][bj][m][n]); acc[ai][bj][m][n] = v; *(f32x4*)(out + off + c) = v;
                        ss += (v[0] * v[0] + v[1] * v[1]) + (v[2] * v[2] + v[3] * v[3]); }
                ss += __shfl_xor(ss, 16); ss += __shfl_xor(ss, 32);
                if (fq == 0) P[(ai * 128 + rb + m * 16) * 4 + wc] = ss;
            }
        asm volatile("s_waitcnt lgkmcnt(0)" ::: "memory"); __builtin_amdgcn_s_barrier(); asm volatile("" ::: "memory");
        const int rl = wid * 32 + (lane & 31);
        if (lane < 32) { const f32x4 p = *(const LAS f32x4*)(P + rl * 4); const float sm = (p[0] + p[1]) + (p[2] + p[3]);
            __hip_atomic_store(slots + (size_t)(u.pm * 256 + rl) * 4 + u.pn, sm, __ATOMIC_RELAXED, __HIP_MEMORY_SCOPE_AGENT); }
        asm volatile("s_waitcnt vmcnt(0)" ::: "memory");
        if (lane == 0) __hip_atomic_fetch_add(cnt + 16 * u.pm, 1u, __ATOMIC_RELAXED, __HIP_MEMORY_SCOPE_AGENT);
        if (wid == 0) {
            unsigned sp = 0;
            while ((unsigned)__builtin_amdgcn_readfirstlane(__hip_atomic_load(cnt + 16 * u.pm, __ATOMIC_RELAXED, __HIP_MEMORY_SCOPE_AGENT)) < target) { __builtin_amdgcn_s_sleep(2); if (++sp > (1u << 16)) break; }
            __builtin_amdgcn_fence(__ATOMIC_ACQUIRE, "agent");
            asm volatile("s_waitcnt vmcnt(0)" ::: "memory");
        }
        asm volatile("s_waitcnt vmcnt(0) lgkmcnt(0)" ::: "memory"); __builtin_amdgcn_s_barrier(); asm volatile("" ::: "memory");
        if (lane < 32) { const float* sl = slots + (size_t)(u.pm * 256 + rl) * 4; float t = 0.f;
#pragma unroll
            for (int k = 0; k < 4; ++k) t += __hip_atomic_load(sl + k, __ATOMIC_RELAXED, __HIP_MEMORY_SCOPE_AGENT);
            Sr[rl] = 1.0f / sqrtf(t * (1.0f / DM) + EPS); }
        asm volatile("s_waitcnt vmcnt(0) lgkmcnt(0)" ::: "memory"); __builtin_amdgcn_s_barrier(); asm volatile("" ::: "memory");
#pragma unroll
        for (int ai = 0; ai < 2; ++ai)
#pragma unroll
            for (int m = 0; m < 4; ++m) {
                const int rloc = ai * 128 + rb + m * 16; const float ri = Sr[rloc]; const size_t off = (size_t)(u.pm * 256 + rloc) * 1024 + col0;
#pragma unroll
                for (int bj = 0; bj < 2; ++bj)
#pragma unroll
                    for (int n = 0; n < 2; ++n) { const int c = col0 + bj * 128 + n * NS; const f32x4 vr = acc[ai][bj][m][n] * ri;
#pragma unroll
                        for (int x = 0; x < NX; ++x) { const f32x4 g4 = *(const f32x4*)(no[x].gain + c), s4 = *(const f32x4*)(no[x].sc + (size_t)b * no[x].bstride + c), h4 = *(const f32x4*)(no[x].sh + (size_t)b * no[x].bstride + c);
                            const f32x4 h = vr * g4 * (s4 + 1.0f) + h4; u32x2 w; w.x = cvt_pk_bf16(h[0], h[1]); w.y = cvt_pk_bf16(h[2], h[3]); *(u32x2*)(no[x].dst + off + bj * 128 + n * NS) = w; } }
            }
    }
};
struct EpiResFinal {
    static constexpr bool PERM = true, KHOOK = false;
    const float* base; float* out; const float* gate; const float* gain; float* slots; unsigned* cnt; unsigned target;
    __device__ __forceinline__ void operator()(f32x4 (&acc)[2][2][4][2], const Unit& u, int wr, int wc, int fr, int fq, LAS unsigned char* lx) const {
        LAS float* P = (LAS float*)lx;
        LAS float* Sr = (LAS float*)(lx + 4096);
        const int row0 = u.pm * 256 + wr * 64 + fr, col0 = u.pn * 256 + wc * 32 + 8 * fq, wid = wr * 4 + wc;
        const int lane = (int)__builtin_amdgcn_mbcnt_hi(~0u, __builtin_amdgcn_mbcnt_lo(~0u, 0u));
#pragma unroll
        for (int ai = 0; ai < 2; ++ai)
#pragma unroll
            for (int m = 0; m < 4; ++m) {
                const int row = row0 + ai * 128 + m * 16; const float* gp = gate + (size_t)(row >> 11) * 6144 + col0; const size_t off = (size_t)row * 1024 + col0;
                float ss = 0.f;
#pragma unroll
                for (int bj = 0; bj < 2; ++bj)
#pragma unroll
                    for (int n = 0; n < 2; ++n) { const int c = bj * 128 + n * 4; const f32x4 gv = *(const f32x4*)(gp + c), bs = *(const f32x4*)(base + off + c);
                        const f32x4 v = bs + gv * acc[ai][bj][m][n]; acc[ai][bj][m][n] = v; ss += (v[0] * v[0] + v[1] * v[1]) + (v[2] * v[2] + v[3] * v[3]); }
                ss += __shfl_xor(ss, 16); ss += __shfl_xor(ss, 32);
                if (fq == 0) P[(ai * 128 + wr * 64 + m * 16 + fr) * 4 + wc] = ss;
            }
        asm volatile("s_waitcnt lgkmcnt(0)" ::: "memory"); __builtin_amdgcn_s_barrier(); asm volatile("" ::: "memory");
        const int rl = wid * 32 + (lane & 31);
        if (lane < 32) { const f32x4 p = *(const LAS f32x4*)(P + rl * 4); const float sm = (p[0] + p[1]) + (p[2] + p[3]);
            __hip_atomic_store(slots + (size_t)(u.pm * 256 + rl) * 4 + u.pn, sm, __ATOMIC_RELAXED, __HIP_MEMORY_SCOPE_AGENT); }
        asm volatile("s_waitcnt vmcnt(0)" ::: "memory");
        if (lane == 0) __hip_atomic_fetch_add(cnt + 16 * u.pm, 1u, __ATOMIC_RELAXED, __HIP_MEMORY_SCOPE_AGENT);
        if (wid == 0) {
            unsigned sp = 0;
            while ((unsigned)__builtin_amdgcn_readfirstlane(__hip_atomic_load(cnt + 16 * u.pm, __ATOMIC_RELAXED, __HIP_MEMORY_SCOPE_AGENT)) < target) { __builtin_amdgcn_s_sleep(2); if (++sp > (1u << 16)) break; }
            __builtin_amdgcn_fence(__ATOMIC_ACQUIRE, "agent");
            asm volatile("s_waitcnt vmcnt(0)" ::: "memory");
        }
        asm volatile("s_waitcnt vmcnt(0) lgkmcnt(0)" ::: "memory"); __builtin_amdgcn_s_barrier(); asm volatile("" ::: "memory");
        if (lane < 32) { const float* sl = slots + (size_t)(u.pm * 256 + rl) * 4; float t = 0.f;
#pragma unroll
            for (int k = 0; k < 4; ++k) t += __hip_atomic_load(sl + k, __ATOMIC_RELAXED, __HIP_MEMORY_SCOPE_AGENT);
            Sr[rl] = 1.0f / sqrtf(t * (1.0f / DM) + EPS); }
        asm volatile("s_waitcnt vmcnt(0) lgkmcnt(0)" ::: "memory"); __builtin_amdgcn_s_barrier(); asm volatile("" ::: "memory");
#pragma unroll
        for (int ai = 0; ai < 2; ++ai)
#pragma unroll
            for (int m = 0; m < 4; ++m) {
                const int rloc = ai * 128 + wr * 64 + m * 16 + fr; const float ri = Sr[rloc]; const size_t off = (size_t)(u.pm * 256 + rloc) * 1024 + col0;
#pragma unroll
                for (int bj = 0; bj < 2; ++bj)
#pragma unroll
                    for (int n = 0; n < 2; ++n) { const int c = bj * 128 + n * 4; __builtin_nontemporal_store(acc[ai][bj][m][n] * ri * *(const f32x4*)(gain + col0 + c), (f32x4*)(out + off + c)); }
            }
    }
};
struct EpiRope {
    static constexpr bool PERM = true, KHOOK = false;
    bf16_t* dstR; bf16_t* dstV; int nrope; const float* tab; float scale;
    bf16_t* dstQ; int nq0; float scaleQ;
    __device__ __forceinline__ void operator()(const f32x4 (&acc)[2][2][4][2], const Unit& u, int wr, int wc, int fr, int fq, LAS unsigned char*) const {
        const int row0 = u.pm * 256 + wr * 64 + fr, cw = wc * 32 + 8 * fq;
        if (u.pn < nrope || u.pn >= nq0) {
            const int p = cw >> 6, dd = cw & 63; const bool isq = u.pn >= nq0; const float scale = isq ? scaleQ : this->scale;
            bf16_t* dst = (isq ? dstQ + (u.pn - nq0) * 256 : dstR + u.pn * 256) + p * 128 + dd;
#pragma unroll
            for (int ai = 0; ai < 2; ++ai)
#pragma unroll
                for (int m = 0; m < 4; ++m) {
                    const int row = row0 + ai * 128 + m * 16, pos = row & 2047;
                    const f32x4* tp = (const f32x4*)(tab + ((size_t)pos * 64 + dd) * 2);
                    const f32x4 t0 = tp[0], t1 = tp[1], t2 = tp[2], t3 = tp[3];
                    const f32x4 cs0 = {t0[0], t0[2], t1[0], t1[2]}, sn0 = {t0[1], t0[3], t1[1], t1[3]}, cs1 = {t2[0], t2[2], t3[0], t3[2]}, sn1 = {t2[1], t2[3], t3[1], t3[3]};
                    const f32x4 x10 = acc[ai][0][m][0], x11 = acc[ai][0][m][1], x20 = acc[ai][1][m][0], x21 = acc[ai][1][m][1];
                    const f32x4 o10 = (x10 * cs0 - x20 * sn0) * scale, o11 = (x11 * cs1 - x21 * sn1) * scale;
                    const f32x4 o20 = (x20 * cs0 + x10 * sn0) * scale, o21 = (x21 * cs1 + x11 * sn1) * scale;
                    bf16_t* rp = dst + (size_t)row * 1024;
                    *(u32x4*)rp = pack8(o10, o11); *(u32x4*)(rp + 64) = pack8(o20, o21);
                }
        } else {
            bf16_t* dst = dstV + (u.pn - nrope) * 256 + cw;
#pragma unroll
            for (int ai = 0; ai < 2; ++ai)
#pragma unroll
                for (int m = 0; m < 4; ++m) {
                    bf16_t* rp = dst + (size_t)(row0 + ai * 128 + m * 16) * 1024;
#pragma unroll
                    for (int bj = 0; bj < 2; ++bj) *(u32x4*)(rp + bj * 128) = pack8(acc[ai][bj][m][0], acc[ai][bj][m][1]);
                }
        }
    }
};
__device__ __forceinline__ float dpp_shr1(float v) { return __builtin_bit_cast(float, __builtin_amdgcn_update_dpp(0, __builtin_bit_cast(int, v), 0x111, 0xf, 0xf, true)); }
__device__ __forceinline__ float dpp_shr2(float v) { return __builtin_bit_cast(float, __builtin_amdgcn_update_dpp(0, __builtin_bit_cast(int, v), 0x112, 0xf, 0xf, true)); }
__device__ __forceinline__ float dpp_ror1(float v) { return __builtin_bit_cast(float, __builtin_amdgcn_update_dpp(0, __builtin_bit_cast(int, v), 0x121, 0xf, 0xf, false)); }
__device__ __forceinline__ float dpp_shr1_old(float old, float v) { return __builtin_bit_cast(float, __builtin_amdgcn_update_dpp(__builtin_bit_cast(int, old), __builtin_bit_cast(int, v), 0x111, 0xf, 0xf, false)); }
__device__ __forceinline__ float dpp_shr2_old(float old, float v) { return __builtin_bit_cast(float, __builtin_amdgcn_update_dpp(__builtin_bit_cast(int, old), __builtin_bit_cast(int, v), 0x112, 0xf, 0xf, false)); }
__device__ __forceinline__ float dpp_ror2(float v) { return __builtin_bit_cast(float, __builtin_amdgcn_update_dpp(0, __builtin_bit_cast(int, v), 0x122, 0xf, 0xf, false)); }
struct EpiFfn {
    static constexpr bool PERM = true, KHOOK = false;
    bf16_t* U; const float* wconv; const float* bconv;
    __device__ __forceinline__ void operator()(const f32x4 (&acc)[2][2][4][2], const Unit& u, int wr, int wc, int fr, int fq, LAS unsigned char* lx) const {
        const int cw = wc * 32 + 8 * fq, j0 = u.pn * 128 + cw;
        f32x4 w0[2], w1[2], w2[2], bc[2];
#pragma unroll
        for (int n = 0; n < 2; ++n) { w0[n] = *(const f32x4*)(wconv + j0 + 4 * n); w1[n] = *(const f32x4*)(wconv + DFF + j0 + 4 * n); w2[n] = *(const f32x4*)(wconv + 2 * DFF + j0 + 4 * n); bc[n] = *(const f32x4*)(bconv + j0 + 4 * n); }
        LAS float* hx = (LAS float*)lx;
        if (fr >= 14) {
#pragma unroll
            for (int ai = 0; ai < 2; ++ai) { LAS float* p = hx + ((((2 * ai + wr) * 4 + wc) * 2 + (fr - 14)) * 4 + fq) * 8;
                *(LAS f32x4*)p = acc[ai][0][3][0]; *(LAS f32x4*)(p + 4) = acc[ai][0][3][1]; }
        }
        asm volatile("s_waitcnt lgkmcnt(0)" ::: "memory"); __builtin_amdgcn_s_barrier(); asm volatile("" ::: "memory");
        const int rr = fr >= 14 ? fr - 14 : 0;
#pragma unroll
        for (int ai = 0; ai < 2; ++ai) {
            const int qc = 2 * ai + wr;
            f32x4 pv[2] = {(f32x4){0.f, 0.f, 0.f, 0.f}, (f32x4){0.f, 0.f, 0.f, 0.f}};
            if (qc >= 1) { const LAS float* p = hx + (((((qc - 1) * 4 + wc) * 2 + rr) * 4 + fq) * 8); pv[0] = *(const LAS f32x4*)p; pv[1] = *(const LAS f32x4*)(p + 4); }
#pragma unroll
            for (int m = 0; m < 4; ++m) {
                const int trow = ai * 128 + wr * 64 + m * 16 + fr, grow = u.pm * 254 - 2 + trow, pos = grow & 2047;
                f32x4 res[2];
#pragma unroll
                for (int n = 0; n < 2; ++n) {
                    const f32x4 cur = acc[ai][0][m][n], gg = acc[ai][1][m][n];
                    f32x4 cv;
#pragma unroll
                    for (int j = 0; j < 4; ++j) {
                        float a1 = dpp_shr1_old(dpp_ror1(pv[n][j]), cur[j]), a2 = dpp_shr2_old(dpp_ror2(pv[n][j]), cur[j]);
                        a1 = pos < 1 ? 0.f : a1; a2 = pos < 2 ? 0.f : a2;
                        cv[j] = w0[n][j] * a2 + w1[n][j] * a1 + w2[n][j] * cur[j] + bc[n][j];
                    }
                    const f32x2 ga = gelu_pk((f32x2){cv[0], cv[1]}), gb = gelu_pk((f32x2){cv[2], cv[3]});
                    res[n] = (f32x4){ga.x * gg[0], ga.y * gg[1], gb.x * gg[2], gb.y * gg[3]};
                    pv[n] = cur;
                }
                if (trow >= 2 && grow < TOK) *(u32x4*)(U + (size_t)grow * DFF + j0) = pack8(res[0], res[1]);
            }
        }
    }
};

__device__ __forceinline__ int rowmap(int kind, int n) {
    if (kind == 0) return n;
    if (kind == 1) { const int half = n >= DFF ? 1 : 0, j = n - half * DFF; return (j >> 7) * 256 + half * 128 + (j & 127); }
    const int h = n >> 8, p = (n >> 7) & 1, d = n & 127; return h * 256 + (d >> 6) * 128 + p * 64 + (d & 63);
}
__device__ __forceinline__ void transpose_item(const float* W, int ldw, int col0, int ncols, int K, bf16_t* WT, int kind, int row_off, LAS float* scr, int item, int lane) {
    const int nblk = ncols / 32, kb = item / nblk, nb = item % nblk, k0 = 64 * kb, n0 = 32 * nb;
    f32x4 v[8];
#pragma unroll
    for (int i = 0; i < 8; ++i) v[i] = *(const f32x4*)(W + (size_t)(k0 + 8 * i + (lane >> 3)) * ldw + col0 + n0 + 4 * (lane & 7));
#pragma unroll
    for (int i = 0; i < 8; ++i) { LAS float* d = scr + (8 * i + (lane >> 3)) * 33 + 4 * (lane & 7); d[0] = v[i][0]; d[1] = v[i][1]; d[2] = v[i][2]; d[3] = v[i][3]; }
    asm volatile("s_waitcnt lgkmcnt(0)" ::: "memory");
    const int c = lane & 7;
#pragma unroll
    for (int j = 0; j < 4; ++j) { const int n = (lane >> 3) + 8 * j; const LAS float* s = scr + (8 * c) * 33 + n;
        u32x4 o; o.x = cvt_pk_bf16(s[0 * 33], s[1 * 33]); o.y = cvt_pk_bf16(s[2 * 33], s[3 * 33]); o.z = cvt_pk_bf16(s[4 * 33], s[5 * 33]); o.w = cvt_pk_bf16(s[6 * 33], s[7 * 33]);
        *(u32x4*)(WT + (size_t)(row_off + rowmap(kind, n0 + n)) * K + k0 + 8 * c) = o; }
    asm volatile("s_waitcnt lgkmcnt(0)" ::: "memory");
}
__device__ __forceinline__ void mods_item(const float* c, const float* W, int N, int strip, int kc, LAS float* scr, LAS float* red, int lane) {
    const int k0 = kc * 128, n0 = strip * 64;
#pragma unroll
    for (int i = 0; i < 16; ++i) { const int idx = lane + 64 * i, b = idx >> 7, kk = idx & 127; scr[kk * 8 + b] = silu_f(c[b * 1024 + k0 + kk]); }
    asm volatile("s_waitcnt lgkmcnt(0)" ::: "memory");
    float a0 = 0.f, a1 = 0.f, a2 = 0.f, a3 = 0.f, a4 = 0.f, a5 = 0.f, a6 = 0.f, a7 = 0.f;
#pragma unroll 32
    for (int kk = 0; kk < 128; ++kk) {
        const float wv = __builtin_nontemporal_load(W + (size_t)(k0 + kk) * N + n0 + lane);
        const f32x4 s0 = *(const LAS f32x4*)(scr + kk * 8), s1 = *(const LAS f32x4*)(scr + kk * 8 + 4);
        a0 += s0[0] * wv; a1 += s0[1] * wv; a2 += s0[2] * wv; a3 += s0[3] * wv; a4 += s1[0] * wv; a5 += s1[1] * wv; a6 += s1[2] * wv; a7 += s1[3] * wv;
    }
    red[0 * 64 + lane] = a0; red[1 * 64 + lane] = a1; red[2 * 64 + lane] = a2; red[3 * 64 + lane] = a3;
    red[4 * 64 + lane] = a4; red[5 * 64 + lane] = a5; red[6 * 64 + lane] = a6; red[7 * 64 + lane] = a7;
}
__device__ __forceinline__ void sincos_acc(float ang, float& s, float& c) {
    const double x = (double)ang;
    const double k = __builtin_rint(x * 0.6366197723675814);
    double y = __builtin_fma(-k, 1.5707963267948966, x); y = __builtin_fma(-k, 6.123233995736766e-17, y);
    const int q = ((int)k) & 3;
    const double y2 = y * y;
    const double sp = y * (1.0 + y2 * (-1.0 / 6.0 + y2 * (1.0 / 120.0 + y2 * (-1.0 / 5040.0 + y2 * (1.0 / 362880.0 + y2 * (-1.0 / 39916800.0 + y2 * (1.0 / 6227020800.0)))))));
    const double cp = 1.0 + y2 * (-0.5 + y2 * (1.0 / 24.0 + y2 * (-1.0 / 720.0 + y2 * (1.0 / 40320.0 + y2 * (-1.0 / 3628800.0 + y2 * (1.0 / 479001600.0))))));
    const double ss = (q == 0) ? sp : (q == 1) ? cp : (q == 2) ? -sp : -cp;
    const double cc = (q == 0) ? cp : (q == 1) ? -sp : (q == 2) ? -cp : sp;
    s = (float)ss; c = (float)cc;
}

struct Args { const float* in[20]; float* out; unsigned char* ws; int ph_lo, ph_hi; };

template <int PART> __device__ __forceinline__ void p0_prologue(const Args& a, LAS unsigned char* lds, int wave, int lane, int G) {
    LAS float* scr = (LAS float*)(lds + wave * 16384);
    const int gw = blockIdx.x * 8 + wave, NGW = G * 8;
    unsigned char* ws = a.ws;
    if (PART == 0) {
    for (int strip = blockIdx.x; strip < 224; strip += G) {
        LAS float* red = (LAS float*)(lds + wave * 16384 + 8192);
        const float* W; const float* bias; float* out; int N, st;
        if (strip < 96) { W = a.in[3]; bias = a.in[4]; out = (float*)(ws + WS_MOD0); N = 6144; st = strip; }
        else if (strip < 192) { W = a.in[3] + (size_t)1024 * 6144; bias = a.in[4] + 6144; out = (float*)(ws + WS_MOD1); N = 6144; st = strip - 96; }
        else { W = a.in[12]; bias = a.in[13]; out = (float*)(ws + WS_KVMOD); N = 2048; st = strip - 192; }
        mods_item(a.in[1], W, N, st, wave, scr, red, lane);
        __syncthreads();
        { float sum = bias[st * 64 + lane];
#pragma unroll
          for (int kc = 0; kc < 8; ++kc) sum += ((const LAS float*)(lds + kc * 16384 + 8192))[wave * 64 + lane];
          out[(size_t)wave * N + st * 64 + lane] = sum; }
        __syncthreads();
    }
    }
    if (PART == 1) {
    {
        constexpr int T_RIN = (1024 / 128) * (6144 / 64), T_ROUT = (2048 / 128) * (1024 / 64), T_FIN = (1024 / 128) * (NFF / 64), T_FDN = (DFF / 128) * (1024 / 64), T_SQ = (1024 / 128) * (1024 / 64);
        constexpr int NTILES = T_RIN + T_ROUT + 2 * T_FIN + 2 * T_FDN + 4 * T_SQ;
        struct TrJob { const float* W; int ldw, col0, ncols, K; bf16_t* WT; int kind, row_off, item; };
        auto decode = [&](int it) -> TrJob {
            int r = it;
            if (r < T_RIN) return TrJob{a.in[5], 6144, 0, 6144, 1024, (bf16_t*)(ws + WS_WRIN), 0, 0, r}; r -= T_RIN;
            if (r < T_ROUT) return TrJob{a.in[6], 1024, 0, 1024, 2048, (bf16_t*)(ws + WS_WROUT), 0, 0, r}; r -= T_ROUT;
            if (r < T_FIN) return TrJob{a.in[7], NFF, 0, NFF, 1024, (bf16_t*)(ws + WS_WFIN0), 1, 0, r}; r -= T_FIN;
            if (r < T_FIN) return TrJob{a.in[7] + (size_t)1024 * NFF, NFF, 0, NFF, 1024, (bf16_t*)(ws + WS_WFIN1), 1, 0, r}; r -= T_FIN;
            if (r < T_FDN) return TrJob{a.in[10], 1024, 0, 1024, DFF, (bf16_t*)(ws + WS_WFDN0), 0, 0, r}; r -= T_FDN;
            if (r < T_FDN) return TrJob{a.in[10] + (size_t)DFF * 1024, 1024, 0, 1024, DFF, (bf16_t*)(ws + WS_WFDN1), 0, 0, r}; r -= T_FDN;
            if (r < T_SQ) return TrJob{a.in[14], 2048, 0, 1024, 1024, (bf16_t*)(ws + WS_WKV), 2, 0, r}; r -= T_SQ;
            if (r < T_SQ) return TrJob{a.in[14], 2048, 1024, 1024, 1024, (bf16_t*)(ws + WS_WKV), 0, 1024, r}; r -= T_SQ;
            if (r < T_SQ) return TrJob{a.in[15], 1024, 0, 1024, 1024, (bf16_t*)(ws + WS_WQ), 2, 0, r}; r -= T_SQ;
            return TrJob{a.in[18], 1024, 0, 1024, 1024, (bf16_t*)(ws + WS_WO), 0, 0, r};
        };
        const int tid = threadIdx.x, c4 = tid & 15, rp = tid >> 4;
        f32x4 v[4];
        int it = blockIdx.x;
        TrJob cur = decode(it < NTILES ? it : 0);
#define TR_LOAD(j_) do { const int nblk_ = (j_).ncols / 64, k0_ = 128 * ((j_).item / nblk_), n0_ = 64 * ((j_).item % nblk_); \
        _Pragma("unroll") for (int i = 0; i < 2; ++i) { const float* p_ = (j_).W + (size_t)(k0_ + 2 * (32 * i + rp)) * (j_).ldw + (j_).col0 + n0_ + 4 * c4; v[2 * i] = __builtin_nontemporal_load((const f32x4*)p_); v[2 * i + 1] = __builtin_nontemporal_load((const f32x4*)(p_ + (j_).ldw)); } } while (0)
        if (it < NTILES) TR_LOAD(cur);
        int buf = 0;
        for (; it < NTILES; it += G) {
            LAS unsigned* tile = (LAS unsigned*)(lds + buf * 16896);
#pragma unroll
            for (int i = 0; i < 2; ++i) { LAS unsigned* d = tile + (32 * i + rp) * 65 + 4 * c4;
                d[0] = cvt_pk_bf16(v[2 * i][0], v[2 * i + 1][0]); d[1] = cvt_pk_bf16(v[2 * i][1], v[2 * i + 1][1]); d[2] = cvt_pk_bf16(v[2 * i][2], v[2 * i + 1][2]); d[3] = cvt_pk_bf16(v[2 * i][3], v[2 * i + 1][3]); }
            __syncthreads();
            const TrJob job = cur;
            if (it + G < NTILES) { cur = decode(it + G); TR_LOAD(cur); }
            { const int nblk = job.ncols / 64, k0 = 128 * (job.item / nblk), n0 = 64 * (job.item % nblk);
#pragma unroll
              for (int p = 0; p < 2; ++p) { const int n = 32 * p + rp; const LAS unsigned* sp = tile + (4 * c4) * 65 + n;
                  u32x4 o; o.x = sp[0]; o.y = sp[65]; o.z = sp[130]; o.w = sp[195];
                  __builtin_nontemporal_store(o, (u32x4*)(job.WT + (size_t)(job.row_off + rowmap(job.kind, n0 + n)) * job.K + k0 + 8 * c4)); } }
            buf ^= 1;
        }
#undef TR_LOAD
        __syncthreads();
    }
    const int gt = blockIdx.x * 512 + threadIdx.x, NGT = G * 512;
    f32x2* tabR = (f32x2*)(ws + WS_TABR); f32x2* tabD = (f32x2*)(ws + WS_TABD);
    for (int i = gt; i < 2048 * 128; i += NGT) { const int pos = i >> 7, f = i & 127; const float fr = exp2f(-13.287712379549449f * ((float)f / 127.0f)); float s, c; sincos_acc((float)pos * fr, s, c); tabR[i] = (f32x2){c, s}; }
    for (int i = gt; i < 2048 * 64; i += NGT) { const int pos = i >> 6, f = i & 63; const float fr = exp2f(-13.287712379549449f * ((float)f / 64.0f)); float s, c; sincos_acc((float)pos * fr, s, c); tabD[i] = (f32x2){c, s}; }
    }
    if (PART == 0 && gw == 0) {
        const float* lv = a.in[16];
        float d0 = lv[lane] * lv[128 + lane] + lv[64 + lane] * lv[128 + 64 + lane];
        float d1 = lv[256 + lane] * lv[384 + lane] + lv[256 + 64 + lane] * lv[384 + 64 + lane];
        d0 = wave_sum(d0); d1 = wave_sum(d1);
        const float lam_init = 0.8f - 0.6f * expf(-0.3f);
        if (lane == 0) { float* lp = (float*)(ws + WS_LAM); lp[0] = expf(d0) - expf(d1) + lam_init; lp[1] = 1.0f - lam_init; }
    }
}

struct NM { const float* gain; const float* sh; const float* sc; int bstride; bf16_t* dst; };
constexpr int RW = 4;
template <bool TWO>
__device__ __forceinline__ void normmod_phase(const float* src, const NM A, const NM Bq, int gw, int NGW, int lane) {
    for (int row = gw; row < TOK; row += RW * NGW) {
        f32x4 v[RW][4]; float rinv[RW];
#pragma unroll
        for (int r = 0; r < RW; ++r) { const int rw = row + r * NGW < TOK ? row + r * NGW : row; const f32x4* xr = (const f32x4*)(src + (size_t)rw * DM) + lane;
#pragma unroll
            for (int j = 0; j < 4; ++j) v[r][j] = xr[64 * j]; }
#pragma unroll
        for (int r = 0; r < RW; ++r) { float ss = 0.f;
#pragma unroll
            for (int j = 0; j < 4; ++j) ss += (v[r][j][0] * v[r][j][0] + v[r][j][1] * v[r][j][1]) + (v[r][j][2] * v[r][j][2] + v[r][j][3] * v[r][j][3]);
            rinv[r] = 1.0f / sqrtf(wave_sum(ss) * (1.0f / DM) + EPS); }
#pragma unroll
        for (int r = 0; r < RW; ++r) {
            const int rw = row + r * NGW; if (rw >= TOK) break;
            const int b = rw >> 11;
#pragma unroll
            for (int j = 0; j < 4; ++j) {
                const int k0 = 256 * j + 4 * lane;
                { const f32x4 g = *(const f32x4*)(A.gain + k0), sc = *(const f32x4*)(A.sc + (size_t)b * A.bstride + k0), sh = *(const f32x4*)(A.sh + (size_t)b * A.bstride + k0);
                  const f32x4 o = v[r][j] * rinv[r] * g * (sc + 1.0f) + sh; u32x2 w; w.x = cvt_pk_bf16(o[0], o[1]); w.y = cvt_pk_bf16(o[2], o[3]); *(u32x2*)(A.dst + (size_t)rw * DM + k0) = w; }
                if (TWO) { const f32x4 g = *(const f32x4*)(Bq.gain + k0), sc = *(const f32x4*)(Bq.sc + (size_t)b * Bq.bstride + k0), sh = *(const f32x4*)(Bq.sh + (size_t)b * Bq.bstride + k0);
                  const f32x4 o = v[r][j] * rinv[r] * g * (sc + 1.0f) + sh; u32x2 w; w.x = cvt_pk_bf16(o[0], o[1]); w.y = cvt_pk_bf16(o[2], o[3]); *(u32x2*)(Bq.dst + (size_t)rw * DM + k0) = w; }
            }
        }
    }
}
__device__ __forceinline__ void gate_phase(const bf16_t* O, const bf16_t* Gt, bf16_t* Y, int gw, int NGW, int lane) {
    for (int idx0 = gw; idx0 < TOK * 4; idx0 += RW * NGW) {
        u32x4 ov[RW], gv[RW];
#pragma unroll
        for (int r = 0; r < RW; ++r) { const int ix = idx0 + r * NGW < TOK * 4 ? idx0 + r * NGW : idx0; const size_t off = (size_t)ix * 512 + 8 * lane; ov[r] = *(const u32x4*)(O + off); gv[r] = *(const u32x4*)(Gt + off); }
#pragma unroll
        for (int r = 0; r < RW; ++r) {
            const int ix = idx0 + r * NGW; if (ix >= TOK * 4) break;
            float o[8], g[8];
            o[0] = bf_lo(ov[r].x); o[1] = bf_hi(ov[r].x); o[2] = bf_lo(ov[r].y); o[3] = bf_hi(ov[r].y); o[4] = bf_lo(ov[r].z); o[5] = bf_hi(ov[r].z); o[6] = bf_lo(ov[r].w); o[7] = bf_hi(ov[r].w);
            g[0] = bf_lo(gv[r].x); g[1] = bf_hi(gv[r].x); g[2] = bf_lo(gv[r].y); g[3] = bf_hi(gv[r].y); g[4] = bf_lo(gv[r].z); g[5] = bf_hi(gv[r].z); g[6] = bf_lo(gv[r].w); g[7] = bf_hi(gv[r].w);
            float ss = 0.f;
#pragma unroll
            for (int i = 0; i < 8; ++i) ss += o[i] * o[i];
            const float rinv = 1.0f / sqrtf(wave_sum(ss) * (1.0f / 512.0f) + EPS);
            float y[8];
#pragma unroll
            for (int i = 0; i < 8; ++i) y[i] = silu_f(g[i]) * o[i] * rinv;
            u32x4 w; w.x = cvt_pk_bf16(y[0], y[1]); w.y = cvt_pk_bf16(y[2], y[3]); w.z = cvt_pk_bf16(y[4], y[5]); w.w = cvt_pk_bf16(y[6], y[7]);
            *(u32x4*)(Y + (size_t)ix * 512 + 8 * lane) = w;
        }
    }
}
__device__ __forceinline__ void combine_phase(const bf16_t* O0, const bf16_t* O1, bf16_t* Od, const float* gain, const float* lamp, int gw, int NGW, int lane) {
    const float lam = lamp[0], oml = lamp[1];
    const f32x4 gn = *(const f32x4*)(gain + 4 * lane);
    for (int idx0 = gw; idx0 < TOK * 4; idx0 += RW * NGW) {
        u32x2 av[RW], bv[RW];
#pragma unroll
        for (int r = 0; r < RW; ++r) { const int ix = idx0 + r * NGW < TOK * 4 ? idx0 + r * NGW : idx0; const size_t off = (size_t)ix * 256 + 4 * lane; av[r] = *(const u32x2*)(O0 + off); bv[r] = *(const u32x2*)(O1 + off); }
#pragma unroll
        for (int r = 0; r < RW; ++r) {
            const int ix = idx0 + r * NGW; if (ix >= TOK * 4) break;
            const u32x2 a = av[r], b = bv[r];
            f32x4 o = {bf_lo(a.x) - lam * bf_lo(b.x), bf_hi(a.x) - lam * bf_hi(b.x), bf_lo(a.y) - lam * bf_lo(b.y), bf_hi(a.y) - lam * bf_hi(b.y)};
            const float ss = (o[0] * o[0] + o[1] * o[1]) + (o[2] * o[2] + o[3] * o[3]);
            const float rinv = 1.0f / sqrtf(wave_sum(ss) * (1.0f / 256.0f) + EPS);
            o = o * (rinv * oml) * gn;
            u32x2 w; w.x = cvt_pk_bf16(o[0], o[1]); w.y = cvt_pk_bf16(o[2], o[3]); *(u32x2*)(Od + (size_t)ix * 256 + 4 * lane) = w;
        }
    }
}
__device__ __forceinline__ void final_norm_phase(float* X, const float* gain, int gw, int NGW, int lane) {
    for (int row = gw; row < TOK; row += RW * NGW) {
        f32x4 v[RW][4]; float rinv[RW];
#pragma unroll
        for (int r = 0; r < RW; ++r) { const int rw = row + r * NGW < TOK ? row + r * NGW : row; const f32x4* xr = (const f32x4*)(X + (size_t)rw * DM) + lane;
#pragma unroll
            for (int j = 0; j < 4; ++j) v[r][j] = xr[64 * j]; }
#pragma unroll
        for (int r = 0; r < RW; ++r) { float ss = 0.f;
#pragma unroll
            for (int j = 0; j < 4; ++j) ss += (v[r][j][0] * v[r][j][0] + v[r][j][1] * v[r][j][1]) + (v[r][j][2] * v[r][j][2] + v[r][j][3] * v[r][j][3]);
            rinv[r] = 1.0f / sqrtf(wave_sum(ss) * (1.0f / DM) + EPS); }
#pragma unroll
        for (int r = 0; r < RW; ++r) {
            const int rw = row + r * NGW; if (rw >= TOK) break;
            f32x4* xw = (f32x4*)(X + (size_t)rw * DM) + lane;
#pragma unroll
            for (int j = 0; j < 4; ++j) __builtin_nontemporal_store(v[r][j] * rinv[r] * *(const f32x4*)(gain + 256 * j + 4 * lane), xw + 64 * j);
        }
    }
}

__device__ __forceinline__ void retention_phase(LAS unsigned char* lds, const bf16_t* Q, const bf16_t* K, bf16_t* V, const bf16_t* Gt, float* ssqb, int G) {
    const int tid = threadIdx.x, lane = tid & 63, w = __builtin_amdgcn_readfirstlane(tid >> 6), li = lane & 15, fq = lane >> 4, q4 = li >> 2, p4 = li & 3;
    constexpr int KS = 528, VS = 144, SS = 528;
    LAS unsigned char* Ks = lds; LAS unsigned char* Vs = lds + 128 * KS; LAS unsigned char* StT = Vs + 128 * VS;
    const int bx = blockIdx.x; const int vcu = (G % 8 == 0) ? (bx % 8) * (G / 8) + bx / 8 : bx;
    for (int item = vcu; item < 256; item += G) {
        const int bh = item >> 3, sl = item & 7, b = bh >> 2, h = bh & 3;
        const float gam = 1.0f - exp2f(-5.0f - (float)h);
        float g128 = gam;
#pragma unroll
        for (int i = 0; i < 7; ++i) g128 *= g128;
        const float g127 = g128 / gam;
        const bf16_t* Qb = Q + (size_t)b * SEQ * 1024 + h * 256;
        const bf16_t* Kb = K + (size_t)b * SEQ * 1024 + h * 256;
        const bf16_t* Vb = V + (size_t)b * SEQ * 2048 + h * 512 + sl * 64;
        bf16_t* Ob = V + (size_t)b * SEQ * 2048 + h * 512 + sl * 64;
        const bf16_t* Gb = Gt + (size_t)b * SEQ * 2048 + h * 512 + sl * 64;
        __syncthreads();
        for (int i = tid; i < 64 * SS / 16; i += 512) *(LAS u32x4*)(StT + i * 16) = (u32x4){0u, 0u, 0u, 0u};
        f32x4 St[2][4];
#pragma unroll
        for (int mt = 0; mt < 2; ++mt)
#pragma unroll
            for (int nt = 0; nt < 4; ++nt) St[mt][nt] = (f32x4){0.f, 0.f, 0.f, 0.f};
        u32x4 kreg[8], vreg[2]; bf16x8 Qf[8];
        const unsigned voK = (unsigned)((tid >> 5) * 1024 + (tid & 31) * 8) * 2u, voV = (unsigned)((tid >> 3) * 2048 + (tid & 7) * 8) * 2u, voQ = (unsigned)(li * 1024 + 8 * fq) * 2u;
#define RET_LOAD_KV(t0_) do { \
        _Pragma("unroll") for (int i = 0; i < 8; ++i) kreg[i] = *(const u32x4*)((const char*)Kb + (size_t)((t0_) + 16 * i) * 2048 + voK); \
        _Pragma("unroll") for (int i = 0; i < 2; ++i) vreg[i] = *(const u32x4*)((const char*)Vb + (size_t)((t0_) + 64 * i) * 4096 + voV); } while (0)
#define RET_LOAD_Q(t0_) do { _Pragma("unroll") for (int ks = 0; ks < 8; ++ks) Qf[ks] = *(const bf16x8*)((const char*)Qb + (size_t)((t0_) + 16 * w) * 2048 + ks * 64 + voQ); } while (0)
#define RET_WRITE_KV() do { \
        _Pragma("unroll") for (int i = 0; i < 8; ++i) { const int id = tid + 512 * i, r = id >> 5, pc = id & 31; *(LAS u32x4*)(Ks + r * KS + pc * 16) = kreg[i]; } \
        _Pragma("unroll") for (int i = 0; i < 2; ++i) { const int id = tid + 512 * i, r = id >> 3, pc = id & 7; *(LAS u32x4*)(Vs + r * VS + pc * 16) = vreg[i]; } } while (0)
        RET_LOAD_KV(0); RET_LOAD_Q(0);
        RET_WRITE_KV();
        __syncthreads();
#pragma nounroll
        for (int n = 0; n < 16; ++n) {
            const int t0 = n * 128;
            if (n + 1 < 16) RET_LOAD_KV(t0 + 128);
            u32x2 greg[4];
#pragma unroll
            for (int nt = 0; nt < 4; ++nt) greg[nt] = *(const u32x2*)(Gb + (size_t)(t0 + 16 * w + li) * 2048 + 16 * nt + 4 * fq);
            f32x4 accS[8];
#pragma unroll
            for (int kt = 0; kt < 8; ++kt) {
                accS[kt] = (f32x4){0.f, 0.f, 0.f, 0.f};
                if (kt <= w) {
#pragma unroll
                    for (int ks = 0; ks < 8; ++ks) accS[kt] = MFMA16(lds_b128(Ks + (16 * kt + li) * KS + (32 * ks + 8 * fq) * 2), Qf[ks], accS[kt]);
                    __builtin_amdgcn_sched_barrier(0);
                    if (kt == w) {
#pragma unroll
                        for (int r = 0; r < 4; ++r) if (4 * fq + r > li) accS[kt][r] = 0.f;
                    }
                }
            }
            bf16x8 P[4];
#pragma unroll
            for (int s = 0; s < 4; ++s) P[s] = pack_frag(accS[2 * s], accS[2 * s + 1]);
            f32x4 o1[4], o2[4];
#pragma unroll
            for (int nt = 0; nt < 4; ++nt) { o1[nt] = (f32x4){0.f, 0.f, 0.f, 0.f}; o2[nt] = (f32x4){0.f, 0.f, 0.f, 0.f}; }
#pragma unroll
            for (int s = 0; s < 4; ++s) {
                if (2 * s <= w) {
#pragma unroll
                    for (int nt = 0; nt < 4; ++nt) {
                        const bf16x8 av = cat4(lds_tr(Vs + (32 * s + 4 * fq + q4) * VS + (16 * nt + 4 * p4) * 2), lds_tr(Vs + (32 * s + 16 + 4 * fq + q4) * VS + (16 * nt + 4 * p4) * 2));
                        o1[nt] = MFMA16(av, P[s], o1[nt]);
                    }
                }
            }
#pragma unroll
            for (int ks = 0; ks < 8; ++ks)
#pragma unroll
                for (int nt = 0; nt < 4; ++nt) { o2[nt] = MFMA16(lds_b128(StT + (16 * nt + li) * SS + (32 * ks + 8 * fq) * 2), Qf[ks], o2[nt]); if (nt == 3 && (ks & 1)) __builtin_amdgcn_sched_barrier(0); }
            {
                bf16_t* op = Ob + (size_t)(t0 + 16 * w + li) * 2048 + 4 * fq;
                float sq = 0.f;
#pragma unroll
                for (int nt = 0; nt < 4; ++nt) { const f32x4 o = o1[nt] + o2[nt] * gam;
                    sq += (o[0] * o[0] + o[1] * o[1]) + (o[2] * o[2] + o[3] * o[3]);
                    const float y0 = silu_f(bf_lo(greg[nt].x)) * o[0], y1 = silu_f(bf_hi(greg[nt].x)) * o[1], y2 = silu_f(bf_lo(greg[nt].y)) * o[2], y3 = silu_f(bf_hi(greg[nt].y)) * o[3];
                    u32x2 wv; wv.x = cvt_pk_bf16(y0, y1); wv.y = cvt_pk_bf16(y2, y3); *(u32x2*)(op + 16 * nt) = wv; }
                sq += __shfl_xor(sq, 16); sq += __shfl_xor(sq, 32);
                if (fq == 0) ssqb[((size_t)(b * SEQ + t0 + 16 * w + li) * 4 + h) * 8 + sl] = sq;
            }
            if (n + 1 < 16) RET_LOAD_Q(t0 + 128);
            f32x4 tmp[2][4];
#pragma unroll
            for (int mt = 0; mt < 2; ++mt)
#pragma unroll
                for (int nt = 0; nt < 4; ++nt) tmp[mt][nt] = (f32x4){0.f, 0.f, 0.f, 0.f};
#pragma unroll
            for (int s = 0; s < 4; ++s) {
                bf16x8 bv[4];
#pragma unroll
                for (int nt = 0; nt < 4; ++nt) bv[nt] = cat4(lds_tr(Vs + (32 * s + 8 * fq + q4) * VS + (16 * nt + 4 * p4) * 2), lds_tr(Vs + (32 * s + 8 * fq + 4 + q4) * VS + (16 * nt + 4 * p4) * 2));
#pragma unroll
                for (int mt = 0; mt < 2; ++mt) {
                    const bf16x8 ak = cat4(lds_tr(Ks + (32 * s + 8 * fq + q4) * KS + (32 * w + 16 * mt + 4 * p4) * 2), lds_tr(Ks + (32 * s + 8 * fq + 4 + q4) * KS + (32 * w + 16 * mt + 4 * p4) * 2));
#pragma unroll
                    for (int nt = 0; nt < 4; ++nt) tmp[mt][nt] = MFMA16(ak, bv[nt], tmp[mt][nt]);
                }
            }
#pragma unroll
            for (int mt = 0; mt < 2; ++mt)
#pragma unroll
                for (int nt = 0; nt < 4; ++nt) St[mt][nt] = St[mt][nt] * g128 + tmp[mt][nt] * g127;
            if (n + 1 < 16) {
                __syncthreads();
#pragma unroll
                for (int mt = 0; mt < 2; ++mt)
#pragma unroll
                    for (int nt = 0; nt < 4; ++nt) {
                        u32x2 wv; wv.x = cvt_pk_bf16(St[mt][nt][0], St[mt][nt][1]); wv.y = cvt_pk_bf16(St[mt][nt][2], St[mt][nt][3]);
                        *(LAS u32x2*)(StT + (16 * nt + li) * SS + (32 * w + 16 * mt + 4 * fq) * 2) = wv;
                    }
                RET_WRITE_KV();
                __syncthreads();
            }
        }
    }
#undef RET_WRITE_KV
#undef RET_LOAD_KV
#undef RET_LOAD_Q
    __syncthreads();
}

__device__ __forceinline__ void attn_phase(LAS unsigned char* lds, const bf16_t* Qd, const bf16_t* Kd, const bf16_t* Vd, bf16_t* O0, bf16_t* O1, int G) {
    const int tid = threadIdx.x, lane = tid & 63, w = __builtin_amdgcn_readfirstlane(tid >> 6), li = lane & 15, fq = lane >> 4, q4 = li >> 2, p4 = li & 3;
    constexpr int KS = 272, VS = 544, SLOT = 32768;
    const float NEG = -__builtin_inff();
    const unsigned ldsb = (unsigned)(size_t)lds;
    int soff[4]; bool isv[4];
#pragma unroll
    for (int i = 0; i < 4; ++i) {
        const int q = (w * 4 + i) * 64 + lane;
        if (q < 544) { const int row = q / 17, pc = q % 17; soff[i] = row * 1024 + (pc < 16 ? pc : 15) * 8; isv[i] = false; }
        else if (q < 1632) { const int q2 = q - 544, row = q2 / 34, pc = q2 % 34; soff[i] = row * 1024 + (pc < 32 ? pc : 31) * 8; isv[i] = true; }
        else { soff[i] = 0; isv[i] = false; }
    }
    for (int idx = blockIdx.x; idx < 512; idx += G) {
        const int r = idx >> 8, c = idx & 255, xc = c & 7, l = c >> 3, qbi = l & 7;
        const int bh = 4 * xc + 2 * r + (l >> 4), p = (l >> 3) & 1, b = bh >> 2, h = bh & 3;
        const int qb = r ? 7 - qbi : qbi;
        const int q0 = qb * 256, nkt = 8 * (qb + 1);
        const int r0 = q0 + 16 * w, r1 = q0 + 16 * (15 - w);
        const bf16_t* Kp = Kd + (size_t)b * SEQ * 1024 + h * 256 + p * 128;
        const bf16_t* Vp = Vd + (size_t)b * SEQ * 1024 + h * 256;
        const bf16_t* src[4];
#pragma unroll
        for (int i = 0; i < 4; ++i) src[i] = (isv[i] ? Vp : Kp) + soff[i];
        bf16x8 Qf[2][4];
#pragma unroll
        for (int u = 0; u < 2; ++u)
#pragma unroll
            for (int ks = 0; ks < 4; ++ks) Qf[u][ks] = *(const bf16x8*)(Qd + (size_t)(b * SEQ + (u ? r1 : r0) + li) * 1024 + h * 256 + p * 128 + 32 * ks + 8 * fq);
#define ATT_DMA(tile_, slot_) do { const size_t ko_ = (size_t)(tile_) * (32 * 1024); const unsigned lb_ = ldsb + (unsigned)(slot_) * SLOT + (unsigned)(w * 4) * 1024u; _Pragma("unroll") for (int i = 0; i < 4; ++i) \
        glds16_asm(src[i] + ko_, __builtin_amdgcn_readfirstlane(lb_ + i * 1024)); } while (0)
#pragma unroll
        for (int u = 0; u < 2; ++u)
#pragma unroll
            for (int ks = 0; ks < 4; ++ks) asm volatile("" : "+v"(Qf[u][ks]));
        asm volatile("s_waitcnt lgkmcnt(0)\n\ts_barrier" ::: "memory");
        ATT_DMA(0, 0); ATT_DMA(1, 1); ATT_DMA(2, 2);
        float mrun[2] = {NEG, NEG}, lrun[2] = {0.f, 0.f};
        f32x4 O[2][16];
#pragma unroll
        for (int u = 0; u < 2; ++u)
#pragma unroll
            for (int nt = 0; nt < 16; ++nt) O[u][nt] = (f32x4){0.f, 0.f, 0.f, 0.f};
#define ATT_BODY(A0) do { \
                const LAS unsigned char* Kt = lds + (kt & 3) * SLOT; const LAS unsigned char* Vt = Kt + 32 * KS; \
                f32x4 sv[2][2]; \
                _Pragma("unroll") for (int u = 0; u < 2; ++u) _Pragma("unroll") for (int kk = 0; kk < 2; ++kk) sv[u][kk] = (f32x4){0.f, 0.f, 0.f, 0.f}; \
                __builtin_amdgcn_s_setprio(1); \
                _Pragma("unroll") for (int kk = 0; kk < 2; ++kk) _Pragma("unroll") for (int ks = 0; ks < 4; ++ks) { \
                    const bf16x8 a = lds_b128(Kt + (16 * kk + li) * KS + (32 * ks + 8 * fq) * 2); \
                    if (A0) sv[0][kk] = MFMA16(a, Qf[0][ks], sv[0][kk]); sv[1][kk] = MFMA16(a, Qf[1][ks], sv[1][kk]); } \
                __builtin_amdgcn_s_setprio(0); \
                _Pragma("unroll") for (int u = (A0) ? 0 : 1; u < 2; ++u) { const int rb = u ? r1 : r0; \
                    if (k0 + 31 > rb) { _Pragma("unroll") for (int kk = 0; kk < 2; ++kk) _Pragma("unroll") for (int rg = 0; rg < 4; ++rg) if (k0 + 16 * kk + 4 * fq + rg > rb + li) sv[u][kk][rg] = NEG; } } \
                float alpha[2] = {1.0f, 1.0f}; \
                _Pragma("unroll") for (int u = (A0) ? 0 : 1; u < 2; ++u) { \
                    float mx = fmaxf(fmaxf(fmaxf(sv[u][0][0], sv[u][0][1]), fmaxf(sv[u][0][2], sv[u][0][3])), fmaxf(fmaxf(sv[u][1][0], sv[u][1][1]), fmaxf(sv[u][1][2], sv[u][1][3]))); \
                    mx = fmaxf(mx, __shfl_xor(mx, 16)); mx = fmaxf(mx, __shfl_xor(mx, 32)); \
                    const float mn = fmaxf(mrun[u], mx); alpha[u] = __builtin_amdgcn_exp2f(mrun[u] - mn); mrun[u] = mn; \
                    float ls = 0.f; \
                    _Pragma("unroll") for (int kk = 0; kk < 2; ++kk) _Pragma("unroll") for (int rg = 0; rg < 4; ++rg) { sv[u][kk][rg] = __builtin_amdgcn_exp2f(sv[u][kk][rg] - mn); ls += sv[u][kk][rg]; } \
                    lrun[u] = lrun[u] * alpha[u] + ls; } \
                if (__any((alpha[0] != 1.0f) || (alpha[1] != 1.0f))) { \
                    _Pragma("unroll") for (int u = (A0) ? 0 : 1; u < 2; ++u) _Pragma("unroll") for (int nt = 0; nt < 16; ++nt) O[u][nt] = O[u][nt] * alpha[u]; } \
                const bf16x8 P0 = pack_frag(sv[0][0], sv[0][1]), P1 = pack_frag(sv[1][0], sv[1][1]); \
                __builtin_amdgcn_sched_barrier(0); \
                __builtin_amdgcn_s_setprio(1); \
                _Pragma("unroll") for (int nt = 0; nt < 16; ++nt) { \
                    const bf16x8 av = cat4(lds_tr(Vt + (4 * fq + q4) * VS + (16 * nt + 4 * p4) * 2), lds_tr(Vt + (16 + 4 * fq + q4) * VS + (16 * nt + 4 * p4) * 2)); \
                    if (A0) O[0][nt] = MFMA16(av, P0, O[0][nt]); O[1][nt] = MFMA16(av, P1, O[1][nt]); \
                    if ((nt & 3) == 3) __builtin_amdgcn_sched_barrier(0); } \
                __builtin_amdgcn_s_setprio(0); } while (0)
#define ATT_STEP() do { asm volatile("s_waitcnt vmcnt(8) lgkmcnt(0)\n\ts_barrier" ::: "memory"); \
                const int tn_ = kt + 3 < nkt ? kt + 3 : nkt - 1; ATT_DMA(tn_, (kt + 3) & 3); } while (0)
        const int ktA = (r0 + 15) / 32 + 1;
        int kt = 0;
#pragma nounroll
        for (; kt < ktA; ++kt) { const int k0 = 32 * kt; ATT_STEP(); ATT_BODY(1); }
#pragma nounroll
        for (; kt < nkt; ++kt) { const int k0 = 32 * kt; ATT_STEP(); if (k0 <= r1 + 15) ATT_BODY(0); }
#undef ATT_BODY
#undef ATT_STEP
#undef ATT_DMA
#pragma unroll
        for (int u = 0; u < 2; ++u) {
            float l = lrun[u]; l += __shfl_xor(l, 16); l += __shfl_xor(l, 32);
            const float inv = 1.0f / l;
            bf16_t* op = (p ? O1 : O0) + (size_t)(b * SEQ + (u ? r1 : r0) + li) * 1024 + h * 256 + 4 * fq;
#pragma unroll
            for (int nt = 0; nt < 16; ++nt) { const f32x4 o = O[u][nt] * inv; u32x2 wv; wv.x = cvt_pk_bf16(o[0], o[1]); wv.y = cvt_pk_bf16(o[2], o[3]); *(u32x2*)(op + 16 * nt) = wv; }
        }
    }
    asm volatile("s_waitcnt vmcnt(0) lgkmcnt(0)\n\ts_barrier" ::: "memory");
}

#define XB_TMO      128
#define XB_XCNT(j)  (256  + 64 * (j))
#define XB_XSUB(j)  (1280 + 64 * (j))
#define XB_XGEN(j)  (2304 + 64 * (j))
#define XB_TOP      3328
#define XB_TOPGEN   3392
#define XCD_BAR_WORDS 3456
#define XB_SPIN_CAP (1u << 18)
__device__ __forceinline__ unsigned xb_ld(unsigned* p)              { return __hip_atomic_load(p, __ATOMIC_RELAXED, __HIP_MEMORY_SCOPE_AGENT); }
__device__ __forceinline__ unsigned xb_add(unsigned* p, unsigned v) { return __hip_atomic_fetch_add(p, v, __ATOMIC_RELAXED, __HIP_MEMORY_SCOPE_AGENT); }
__device__ __forceinline__ unsigned xb_xcc_id() { return (unsigned)__builtin_amdgcn_s_getreg((3 << 11) | 20) & 0xFu; }
#define XB_SPIN(cond, bar) do { unsigned _sp = 0; while (cond) { __builtin_amdgcn_s_sleep(1); \
    if ((++_sp & 255u) == 0u) { if (xb_ld(&(bar)[XB_TMO])) break; if (_sp > XB_SPIN_CAP) { atomicAdd(&(bar)[XB_TMO], 1u); break; } } } } while (0)
struct XcdBarrier { unsigned* bar; unsigned x; volatile LAS unsigned* st; };
__device__ __forceinline__ XcdBarrier xcd_barrier_post(unsigned* bar, volatile LAS unsigned* st) {
    XcdBarrier b; b.bar = bar; b.x = xb_xcc_id(); b.st = st;
    if (threadIdx.x == 0) (void)xb_add(&bar[XB_XCNT(b.x)], 1u);
    return b;
}
__device__ __forceinline__ void xcd_barrier_complete(unsigned* bar, unsigned x, unsigned& nloc, unsigned& nx) {
    const unsigned G = gridDim.x * gridDim.y * gridDim.z;
    unsigned sum, cnt, mine, sp = 0u;
    for (;;) {
        sum = 0u; cnt = 0u; mine = 0u;
#pragma unroll
        for (unsigned j = 0; j < 16; ++j) { const unsigned c = xb_ld(&bar[XB_XCNT(j)]); sum += c; cnt += (c > 0u) ? 1u : 0u; mine = (j == x) ? c : mine; }
        if (sum == G) break;
        __builtin_amdgcn_s_sleep(1);
        if ((++sp & 255u) == 0u) { if (xb_ld(&bar[XB_TMO])) break; if (sp > XB_SPIN_CAP) { atomicAdd(&bar[XB_TMO], 1u); break; } }
    }
    nloc = mine > 0u ? mine : 1u; nx = cnt > 0u ? cnt : 1u;
}
__device__ __forceinline__ void xcd_barrier(const XcdBarrier& b) {
    asm volatile("s_waitcnt vmcnt(0)" ::: "memory");
    __syncthreads();
    if (threadIdx.x == 0) {
        unsigned* bar = b.bar;
        __builtin_amdgcn_s_waitcnt(0);
        unsigned nloc = b.st[0], nx = b.st[1];
        if (nloc == 0u) { xcd_barrier_complete(bar, b.x, nloc, nx); b.st[0] = nloc; b.st[1] = nx; }
        const unsigned old = xb_add(&bar[XB_XSUB(b.x)], 1u);
        const unsigned gen = old / nloc;
        if (old + 1u == (gen + 1u) * nloc) {
            __builtin_amdgcn_fence(__ATOMIC_RELEASE, "agent");
            asm volatile("s_waitcnt vmcnt(0)" ::: "memory");
            const unsigned og = xb_add(&bar[XB_TOP], 1u);
            const unsigned tg = og / nx;
            if (og + 1u == (tg + 1u) * nx) xb_add(&bar[XB_TOPGEN], 1u);
            else XB_SPIN(xb_ld(&bar[XB_TOPGEN]) == tg, bar);
            __builtin_amdgcn_fence(__ATOMIC_ACQUIRE, "agent");
            xb_add(&bar[XB_XGEN(b.x)], 1u);
            asm volatile("s_waitcnt vmcnt(0)" ::: "memory");
        } else {
            XB_SPIN(xb_ld(&bar[XB_XGEN(b.x)]) == gen, bar);
            __builtin_amdgcn_fence(__ATOMIC_ACQUIRE, "agent");
            asm volatile("s_waitcnt vmcnt(0)" ::: "memory");
        }
    }
    __syncthreads();
}

__global__ void __launch_bounds__(512, 2) yoco_fwd(Args args) {
    extern __shared__ __attribute__((aligned(16))) unsigned char lds_raw[];
    LAS unsigned char* lds = (LAS unsigned char*)lds_raw;
    LAS unsigned char* ldsx = lds + LDS_XOFF;
    cg::grid_group grid = cg::this_grid();
    const int tid = threadIdx.x, lane = tid & 63, wave = __builtin_amdgcn_readfirstlane(tid >> 6);
    const int G = gridDim.x, gw = blockIdx.x * 8 + wave, NGW = G * 8;
    unsigned char* ws = args.ws;
    const int lo = args.ph_lo, hi = args.ph_hi;
    volatile LAS unsigned* xst = (volatile LAS unsigned*)(lds + LDS_XOFF + 8192);
    if (tid < 2) xst[tid] = 0u;
    if (blockIdx.x == 0 && tid < 64) __hip_atomic_store((unsigned*)(ws + WS_XCNT) + 16 * tid, 0u, __ATOMIC_RELAXED, __HIP_MEMORY_SCOPE_AGENT);
    if (blockIdx.x == 0) { for (int i = tid; i < XCD_BAR_WORDS; i += 512) __hip_atomic_store((unsigned*)(ws + WS_BAR) + i, 0u, __ATOMIC_RELAXED, __HIP_MEMORY_SCOPE_AGENT); }
    asm volatile("s_waitcnt vmcnt(0)" ::: "memory");
    __syncthreads();
#define IN(k) (lo <= (k) && (k) < hi)
#define SEAM(k) do { if (IN(k) && hi > (k) + 1 && (k) != 16) xcd_barrier(xbar); } while (0)
    grid.sync();
    asm volatile("" ::: "memory");
    const XcdBarrier xbar = xcd_barrier_post((unsigned*)(ws + WS_BAR), xst);
    float* X = args.out;
    const float* mod0 = (const float*)(ws + WS_MOD0); const float* mod1 = (const float*)(ws + WS_MOD1); const float* kvmod = (const float*)(ws + WS_KVMOD);
    bf16_t* H = (bf16_t*)(ws + WS_H);
    bf16_t* U = (bf16_t*)(ws + WS_U);
    const float* tabR = (const float*)(ws + WS_TABR); const float* tabD = (const float*)(ws + WS_TABD);
    pg8::StaticOrder S;

#define PH(k, ...) do { if (IN(k)) { __VA_ARGS__ if (MK_DUP == (k)) { __VA_ARGS__ } } SEAM(k); if (MK_DUPSYNC) SEAM(k); } while (0)
    PH(0, { p0_prologue<0>(args, lds, wave, lane, G); });
    PH(1, { p0_prologue<1>(args, lds, wave, lane, G); NM a{args.in[2], mod0, mod0 + 1024, 6144, (bf16_t*)args.out}; normmod_phase<false>(args.in[0], a, a, gw, NGW, lane); });
    PH(2, {
        pg8::Gemm g{(const bf16_t*)args.out, (const bf16_t*)(ws + WS_WRIN), TOK, 6144, 1024, 256}; S.init(TOK, 6144, G, (int)blockIdx.x);
        EpiRetIn E{(bf16_t*)(ws + WS_Q), (bf16_t*)(ws + WS_K), (bf16_t*)(ws + WS_V), (bf16_t*)(ws + WS_G), tabR};
        pg8::gemm_phase<EpiRetIn>(lds, ldsx, g, S, E); });
    PH(3, { retention_phase(lds, (const bf16_t*)(ws + WS_Q), (const bf16_t*)(ws + WS_K), (bf16_t*)(ws + WS_V), (const bf16_t*)(ws + WS_G), (float*)(ws + WS_SSQ), G); });
    PH(5, {
        pg8::Gemm g{(const bf16_t*)(ws + WS_V), (const bf16_t*)(ws + WS_WROUT), TOK, 1024, 2048, 256}; S.init(TOK, 1024, G, (int)blockIdx.x);
        EpiResNorm<true, 1> E{args.in[0], X, mod0 + 2048, (const float*)(ws + WS_SSQ), {{H, args.in[2] + 1024, mod0 + 3072, mod0 + 4096, 6144}, {H, args.in[2] + 1024, mod0 + 3072, mod0 + 4096, 6144}}, (float*)(ws + WS_XSLOT), (unsigned*)(ws + WS_XCNT), 32u};
        pg8::gemm_phase<EpiResNorm<true, 1>>(lds, ldsx, g, S, E); });
    PH(7, {
        pg8::Gemm g{H - 2 * 1024, (const bf16_t*)(ws + WS_WFIN0), 65 * 256, NFF, 1024, 254}; S.init(65 * 256, NFF, G, (int)blockIdx.x);
        EpiFfn E{U, args.in[8], args.in[9]};
        pg8::gemm_phase<EpiFfn>(lds, ldsx, g, S, E); });
    PH(8, {
        pg8::Gemm g{U, (const bf16_t*)(ws + WS_WFDN0), TOK, 1024, DFF, 256}; S.init(TOK, 1024, G, (int)blockIdx.x);
        EpiResNorm<false, 2> E{X, X, mod0 + 5120, nullptr, {{H, args.in[11], kvmod, kvmod + 1024, 2048}, {(bf16_t*)(ws + WS_H3), args.in[2] + 2048, mod1, mod1 + 1024, 6144}}, (float*)(ws + WS_XSLOT), (unsigned*)(ws + WS_XCNT), 64u};
        pg8::gemm_phase<EpiResNorm<false, 2>>(lds, ldsx, g, S, E); });
    PH(10, {
        pg8::Gemm g{H, (const bf16_t*)(ws + WS_WKV), TOK, 3072, 1024, 256, (const bf16_t*)(ws + WS_H3), 8}; S.init(TOK, 3072, G, (int)blockIdx.x);
        EpiRope E{(bf16_t*)(ws + WS_KSH), (bf16_t*)(ws + WS_VSH), 4, tabD, 1.0f, (bf16_t*)(ws + WS_QD), 8, 0.08838834764831845f * 1.4426950408889634f};
        pg8::gemm_phase<EpiRope>(lds, ldsx, g, S, E); });
    PH(11, { attn_phase(lds, (const bf16_t*)(ws + WS_QD), (const bf16_t*)(ws + WS_KSH), (const bf16_t*)(ws + WS_VSH), (bf16_t*)(ws + WS_O0), (bf16_t*)(ws + WS_O1), G); });
    PH(12, { combine_phase((const bf16_t*)(ws + WS_O0), (const bf16_t*)(ws + WS_O1), (bf16_t*)(ws + WS_OD), args.in[17], (const float*)(ws + WS_LAM), gw, NGW, lane); });
    PH(13, {
        pg8::Gemm g{(const bf16_t*)(ws + WS_OD), (const bf16_t*)(ws + WS_WO), TOK, 1024, 1024, 256}; S.init(TOK, 1024, G, (int)blockIdx.x);
        EpiResNorm<false, 1> E{X, X, mod1 + 2048, nullptr, {{H, args.in[2] + 3072, mod1 + 3072, mod1 + 4096, 6144}, {H, args.in[2] + 3072, mod1 + 3072, mod1 + 4096, 6144}}, (float*)(ws + WS_XSLOT), (unsigned*)(ws + WS_XCNT), 96u};
        pg8::gemm_phase<EpiResNorm<false, 1>>(lds, ldsx, g, S, E); });
    PH(15, {
        pg8::Gemm g{H - 2 * 1024, (const bf16_t*)(ws + WS_WFIN1), 65 * 256, NFF, 1024, 254}; S.init(65 * 256, NFF, G, (int)blockIdx.x);
        EpiFfn E{U, args.in[8] + 3 * DFF, args.in[9] + DFF};
        pg8::gemm_phase<EpiFfn>(lds, ldsx, g, S, E); });
    PH(16, {
        pg8::Gemm g{U, (const bf16_t*)(ws + WS_WFDN1), TOK, 1024, DFF, 256}; S.init(TOK, 1024, G, (int)blockIdx.x);
        EpiResFinal E{X, X, mod1 + 5120, args.in[19], (float*)(ws + WS_XSLOT), (unsigned*)(ws + WS_XCNT), 128u};
        pg8::gemm_phase<EpiResFinal>(lds, ldsx, g, S, E); });
#undef PH
#undef IN
#undef SEAM
}

extern "C" void kernel_launch(void* const* d_in, const int* in_sizes, int n_in, void* d_out, int out_size, void* d_ws, size_t ws_size, hipStream_t stream) {
    static int grid = 0;
    if (grid == 0) {
        if (n_in != 20 || out_size != TOK * DM || ws_size < WS_END) { fprintf(stderr, "kernel_launch: unexpected shapes (n_in %d, out %d, ws %zu)\n", n_in, out_size, ws_size); grid = -1; return; }
        int dev = 0, cus = 0, per_cu = 0;
        if (hipGetDevice(&dev) != hipSuccess || hipDeviceGetAttribute(&cus, hipDeviceAttributeMultiprocessorCount, dev) != hipSuccess) { grid = -1; return; }
        if (hipFuncSetAttribute((const void*)yoco_fwd, hipFuncAttributeMaxDynamicSharedMemorySize, LDS_BYTES) != hipSuccess) { fprintf(stderr, "kernel_launch: hipFuncSetAttribute failed\n"); grid = -1; return; }
        if (hipOccupancyMaxActiveBlocksPerMultiprocessor(&per_cu, (const void*)yoco_fwd, 512, LDS_BYTES) != hipSuccess || per_cu < 1) { fprintf(stderr, "kernel_launch: occupancy query failed (%d)\n", per_cu); (void)hipGetLastError(); grid = -1; return; }
        if (cus != 256) { fprintf(stderr, "kernel_launch: built for a 256-CU device (one 256x256 unit per workgroup in the fused final-norm GEMM), found %d CUs\n", cus); grid = -1; return; }
        grid = cus;
    }
    if (grid < 0) return;
    Args a{};
    for (int i = 0; i < 20; ++i) a.in[i] = (const float*)d_in[i];
    a.out = (float*)d_out; a.ws = (unsigned char*)d_ws;
#if MK_PER_PHASE
    for (int ph = 0; ph < NPHASE; ++ph) {
        a.ph_lo = ph; a.ph_hi = ph + 1; void* kargs[] = {&a};
        hipError_t e = hipLaunchCooperativeKernel((const void*)yoco_fwd, dim3(grid), dim3(512), kargs, LDS_BYTES, stream);
        if (e != hipSuccess) { fprintf(stderr, "cooperative launch failed: %s\n", hipGetErrorString(e)); break; }
    }
#else
    a.ph_lo = 0; a.ph_hi = NPHASE; void* kargs[] = {&a};
    hipError_t e = hipLaunchCooperativeKernel((const void*)yoco_fwd, dim3(grid), dim3(512), kargs, LDS_BYTES, stream);
    if (e != hipSuccess) fprintf(stderr, "cooperative launch failed: %s (grid %d)\n", hipGetErrorString(e), grid);
#endif
}
```
